# Optimizing an MI355X kernel written in HIP

```python
import math
import jax
import jax.numpy as jnp
from jax import lax
import numpy as np

D_MODEL = 1024
BATCH = 1
SEQ = 16384
DEPTH = 4
DEC_BATCH = 32
DEC_SEQ = 64
PAST_LEN = 4096

CHUNK = 64
EPS = 1e-6
N_BRANCH = 3
D_FF = 4 * D_MODEL

A_HEADS = 4
A_DK = 128
A_DV = 128
A_KW = A_HEADS * A_DK
A_VW = A_HEADS * A_DV
A_BLOCK = 32

B_WIDTH = 512
B_BLOCKS = 8
B_BW = B_WIDTH // B_BLOCKS
B_CONV = 4
RG_C = 8.0

C_HEADS = 4
C_DK = 128
C_DV = 128
C_KW = C_HEADS * C_DK
C_VW = C_HEADS * C_DV
C_QKV = 2 * C_KW + C_VW
C_CONV = 4
C_BLOCK = CHUNK

IN_SIZES = (A_KW, A_KW, A_VW, A_VW, B_WIDTH, B_WIDTH, C_QKV, C_VW, C_HEADS, C_HEADS, N_BRANCH * D_MODEL)
D_IN = 2 * A_KW + 2 * A_VW + 2 * B_WIDTH + C_QKV + C_VW + 2 * C_HEADS + N_BRANCH * D_MODEL

kernel_name = 'hybrid_stream_hgrn2_rglru_gdn_step'


def split_points():
    pts, acc = [], 0
    for s in IN_SIZES[:-1]:
        acc += s
        pts.append(acc)
    return pts


def rms_norm(x, w):
    xf = x.astype(jnp.float32)
    y = xf * lax.rsqrt(jnp.mean(xf * xf, axis=-1, keepdims=True) + EPS)
    return (y * w.astype(jnp.float32)).astype(x.dtype)


def l2_norm(x):
    return x * lax.rsqrt(jnp.sum(x * x, axis=-1, keepdims=True) + EPS)


def causal_dwconv(x, prev, w):
    width = w.shape[0]
    t = x.shape[1]
    xp = jnp.concatenate([prev.astype(x.dtype), x], axis=1)
    y = xp[:, 0:t] * w[0]
    for j in range(1, width):
        y = y + xp[:, j:j + t] * w[j]
    return y, xp[:, t:]


def to_blocks(a, block):
    b, t = a.shape[:2]
    n = -(-t // block)
    a = jnp.pad(a, [(0, 0), (0, n * block - t)] + [(0, 0)] * (a.ndim - 2))
    a = a.reshape((b, n, block) + a.shape[2:])
    perm = (1, 0, 3, 2) + tuple(range(4, a.ndim))
    return a.transpose(perm)


def from_blocks(o, t):
    n, b, h, l, d = o.shape
    return o.transpose(1, 0, 3, 2, 4).reshape(b, n * l, h, d)[:, :t]


def hgrn2_core(q, k, v, logf, s0):
    t = q.shape[1]
    qb, kb, vb, gb = (to_blocks(a, A_BLOCK) for a in (q, k, v, logf))
    incl = jnp.tril(jnp.ones((A_BLOCK, A_BLOCK), dtype=bool))

    def step(s, inp):
        q_i, k_i, v_i, g_i = inp
        b = jnp.cumsum(g_i, axis=2)
        diff = b[:, :, :, None, :] - b[:, :, None, :, :]
        decay = jnp.exp(jnp.where(incl[:, :, None], diff, -jnp.inf))
        attn = jnp.einsum('bhtk,bhsk,bhtsk->bhts', q_i, k_i, decay)
        o = jnp.einsum('bhts,bhsv->bhtv', attn, v_i) + jnp.einsum('bhtk,bhkv->bhtv', q_i * jnp.exp(b), s)
        b_last = b[:, :, -1:, :]
        s = jnp.exp(b_last)[:, :, 0, :, None] * s + jnp.einsum('bhsk,bhsv->bhkv', k_i * jnp.exp(b_last - b), v_i)
        return s, o

    s, o = lax.scan(step, s0.astype(jnp.float32), (qb, kb, vb, gb))
    return from_blocks(o, t), s


def gdn_core(q, k, v, g, beta, s0):
    t = q.shape[1]
    qb, kb, vb = (to_blocks(a, C_BLOCK) for a in (q, k, v))
    gb, bb = to_blocks(g, C_BLOCK), to_blocks(beta, C_BLOCK)
    gc = jnp.cumsum(gb, axis=-1)
    incl = jnp.tril(jnp.ones((C_BLOCK, C_BLOCK), dtype=bool))
    strict = jnp.tril(jnp.ones((C_BLOCK, C_BLOCK), dtype=bool), -1)
    decay = jnp.exp(jnp.where(incl, gc[..., :, None] - gc[..., None, :], -jnp.inf))
    k_beta = kb * bb[..., None]
    a_mat = jnp.where(strict, jnp.einsum('nbhtk,nbhsk->nbhts', k_beta, kb) * decay, 0.0)
    eye = jnp.eye(C_BLOCK, dtype=jnp.float32)
    t_mat = lax.linalg.triangular_solve(eye + a_mat, jnp.broadcast_to(eye, a_mat.shape),
                                        left_side=True, lower=True, unit_diagonal=True)
    u = jnp.einsum('nbhts,nbhsv->nbhtv', t_mat, vb * bb[..., None])
    w = jnp.einsum('nbhts,nbhsk->nbhtk', t_mat, k_beta * jnp.exp(gc)[..., None])
    qk = jnp.where(incl, jnp.einsum('nbhtk,nbhsk->nbhts', qb, kb) * decay, 0.0)

    def step(s, inp):
        q_i, k_i, u_i, w_i, g_i, qk_i = inp
        v_new = u_i - jnp.einsum('bhtk,bhkv->bhtv', w_i, s)
        o = (jnp.einsum('bhtk,bhkv->bhtv', q_i * jnp.exp(g_i)[..., None], s)
             + jnp.einsum('bhts,bhsv->bhtv', qk_i, v_new))
        g_last = g_i[..., -1:]
        s = (s * jnp.exp(g_last)[..., None]
             + jnp.einsum('bhtk,bhtv->bhkv', k_i * jnp.exp(g_last - g_i)[..., None], v_new))
        return s, o

    s, o = lax.scan(step, s0.astype(jnp.float32), (qb, kb, u, w, gc, qk))
    return from_blocks(o, t), s


def rg_lru(x, h0, w_a, b_a, w_x, b_x, lam, first):
    f32 = jnp.float32
    b, t, _ = x.shape
    xf = x.astype(f32)
    xb = xf.reshape(b, t, B_BLOCKS, B_BW)
    r = jax.nn.sigmoid(jnp.einsum('btnc,ncd->btnd', xb, w_a.astype(f32)).reshape(b, t, B_WIDTH) + b_a.astype(f32))
    i = jax.nn.sigmoid(jnp.einsum('btnc,ncd->btnd', xb, w_x.astype(f32)).reshape(b, t, B_WIDTH) + b_x.astype(f32))
    log_a = -RG_C * r * jax.nn.softplus(-lam.astype(f32))
    a = jnp.exp(log_a)
    mult = jnp.sqrt(-jnp.expm1(2.0 * log_a))
    if first:
        mult = mult.at[:, 0].set(1.0)
    u = mult * i * xf
    u = u.at[:, 0].add(a[:, 0] * h0.astype(f32))

    def combine(e1, e2):
        return e1[0] * e2[0], e2[0] * e1[1] + e2[1]

    _, h = lax.associative_scan(combine, (a, u), axis=1)
    return h, h[:, -1]


def trunk_layer(x, states, p, lb, first):
    f32 = jnp.float32
    s_a, h_b, conv_b, s_c, conv_c = states
    bsz, t, _ = x.shape
    h = rms_norm(x, p['pre_mix'])
    z = h @ p['w_in']
    (za_q, za_f, za_i, za_g, zb_x, zb_g, zc_qkv, zc_g, zc_beta, zc_alpha, z_merge) = jnp.split(z, split_points(), axis=-1)

    qa = jax.nn.silu(za_q.astype(f32)).reshape(bsz, t, A_HEADS, A_DK)
    zf = za_f.astype(f32)
    lbf = lb.astype(f32)
    logf = jnp.logaddexp(jnp.log(lbf), jnp.log1p(-lbf) + jax.nn.log_sigmoid(zf))
    ka = (1.0 - lbf) * jax.nn.sigmoid(-zf)
    va = za_i.astype(f32).reshape(bsz, t, A_HEADS, A_DV)
    oa, s_a_new = hgrn2_core(qa, ka.reshape(bsz, t, A_HEADS, A_DK), va, logf.reshape(bsz, t, A_HEADS, A_DK), s_a)
    oa = rms_norm(oa, p['a_norm']) * jax.nn.silu(za_g.astype(f32)).reshape(bsz, t, A_HEADS, A_DV)
    oa = oa.reshape(bsz, t, A_VW).astype(x.dtype)

    xb_c, conv_b_new = causal_dwconv(zb_x, conv_b, p['b_conv_w'])
    xb_c = xb_c + p['b_conv_b']
    hb, h_b_new = rg_lru(xb_c, h_b, p['b_gate_a_w'], p['b_gate_a_b'], p['b_gate_x_w'], p['b_gate_x_b'], p['b_lambda'], first)
    ob = (jax.nn.gelu(zb_g.astype(f32)) * hb).astype(x.dtype)

    qkv, conv_c_new = causal_dwconv(zc_qkv, conv_c, p['c_conv_w'])
    qkv = jax.nn.silu(qkv.astype(f32))
    qc, kc, vc = jnp.split(qkv, [C_KW, 2 * C_KW], axis=-1)
    qc = l2_norm(qc.reshape(bsz, t, C_HEADS, C_DK)) * (C_DK ** -0.5)
    kc = l2_norm(kc.reshape(bsz, t, C_HEADS, C_DK))
    vc = vc.reshape(bsz, t, C_HEADS, C_DV)
    beta = jax.nn.sigmoid(zc_beta.astype(f32))
    gdec = -jnp.exp(p['c_a_log'].astype(f32)) * jax.nn.softplus(zc_alpha.astype(f32) + p['c_dt_bias'].astype(f32))
    oc, s_c_new = gdn_core(qc, kc, vc, gdec, beta, s_c)
    oc = rms_norm(oc, p['c_norm']) * jax.nn.silu(zc_g.astype(f32)).reshape(bsz, t, C_HEADS, C_DV)
    oc = oc.reshape(bsz, t, C_VW).astype(x.dtype)

    gates = jax.nn.sigmoid(z_merge.astype(f32)).reshape(bsz, t, N_BRANCH, D_MODEL).astype(x.dtype)
    merged = (gates[:, :, 0] * (oa @ p['w_br_a']) + gates[:, :, 1] * (ob @ p['w_br_b'])
              + gates[:, :, 2] * (oc @ p['w_br_c']))
    x = x + rms_norm(merged @ p['w_out'], p['post_mix'])

    h2 = rms_norm(x, p['pre_mlp'])
    m = jnp.square(jax.nn.relu(h2 @ p['w_up'])) @ p['w_down']
    x = x + rms_norm(m, p['post_mlp'])
    new = (s_a_new, h_b_new, conv_b_new, s_c_new, conv_c_new)
    return x, tuple(n.astype(o.dtype) for n, o in zip(new, states))


def setup_inputs(seed: int = 0) -> dict:
    key = jax.random.key(seed)
    ks = jax.random.split(key, 32)
    f32 = jnp.float32

    def nrm(k, shape, scale):
        return scale * jax.random.normal(k, shape, f32)

    def gain(k, shape):
        return 1.0 + 0.02 * jax.random.normal(k, shape, f32)

    u = jax.random.uniform(ks[20], (DEPTH, B_WIDTH), f32, 0.9, 0.999)
    a_base = u ** (1.0 / RG_C)
    b_lambda = jnp.log(a_base) - jnp.log1p(-a_base)
    c_a_log = jnp.log(jax.random.uniform(ks[22], (DEPTH, C_HEADS), f32, 1.0, 16.0))
    dt = jnp.exp(jax.random.uniform(ks[23], (DEPTH, C_HEADS), f32, math.log(1e-3), math.log(1e-1)))
    c_dt_bias = dt + jnp.log(-jnp.expm1(-dt))
    return {
        'x_prompt': nrm(ks[0], (BATCH, SEQ, D_MODEL), 1.0),
        'x_sample': nrm(ks[1], (DEC_BATCH, DEC_SEQ, D_MODEL), 1.0),
        'state_hgrn': nrm(ks[2], (DEPTH, DEC_BATCH, A_HEADS, A_DK, A_DV), 0.5),
        'state_rglru': nrm(ks[3], (DEPTH, DEC_BATCH, B_WIDTH), 0.5),
        'state_rglru_conv': nrm(ks[4], (DEPTH, DEC_BATCH, B_CONV - 1, B_WIDTH), 1.0),
        'state_gdn': nrm(ks[5], (DEPTH, DEC_BATCH, C_HEADS, C_DK, C_DV), 0.1),
        'state_gdn_conv': nrm(ks[6], (DEPTH, DEC_BATCH, C_CONV - 1, C_QKV), 1.0),
        'lb_raw': nrm(ks[7], (DEPTH, A_KW), 0.1),
        'norm_pre_mix': gain(ks[8], (DEPTH, D_MODEL)),
        'norm_post_mix': gain(ks[9], (DEPTH, D_MODEL)),
        'norm_pre_mlp': gain(ks[10], (DEPTH, D_MODEL)),
        'norm_post_mlp': gain(ks[11], (DEPTH, D_MODEL)),
        'w_in': nrm(ks[12], (DEPTH, D_MODEL, D_IN), D_MODEL ** -0.5),
        'a_norm': gain(ks[13], (DEPTH, A_DV)),
        'b_conv_w': nrm(ks[14], (DEPTH, B_CONV, B_WIDTH), 0.5),
        'b_conv_b': nrm(ks[15], (DEPTH, B_WIDTH), 0.01),
        'b_gate_a_w': nrm(ks[16], (DEPTH, B_BLOCKS, B_BW, B_BW), B_BW ** -0.5),
        'b_gate_a_b': nrm(ks[17], (DEPTH, B_WIDTH), 0.01),
        'b_gate_x_w': nrm(ks[18], (DEPTH, B_BLOCKS, B_BW, B_BW), B_BW ** -0.5),
        'b_gate_x_b': nrm(ks[19], (DEPTH, B_WIDTH), 0.01),
        'b_lambda': b_lambda,
        'c_conv_w': nrm(ks[21], (DEPTH, C_CONV, C_QKV), 0.5),
        'c_a_log': c_a_log,
        'c_dt_bias': c_dt_bias,
        'c_norm': gain(ks[24], (DEPTH, C_DV)),
        'w_br_a': nrm(ks[25], (DEPTH, A_VW, D_MODEL), A_VW ** -0.5),
        'w_br_b': nrm(ks[26], (DEPTH, B_WIDTH, D_MODEL), B_WIDTH ** -0.5),
        'w_br_c': nrm(ks[27], (DEPTH, C_VW, D_MODEL), C_VW ** -0.5),
        'w_out': nrm(ks[28], (DEPTH, D_MODEL, D_MODEL), D_MODEL ** -0.5),
        'w_up': nrm(ks[29], (DEPTH, D_MODEL, D_FF), D_MODEL ** -0.5),
        'w_down': nrm(ks[30], (DEPTH, D_FF, D_MODEL), (1.5 * D_FF) ** -0.5),
    }


def reference(x_prompt, x_sample, state_hgrn, state_rglru, state_rglru_conv, state_gdn, state_gdn_conv,
              lb_raw, norm_pre_mix, norm_post_mix, norm_pre_mlp, norm_post_mlp, w_in, a_norm,
              b_conv_w, b_conv_b, b_gate_a_w, b_gate_a_b, b_gate_x_w, b_gate_x_b, b_lambda,
              c_conv_w, c_a_log, c_dt_bias, c_norm, w_br_a, w_br_b, w_br_c, w_out, w_up, w_down):
    f32 = jnp.float32
    lb_cum = jnp.cumsum(jax.nn.softmax(lb_raw.astype(f32), axis=0), axis=0)
    lower_bounds = lb_cum - lb_cum[0:1]
    bp = x_prompt.shape[0]
    sdt = state_hgrn.dtype
    prompt_state = (jnp.zeros((bp, A_HEADS, A_DK, A_DV), sdt), jnp.zeros((bp, B_WIDTH), sdt),
                    jnp.zeros((bp, B_CONV - 1, B_WIDTH), sdt), jnp.zeros((bp, C_HEADS, C_DK, C_DV), sdt),
                    jnp.zeros((bp, C_CONV - 1, C_QKV), sdt))
    yp, ys = x_prompt, x_sample
    new_p, new_s = [], []
    for l in range(DEPTH):
        p = dict(pre_mix=norm_pre_mix[l], post_mix=norm_post_mix[l], pre_mlp=norm_pre_mlp[l],
                 post_mlp=norm_post_mlp[l], w_in=w_in[l], a_norm=a_norm[l], b_conv_w=b_conv_w[l],
                 b_conv_b=b_conv_b[l], b_gate_a_w=b_gate_a_w[l], b_gate_a_b=b_gate_a_b[l],
                 b_gate_x_w=b_gate_x_w[l], b_gate_x_b=b_gate_x_b[l], b_lambda=b_lambda[l],
                 c_conv_w=c_conv_w[l], c_a_log=c_a_log[l], c_dt_bias=c_dt_bias[l], c_norm=c_norm[l],
                 w_br_a=w_br_a[l], w_br_b=w_br_b[l], w_br_c=w_br_c[l], w_out=w_out[l],
                 w_up=w_up[l], w_down=w_down[l])
        yp, st_p = trunk_layer(yp, prompt_state, p, lower_bounds[l], True)
        new_p.append(st_p)
        st_in = (state_hgrn[l], state_rglru[l], state_rglru_conv[l], state_gdn[l], state_gdn_conv[l])
        ys, st_s = trunk_layer(ys, st_in, p, lower_bounds[l], False)
        new_s.append(st_s)
    p_hgrn, p_rglru, p_rglru_conv, p_gdn, p_gdn_conv = [jnp.stack([st[j] for st in new_p]) for j in range(5)]
    s_hgrn, s_rglru, s_rglru_conv, s_gdn, s_gdn_conv = [jnp.stack([st[j] for st in new_s]) for j in range(5)]
    return (yp, ys, p_hgrn, p_rglru, p_rglru_conv, p_gdn, p_gdn_conv,
            s_hgrn, s_rglru, s_rglru_conv, s_gdn, s_gdn_conv)
```

```cpp
#include <hip/hip_runtime.h>
#include <hip/hip_cooperative_groups.h>
#include <cstdio>
namespace cg = cooperative_groups;

#ifndef MULTI_LAUNCH
#define MULTI_LAUNCH 0
#endif

typedef unsigned short u16;
typedef __attribute__((ext_vector_type(8))) short bf16x8;
typedef __attribute__((ext_vector_type(4))) float f32x4;
typedef __attribute__((ext_vector_type(4))) unsigned int u32x4;

constexpr int D = 1024, NTOK = 18432, TP = 16384, NCHUNK = 288, DEPTH = 4, DFF = 4096;
constexpr int DIN = 8200, ZS = 8320;
constexpr int ZA_Q = 0, ZA_F = 512, ZA_I = 1024, ZA_G = 1536, ZB_X = 2048, ZB_G = 2560, ZC_Q = 3072, ZC_V = 4096,
              ZC_G = 4608, ZC_BETA = 5120, ZC_ALPHA = 5124, Z_MERGE = 5128;
constexpr float EPS = 1e-6f;

constexpr size_t O_YP = 0, O_YS = 16777216, O_PH = 18874368, O_PR = 19136512, O_PRC = 19138560, O_PG = 19144704,
                 O_PGC = 19406848, O_SH = 19425280, O_SR = 27813888, O_SRC = 27879424, O_SG = 28076032, O_SGC = 36464640;

constexpr size_t WS_Z = 0;
constexpr size_t WS_WB = WS_Z + (size_t)NTOK * ZS * 2;
constexpr size_t WB_IN = 0, WB_BR = (size_t)ZS * 1024, WB_OUT = WB_BR + 3 * 1024 * 512, WB_UP = WB_OUT + 1024 * 1024,
                 WB_DN = WB_UP + 4096 * 1024, WB_END = WB_DN + 4096 * 1024;
constexpr size_t WS_G = WS_WB + WB_END * 2;
constexpr size_t G_U = 0, G_W = (size_t)NTOK * 512, G_QP = 2 * G_W, G_KPT = 3 * G_W, G_QK = 4 * G_W, G_END = 4 * G_W + (size_t)NTOK * 256;
constexpr size_t WS_H = WS_G, WS_Y = WS_G + (size_t)NTOK * 1024 * 2;
constexpr size_t WS_HKPT = WS_G + G_END * 2;
constexpr size_t WS_HQK = WS_HKPT + (size_t)NTOK * 512 * 2;
constexpr size_t WS_HDA = WS_HQK + (size_t)NTOK * 256 * 2;
constexpr size_t WS_GGL = WS_HDA + (size_t)NCHUNK * 512 * 4;
constexpr size_t WS_RLA = WS_GGL + 8192;
constexpr size_t WS_RU = WS_RLA + (size_t)NTOK * 512 * 2;
constexpr size_t WS_RAGG = WS_RU + (size_t)NTOK * 512 * 2;
constexpr size_t WS_BAR = WS_RAGG + (size_t)NCHUNK * 512 * 8;
constexpr size_t WS_HS = WS_BAR + 16384;
constexpr size_t WS_HD = WS_HS + (size_t)15 * 4 * 16384 * 4;
constexpr size_t WS_GB = WS_HD + (size_t)15 * 4 * 128 * 4;
constexpr size_t WS_GP = WS_GB + (size_t)15 * 4 * 16384 * 4;
constexpr size_t WS_END = WS_GP + (size_t)15 * 4 * 16384 * 2;

struct Params {
  const float *x_prompt, *x_sample, *st_hgrn, *st_rglru, *st_rglru_conv, *st_gdn, *st_gdn_conv, *lb_raw, *n_pre_mix,
      *n_post_mix, *n_pre_mlp, *n_post_mlp, *w_in, *a_norm, *b_conv_w, *b_conv_b, *b_ga_w, *b_ga_b, *b_gx_w, *b_gx_b,
      *b_lambda, *c_conv_w, *c_a_log, *c_dt_bias, *c_norm, *w_br_a, *w_br_b, *w_br_c, *w_out, *w_up, *w_down;
  float* out;
  char* ws;
};

__device__ __forceinline__ u16 f2bf(float f) {
  unsigned u = __float_as_uint(f);
  u += 0x7fffu + ((u >> 16) & 1u);
  return (u16)(u >> 16);
}
__device__ __forceinline__ float bf2f(u16 h) { return __uint_as_float(((unsigned)h) << 16); }
__device__ __forceinline__ float sigm(float x) { return 1.f / (1.f + __expf(-x)); }
__device__ __forceinline__ float silu(float x) { return x * sigm(x); }
__device__ __forceinline__ float softplus(float x) { return fmaxf(x, 0.f) + __logf(1.f + __expf(-fabsf(x))); }
__device__ __forceinline__ float gelu_t(float x) {
  const float u = 1.5957691216f * (x + 0.044715f * x * x * x);
  return x * sigm(u);
}
__device__ __forceinline__ unsigned pack2(float a, float b) { return (unsigned)f2bf(a) | ((unsigned)f2bf(b) << 16); }

template <class T> __device__ __forceinline__ T* opq(T* x) { asm volatile("" : "+s"(x)); return x; }
#define OPAQUE_TID(t) int t = threadIdx.x; asm volatile("" : "+v"(t))

template <int K>
__device__ __forceinline__ f32x4 mma_lds_(int lane, const u16* a, int lda, const u16* b, int ldb, f32x4 acc) {
  const int r = lane & 15, q = lane >> 4;
  const u16* pa = a + r * lda + q * 8;
  const u16* pb = b + r * ldb + q * 8;
#pragma unroll
  for (int k = 0; k < K; k += 32) {
    bf16x8 af = *(const bf16x8*)(pa + k);
    bf16x8 bf = *(const bf16x8*)(pb + k);
    acc = __builtin_amdgcn_mfma_f32_16x16x32_bf16(af, bf, acc, 0, 0, 0);
  }
  return acc;
}

constexpr int BM = 128, BK = 64, LDT = 72;
constexpr int SMEM_BYTES = 75776;

template <int NJ>
__device__ __forceinline__ void gemm_tile(u16* smem, const u16* __restrict__ A, int lda, const u16* __restrict__ Bt,
                                          int ldb, int K, int m0, int n0, f32x4 (&acc)[4][NJ]) {
  OPAQUE_TID(tid);
  const int lane = tid & 63, wid = tid >> 6, wr = wid >> 1, wc = wid & 1, fr = lane & 15, fq = lane >> 4;
#pragma unroll
  for (int i = 0; i < 4; i++)
#pragma unroll
    for (int j = 0; j < NJ; j++) acc[i][j] = (f32x4){0.f, 0.f, 0.f, 0.f};
  const int lrow = tid >> 3, lc8 = (tid & 7) * 8;
  const u16* ga = A + (size_t)(m0 + lrow) * lda + lc8;
  const u16* gb = Bt + (size_t)(n0 + lrow) * ldb + lc8;
  u32x4 ra[4], rb[NJ];
#pragma unroll
  for (int i = 0; i < 4; i++) {
    ra[i] = *(const u32x4*)(ga + (size_t)i * 32 * lda);
    if (i < NJ) rb[i] = *(const u32x4*)(gb + (size_t)i * 32 * ldb);
  }
#pragma unroll
  for (int i = 0; i < 4; i++) {
    *(u32x4*)(smem + (lrow + i * 32) * LDT + lc8) = ra[i];
    if (i < NJ) *(u32x4*)(smem + BM * LDT + (lrow + i * 32) * LDT + lc8) = rb[i];
  }
  __syncthreads();
  const int nk = K / BK;
  for (int kt = 0; kt < nk; kt++) {
    const int cur = kt & 1;
    const bool more = (kt + 1 < nk);
    if (more) {
      ga += BK; gb += BK;
#pragma unroll
      for (int i = 0; i < 4; i++) {
        ra[i] = *(const u32x4*)(ga + (size_t)i * 32 * lda);
        if (i < NJ) rb[i] = *(const u32x4*)(gb + (size_t)i * 32 * ldb);
      }
    }
    const u16* a = smem + cur * 2 * BM * LDT + (wr * 64 + fr) * LDT + fq * 8;
    const u16* b = smem + cur * 2 * BM * LDT + BM * LDT + (wc * 16 * NJ + fr) * LDT + fq * 8;
#pragma unroll
    for (int ks = 0; ks < 2; ks++) {
      bf16x8 af[4], bf[NJ];
#pragma unroll
      for (int i = 0; i < 4; i++) {
        af[i] = *(const bf16x8*)(a + i * 16 * LDT + ks * 32);
        if (i < NJ) bf[i] = *(const bf16x8*)(b + i * 16 * LDT + ks * 32);
      }
#pragma unroll
      for (int i = 0; i < 4; i++)
#pragma unroll
        for (int j = 0; j < NJ; j++) acc[i][j] = __builtin_amdgcn_mfma_f32_16x16x32_bf16(af[i], bf[j], acc[i][j], 0, 0, 0);
    }
    if (more) {
      u16* sa = smem + (cur ^ 1) * 2 * BM * LDT;
#pragma unroll
      for (int i = 0; i < 4; i++) {
        *(u32x4*)(sa + (lrow + i * 32) * LDT + lc8) = ra[i];
        if (i < NJ) *(u32x4*)(sa + BM * LDT + (lrow + i * 32) * LDT + lc8) = rb[i];
      }
    }
    __syncthreads();
  }
}

__device__ __forceinline__ void tile_coords(int tile, int NT, int& mt, int& nt) {
  const int band = tile / (8 * NT), within = tile % (8 * NT);
  mt = band * 8 + (within & 7);
  nt = within >> 3;
}

__device__ __forceinline__ void gemm_phase(u16* smem, const u16* A, int lda, const u16* Bt, int ldb, int N, int K, u16* C, int ldc, int EPI) {
  const int NT = N / 128, MT = NTOK / 128;
  OPAQUE_TID(tid);
  const int lane = tid & 63, wid = tid >> 6, wr = wid >> 1, wc = wid & 1, fr = lane & 15, fq = lane >> 4;
  for (int tile = blockIdx.x; tile < MT * NT; tile += gridDim.x) {
    int mt, nt;
    tile_coords(tile, NT, mt, nt);
    f32x4 acc[4][4];
    gemm_tile<4>(smem, A, lda, Bt, ldb, K, mt * 128, nt * 128, acc);
#pragma unroll
    for (int i = 0; i < 4; i++)
#pragma unroll
      for (int j = 0; j < 4; j++)
#pragma unroll
        for (int e = 0; e < 4; e++) {
          const int row = mt * 128 + wr * 64 + i * 16 + fq * 4 + e, col = nt * 128 + wc * 64 + j * 16 + fr;
          float v = acc[i][j][e];
          if (EPI == 1) { v = fmaxf(v, 0.f); v = v * v; }
          C[(size_t)row * ldc + col] = f2bf(v);
        }
  }
}

constexpr int BMB = 288, LDB_ = 40, STG = (BMB + 128) * LDB_;
__device__ __forceinline__ void gemm_big_phase(u16* smem, const u16* __restrict__ A, int lda, const u16* __restrict__ Bt, int ldb,
                                               int N, int K, u16* C, int ldc, int EPI) {
  const int NT = N / 128, MT = NTOK / BMB;
  OPAQUE_TID(tid);
  const int lane = tid & 63, wid = tid >> 6, wr = wid >> 1, wc = wid & 1, fr = lane & 15, fq = lane >> 4;
  const int lrow = tid >> 2, lc8 = (tid & 3) * 8;
  const int nmc = (NT + 7) >> 3;
  const bool xcd_order = (gridDim.x == 512);
  const int nwork = xcd_order ? 8 * nmc * 64 : MT * NT;
  for (int w = blockIdx.x; w < nwork; w += gridDim.x) {
    int mt, nt;
    if (xcd_order) {
      const int q = (w >> 9) * 8 + (w & 7), slot = (w >> 3) & 63;
      mt = (q & 7) * 8 + (slot & 7); nt = (q >> 3) * 8 + (slot >> 3);
      if (nt >= NT) continue;
    } else {
      tile_coords(w, NT, mt, nt);
    }
    const int m0 = mt * BMB, n0 = nt * 128;
    f32x4 acc[9][4];
#pragma unroll
    for (int i = 0; i < 9; i++)
#pragma unroll
      for (int j = 0; j < 4; j++) acc[i][j] = (f32x4){0.f, 0.f, 0.f, 0.f};
    const u16* ga = A + (size_t)(m0 + lrow) * lda + lc8;
    const u16* gb = Bt + (size_t)(n0 + lrow) * ldb + lc8;
    u32x4 ra[5], rb[2];
#pragma unroll
    for (int i = 0; i < 4; i++) ra[i] = *(const u32x4*)(ga + (size_t)i * 64 * lda);
    if (tid < 128) ra[4] = *(const u32x4*)(ga + (size_t)256 * lda);
#pragma unroll
    for (int i = 0; i < 2; i++) rb[i] = *(const u32x4*)(gb + (size_t)i * 64 * ldb);
#pragma unroll
    for (int i = 0; i < 4; i++) *(u32x4*)(smem + (lrow + i * 64) * LDB_ + lc8) = ra[i];
    if (tid < 128) *(u32x4*)(smem + (lrow + 256) * LDB_ + lc8) = ra[4];
#pragma unroll
    for (int i = 0; i < 2; i++) *(u32x4*)(smem + (BMB + lrow + i * 64) * LDB_ + lc8) = rb[i];
    __syncthreads();
    const int nk = K / 32;
    for (int kt = 0; kt < nk; kt++) {
      const int cur = kt & 1;
      const bool more = (kt + 1 < nk);
      if (more) {
        ga += 32; gb += 32;
#pragma unroll
        for (int i = 0; i < 4; i++) ra[i] = *(const u32x4*)(ga + (size_t)i * 64 * lda);
        if (tid < 128) ra[4] = *(const u32x4*)(ga + (size_t)256 * lda);
#pragma unroll
        for (int i = 0; i < 2; i++) rb[i] = *(const u32x4*)(gb + (size_t)i * 64 * ldb);
      }
      const u16* a = smem + cur * STG + (wr * 144 + fr) * LDB_ + fq * 8;
      const u16* b = smem + cur * STG + (BMB + wc * 64 + fr) * LDB_ + fq * 8;
      bf16x8 bf[4];
#pragma unroll
      for (int j = 0; j < 4; j++) bf[j] = *(const bf16x8*)(b + j * 16 * LDB_);
#pragma unroll
      for (int i = 0; i < 9; i++) {
        const bf16x8 af = *(const bf16x8*)(a + i * 16 * LDB_);
#pragma unroll
        for (int j = 0; j < 4; j++) acc[i][j] = __builtin_amdgcn_mfma_f32_16x16x32_bf16(af, bf[j], acc[i][j], 0, 0, 0);
      }
      if (more) {
        u16* sa = smem + (cur ^ 1) * STG;
#pragma unroll
        for (int i = 0; i < 4; i++) *(u32x4*)(sa + (lrow + i * 64) * LDB_ + lc8) = ra[i];
        if (tid < 128) *(u32x4*)(sa + (lrow + 256) * LDB_ + lc8) = ra[4];
#pragma unroll
        for (int i = 0; i < 2; i++) *(u32x4*)(sa + (BMB + lrow + i * 64) * LDB_ + lc8) = rb[i];
      }
      __syncthreads();
    }
    {
      u16* scr = smem + STG + wid * 16 * 72;
#pragma unroll
      for (int i = 0; i < 9; i++) {
#pragma unroll
        for (int j = 0; j < 4; j++)
#pragma unroll
          for (int e = 0; e < 4; e++) {
            float v = acc[i][j][e];
            if (EPI == 1) { v = fmaxf(v, 0.f); v = v * v; }
            scr[(fq * 4 + e) * 72 + j * 16 + fr] = f2bf(v);
          }
#pragma unroll
        for (int h = 0; h < 2; h++) {
          const int rr = h * 8 + (lane >> 3), cc = (lane & 7) * 8;
          const u32x4 v = *(const u32x4*)(scr + rr * 72 + cc);
          *(u32x4*)(C + (size_t)(m0 + wr * 144 + i * 16 + rr) * ldc + n0 + wc * 64 + cc) = v;
        }
      }
    }
  }
}

__device__ __forceinline__ void merge_phase(u16* smem, const Params& p) {
  const u16* z = (const u16*)(p.ws + WS_Z);
  const u16* wb = (const u16*)(p.ws + WS_WB) + WB_BR;
  const u16* ru = (const u16*)(p.ws + WS_RU);
  u16* H = (u16*)(p.ws + WS_H);
  const int NT = 8, MT = NTOK / 128;
  OPAQUE_TID(tid);
  const int lane = tid & 63, wid = tid >> 6, wr = wid >> 1, wc = wid & 1, fr = lane & 15, fq = lane >> 4;
  const int lrow = tid >> 3, lc8 = (tid & 7) * 8;
  for (int tile = blockIdx.x; tile < MT * NT; tile += gridDim.x) {
    int mt, nt;
    tile_coords(tile, NT, mt, nt);
    const int m0 = mt * 128, n0 = nt * 128;
    f32x4 tot[4][4], acc[4][4];
#pragma unroll
    for (int i = 0; i < 4; i++)
#pragma unroll
      for (int j = 0; j < 4; j++) { tot[i][j] = (f32x4){0.f, 0.f, 0.f, 0.f}; acc[i][j] = tot[i][j]; }
    u32x4 ra[4], rb[4];
    unsigned gv[4][4][2];
#define MG_LOAD(it_) do { \
      const int sg_ = (it_) >> 3, kk_ = (it_) & 7; \
      const u16* A_ = (sg_ == 0) ? z + ZA_I : (sg_ == 1) ? ru : z + ZC_V; \
      const int lda_ = (sg_ == 1) ? 512 : ZS; \
      const u16* ga_ = A_ + (size_t)(m0 + lrow) * lda_ + kk_ * 64 + lc8; \
      const u16* gb_ = wb + (size_t)sg_ * 1024 * 512 + (size_t)(n0 + lrow) * 512 + kk_ * 64 + lc8; \
      _Pragma("unroll") \
      for (int i = 0; i < 4; i++) ra[i] = *(const u32x4*)(ga_ + (size_t)i * 32 * lda_); \
      _Pragma("unroll") \
      for (int i = 0; i < 4; i++) rb[i] = *(const u32x4*)(gb_ + (size_t)i * 32 * 512); \
    } while (0)
#define MG_STORE(st_) do { \
      u16* sa_ = smem + (st_) * 2 * BM * LDT; \
      _Pragma("unroll") \
      for (int i = 0; i < 4; i++) *(u32x4*)(sa_ + (lrow + i * 32) * LDT + lc8) = ra[i]; \
      _Pragma("unroll") \
      for (int i = 0; i < 4; i++) *(u32x4*)(sa_ + BM * LDT + (lrow + i * 32) * LDT + lc8) = rb[i]; \
    } while (0)
    MG_LOAD(0);
    MG_STORE(0);
    __syncthreads();
    for (int it = 0; it < 24; it++) {
      const int cur = it & 1, sg = it >> 3, kk = it & 7;
      if (kk == 0) {
#pragma unroll
        for (int i = 0; i < 4; i++)
#pragma unroll
          for (int j = 0; j < 4; j++) {
            const u16* gp = z + (size_t)(m0 + wr * 64 + i * 16 + fq * 4) * ZS + Z_MERGE + sg * 1024 + n0 + wc * 64 + j * 16 + fr;
            gv[i][j][0] = (unsigned)gp[0] | ((unsigned)gp[ZS] << 16);
            gv[i][j][1] = (unsigned)gp[2 * ZS] | ((unsigned)gp[3 * ZS] << 16);
          }
      }
      if (it + 1 < 24) MG_LOAD(it + 1);
      const u16* a = smem + cur * 2 * BM * LDT + (wr * 64 + fr) * LDT + fq * 8;
      const u16* b = smem + cur * 2 * BM * LDT + BM * LDT + (wc * 64 + fr) * LDT + fq * 8;
#pragma unroll
      for (int ks = 0; ks < 2; ks++) {
        bf16x8 af[4], bf[4];
#pragma unroll
        for (int i = 0; i < 4; i++) af[i] = *(const bf16x8*)(a + i * 16 * LDT + ks * 32);
#pragma unroll
        for (int j = 0; j < 4; j++) bf[j] = *(const bf16x8*)(b + j * 16 * LDT + ks * 32);
#pragma unroll
        for (int i = 0; i < 4; i++)
#pragma unroll
          for (int j = 0; j < 4; j++) acc[i][j] = __builtin_amdgcn_mfma_f32_16x16x32_bf16(af[i], bf[j], acc[i][j], 0, 0, 0);
      }
      if (it + 1 < 24) MG_STORE(cur ^ 1);
      if (kk == 7) {
#pragma unroll
        for (int i = 0; i < 4; i++)
#pragma unroll
          for (int j = 0; j < 4; j++) {
            tot[i][j][0] += sigm(bf2f((u16)(gv[i][j][0] & 0xffff))) * acc[i][j][0];
            tot[i][j][1] += sigm(bf2f((u16)(gv[i][j][0] >> 16))) * acc[i][j][1];
            tot[i][j][2] += sigm(bf2f((u16)(gv[i][j][1] & 0xffff))) * acc[i][j][2];
            tot[i][j][3] += sigm(bf2f((u16)(gv[i][j][1] >> 16))) * acc[i][j][3];
            acc[i][j] = (f32x4){0.f, 0.f, 0.f, 0.f};
          }
      }
      __syncthreads();
    }
#pragma unroll
    for (int i = 0; i < 4; i++)
#pragma unroll
      for (int j = 0; j < 4; j++)
#pragma unroll
        for (int e = 0; e < 4; e++) {
          const int row = m0 + wr * 64 + i * 16 + fq * 4 + e, col = n0 + wc * 64 + j * 16 + fr;
          H[(size_t)row * 1024 + col] = f2bf(tot[i][j][e]);
        }
  }
}

__device__ __forceinline__ void merge_big_phase(u16* smem, const Params& p) {
  const u16* z = (const u16*)(p.ws + WS_Z);
  const u16* wb = (const u16*)(p.ws + WS_WB) + WB_BR;
  const u16* ru = (const u16*)(p.ws + WS_RU);
  u16* H = (u16*)(p.ws + WS_H);
  const int NT = 8, MT = NTOK / BMB;
  OPAQUE_TID(tid);
  const int lane = tid & 63, wid = tid >> 6, wr = wid >> 1, wc = wid & 1, fr = lane & 15, fq = lane >> 4;
  const int lrow = tid >> 2, lc8 = (tid & 3) * 8;
  for (int tile = blockIdx.x; tile < MT * NT; tile += gridDim.x) {
    int mt, nt;
    tile_coords(tile, NT, mt, nt);
    const int m0 = mt * BMB, n0 = nt * 128;
    f32x4 acc[9][4];
#pragma unroll
    for (int i = 0; i < 9; i++)
#pragma unroll
      for (int j = 0; j < 4; j++) acc[i][j] = (f32x4){0.f, 0.f, 0.f, 0.f};
    u32x4 ra[5], rb[2];
#define MB_LOAD() do { \
      _Pragma("unroll") \
      for (int i = 0; i < 4; i++) ra[i] = *(const u32x4*)(ga + (size_t)i * 64 * lda); \
      if (tid < 128) ra[4] = *(const u32x4*)(ga + (size_t)256 * lda); \
      _Pragma("unroll") \
      for (int i = 0; i < 2; i++) rb[i] = *(const u32x4*)(gb + (size_t)i * 64 * 512); \
    } while (0)
#define MB_STORE(stg_) do { \
      u16* sa_ = smem + (stg_) * STG; \
      _Pragma("unroll") \
      for (int i = 0; i < 4; i++) *(u32x4*)(sa_ + (lrow + i * 64) * LDB_ + lc8) = ra[i]; \
      if (tid < 128) *(u32x4*)(sa_ + (lrow + 256) * LDB_ + lc8) = ra[4]; \
      _Pragma("unroll") \
      for (int i = 0; i < 2; i++) *(u32x4*)(sa_ + (BMB + lrow + i * 64) * LDB_ + lc8) = rb[i]; \
    } while (0)
#define MB_GSTRIP_LOAD(G_, i_) do { \
        int t_ = tid; asm volatile("" : "+v"(t_)); \
        const int ln_ = t_ & 63, wd_ = t_ >> 6; \
        _Pragma("unroll") \
        for (int h = 0; h < 2; h++) { \
          const int rr = h * 8 + (ln_ >> 3), cc = (ln_ & 7) * 8; \
          nv[h] = *(const u32x4*)(z + (size_t)(m0 + (wd_ >> 1) * 144 + (i_) * 16 + rr) * ZS + Z_MERGE + (G_) * 1024 + n0 + (wd_ & 1) * 64 + cc); \
        } \
      } while (0)
#define MB_GATE(G_, INV) do { \
      u32x4 nv[2]; \
      MB_GSTRIP_LOAD(G_, 0); \
      _Pragma("unroll") \
      for (int i = 0; i < 9; i++) { \
        int t_ = tid; asm volatile("" : "+v"(t_));     \
        const int ln_ = t_ & 63, wd_ = t_ >> 6, fr_ = ln_ & 15, fq_ = ln_ >> 4; \
        u16* scr_ = smem + 2 * STG + wd_ * 16 * 72; \
        _Pragma("unroll") \
        for (int h = 0; h < 2; h++) { \
          const int rr = h * 8 + (ln_ >> 3), cc = (ln_ & 7) * 8; \
          *(u32x4*)(scr_ + rr * 72 + cc) = nv[h]; \
        } \
        if (i + 1 < 9) MB_GSTRIP_LOAD(G_, i + 1);     \
        _Pragma("unroll") \
        for (int j = 0; j < 4; j++) \
        _Pragma("unroll") \
          for (int e = 0; e < 4; e++) { \
            const float x_ = 1.f + __expf(-bf2f(scr_[(fq_ * 4 + e) * 72 + j * 16 + fr_])); \
            acc[i][j][e] *= (INV) ? x_ : __frcp_rn(x_); \
          } \
      } \
    } while (0)
    int lda = ZS;
    const u16* ga = z + ZA_I + (size_t)(m0 + lrow) * ZS + lc8;
    const u16* gb = wb + (size_t)(n0 + lrow) * 512 + lc8;
    MB_LOAD();
    MB_STORE(0);
    __syncthreads();
#pragma unroll 1
    for (int it = 0; it < 48; it++) {
      const int cur = it & 1;
      const bool more = (it + 1 < 48);
      if (more) {
        if (((it + 1) & 15) == 0) {
          const int sg_ = (it + 1) >> 4;
          lda = (sg_ == 1) ? 512 : ZS;
          ga = ((sg_ == 1) ? ru : z + ZC_V) + (size_t)(m0 + lrow) * lda + lc8;
          gb = wb + (size_t)sg_ * 1024 * 512 + (size_t)(n0 + lrow) * 512 + lc8;
        } else {
          ga += 32; gb += 32;
        }
        MB_LOAD();
      }
      const u16* a = smem + cur * STG + (wr * 144 + fr) * LDB_ + fq * 8;
      const u16* b = smem + cur * STG + (BMB + wc * 64 + fr) * LDB_ + fq * 8;
      bf16x8 bf[4];
#pragma unroll
      for (int j = 0; j < 4; j++) bf[j] = *(const bf16x8*)(b + j * 16 * LDB_);
#pragma unroll
      for (int i = 0; i < 9; i++) {
        const bf16x8 af = *(const bf16x8*)(a + i * 16 * LDB_);
#pragma unroll
        for (int j = 0; j < 4; j++) acc[i][j] = __builtin_amdgcn_mfma_f32_16x16x32_bf16(af, bf[j], acc[i][j], 0, 0, 0);
      }
      if (more) MB_STORE(cur ^ 1);
      if ((it & 15) == 15) {
        const int sg = it >> 4, napply = (sg < 2) ? 2 : 1;
#pragma unroll 1
        for (int q = 0; q < napply; q++) { MB_GATE(sg + q, q); }
      }
      __syncthreads();
    }
    {
#pragma unroll
      for (int i = 0; i < 9; i++) {
        int t_ = tid; asm volatile("" : "+v"(t_));
        const int ln_ = t_ & 63, wd_ = t_ >> 6, fr_ = ln_ & 15, fq_ = ln_ >> 4;
        u16* scr_ = smem + 2 * STG + wd_ * 16 * 72;
#pragma unroll
        for (int j = 0; j < 4; j++)
#pragma unroll
          for (int e = 0; e < 4; e++) scr_[(fq_ * 4 + e) * 72 + j * 16 + fr_] = f2bf(acc[i][j][e]);
#pragma unroll
        for (int h = 0; h < 2; h++) {
          const int rr = h * 8 + (ln_ >> 3), cc = (ln_ & 7) * 8;
          const u32x4 v = *(const u32x4*)(scr_ + rr * 72 + cc);
          *(u32x4*)(H + (size_t)(m0 + (wd_ >> 1) * 144 + i * 16 + rr) * 1024 + n0 + (wd_ & 1) * 64 + cc) = v;
        }
      }
    }
  }
}

__device__ __forceinline__ void conv_w_tile(float* sm, const float* __restrict__ W, int K, int N, u16* Wt, int kt, int nt) {
  OPAQUE_TID(tid);
  const int lane = tid & 63, wid = tid >> 6;
  const int n = nt * 64 + lane;
#pragma unroll
  for (int i = 0; i < 16; i++) {
    const int k = wid * 16 + i;
    sm[lane * 65 + k] = (n < N) ? W[(size_t)(kt * 64 + k) * N + n] : 0.f;
  }
  __syncthreads();
  const int nn = tid >> 2, ks = (tid & 3) * 16;
  const float* s = sm + nn * 65 + ks;
  uint4 o0, o1;
  o0.x = pack2(s[0], s[1]); o0.y = pack2(s[2], s[3]); o0.z = pack2(s[4], s[5]); o0.w = pack2(s[6], s[7]);
  o1.x = pack2(s[8], s[9]); o1.y = pack2(s[10], s[11]); o1.z = pack2(s[12], s[13]); o1.w = pack2(s[14], s[15]);
  u16* dst = Wt + (size_t)(nt * 64 + nn) * K + kt * 64 + ks;
  *(uint4*)dst = o0;
  *(uint4*)(dst + 8) = o1;
  __syncthreads();
}

__device__ __forceinline__ void wconv_phase(u16* smem, const Params& p, int l) {
  float* sm = (float*)smem;
  u16* wb = (u16*)(p.ws + WS_WB);
  const int total = 2080 + 384 + 256 + 1024 + 1024;
  for (int t = blockIdx.x; t < total; t += gridDim.x) {
    const float* src; u16* dst; int K, N, kt, nt;
    if (t < 2080) {
      src = opq(p.w_in) + (size_t)l * 1024 * DIN; K = 1024; N = DIN; dst = wb + WB_IN; kt = t / 130; nt = t % 130;
    } else if (t < 2080 + 384) {
      const int u = t - 2080, br = u / 128, v = u % 128;
      src = (br == 0 ? opq(p.w_br_a) : br == 1 ? opq(p.w_br_b) : opq(p.w_br_c)) + (size_t)l * 512 * 1024;
      K = 512; N = 1024; dst = wb + WB_BR + (size_t)br * 1024 * 512; kt = v / 16; nt = v % 16;
    } else if (t < 2080 + 384 + 256) {
      const int u = t - 2464;
      src = opq(p.w_out) + (size_t)l * 1024 * 1024; K = 1024; N = 1024; dst = wb + WB_OUT; kt = u / 16; nt = u % 16;
    } else if (t < 2080 + 384 + 256 + 1024) {
      const int u = t - 2720;
      src = opq(p.w_up) + (size_t)l * 1024 * 4096; K = 1024; N = 4096; dst = wb + WB_UP; kt = u / 64; nt = u % 64;
    } else {
      const int u = t - 3744;
      src = opq(p.w_down) + (size_t)l * 4096 * 1024; K = 4096; N = 1024; dst = wb + WB_DN; kt = u / 16; nt = u % 16;
    }
    conv_w_tile(sm, src, K, N, dst, kt, nt);
  }
}

__device__ __forceinline__ float wave_sum(float v) {
#pragma unroll
  for (int o = 32; o >= 1; o >>= 1) v += __shfl_xor(v, o);
  return v;
}

__device__ __forceinline__ void rowpass_phase(const Params& p, bool from_input, const u16* Y, const float* postw, const float* prew, u16* H) {
  OPAQUE_TID(tid);
  const int lane = tid & 63, wid = tid >> 6;
  const float* xpr = opq(p.x_prompt); const float* xsa = opq(p.x_sample); const float* xo = opq((const float*)p.out);
  const int stride = gridDim.x * 4;
  for (int row0 = blockIdx.x * 4 + wid; row0 < NTOK; row0 += 3 * stride) {
    float xv[3][16], yv[3][16];
#pragma unroll
    for (int k = 0; k < 3; k++) {
      const int row = min(row0 + k * stride, NTOK - 1);
      const float* xin = from_input ? (row < TP ? xpr + (size_t)row * D : xsa + (size_t)(row - TP) * D) : xo + (size_t)row * D;
#pragma unroll
      for (int i = 0; i < 4; i++) {
        const float4 v = *(const float4*)(xin + lane * 4 + i * 256);
        xv[k][i * 4] = v.x; xv[k][i * 4 + 1] = v.y; xv[k][i * 4 + 2] = v.z; xv[k][i * 4 + 3] = v.w;
      }
      if (Y) {
#pragma unroll
        for (int i = 0; i < 4; i++) {
          const uint2 v = *(const uint2*)(Y + (size_t)row * D + lane * 4 + i * 256);
          yv[k][i * 4] = bf2f((u16)(v.x & 0xffff)); yv[k][i * 4 + 1] = bf2f((u16)(v.x >> 16));
          yv[k][i * 4 + 2] = bf2f((u16)(v.y & 0xffff)); yv[k][i * 4 + 3] = bf2f((u16)(v.y >> 16));
        }
      }
    }
#pragma unroll
    for (int k = 0; k < 3; k++) {
      const int row = row0 + k * stride;
      if (row < NTOK) {
        if (Y) {
          float ss = 0.f;
#pragma unroll
          for (int i = 0; i < 16; i++) ss += yv[k][i] * yv[k][i];
          ss = wave_sum(ss);
          const float r = rsqrtf(ss * (1.f / D) + EPS);
#pragma unroll
          for (int i = 0; i < 4; i++) {
            const float4 w = *(const float4*)(postw + lane * 4 + i * 256);
            xv[k][i * 4] += yv[k][i * 4] * r * w.x; xv[k][i * 4 + 1] += yv[k][i * 4 + 1] * r * w.y;
            xv[k][i * 4 + 2] += yv[k][i * 4 + 2] * r * w.z; xv[k][i * 4 + 3] += yv[k][i * 4 + 3] * r * w.w;
          }
        }
        if (Y || from_input) {
#pragma unroll
          for (int i = 0; i < 4; i++)
            *(float4*)(p.out + (size_t)row * D + lane * 4 + i * 256) =
                make_float4(xv[k][i * 4], xv[k][i * 4 + 1], xv[k][i * 4 + 2], xv[k][i * 4 + 3]);
        }
        if (prew) {
          float ss = 0.f;
#pragma unroll
          for (int i = 0; i < 16; i++) ss += xv[k][i] * xv[k][i];
          ss = wave_sum(ss);
          const float r = rsqrtf(ss * (1.f / D) + EPS);
#pragma unroll
          for (int i = 0; i < 4; i++) {
            const float4 w = *(const float4*)(prew + lane * 4 + i * 256);
            uint2 o;
            o.x = pack2(xv[k][i * 4] * r * w.x, xv[k][i * 4 + 1] * r * w.y);
            o.y = pack2(xv[k][i * 4 + 2] * r * w.z, xv[k][i * 4 + 3] * r * w.w);
            *(uint2*)(H + (size_t)row * D + lane * 4 + i * 256) = o;
          }
        }
      }
    }
  }
}

__device__ __forceinline__ void hgrn_prep(u16* smem, const Params& p, int l, int c, int hd) {
  u16* z = (u16*)(p.ws + WS_Z);
  u16* sq = smem;
  u16* skt = smem + 64 * 136;
  u16* skh = smem + 2 * 64 * 136;
  float* sd = (float*)(smem + 3 * 64 * 136);
  OPAQUE_TID(tid);
  const int lane = tid & 63, wid = tid >> 6, fr = lane & 15, fq = lane >> 4;
  const int tok0 = c * 64;
  {
    const int hb = tid >> 7, ch = tid & 127, col = hd * 128 + ch;
    float lbv = 0.f;
    if (l > 0) {
      const float r0 = p.lb_raw[col], r1 = p.lb_raw[512 + col], r2 = p.lb_raw[1024 + col], r3 = p.lb_raw[1536 + col];
      const float m = fmaxf(fmaxf(r0, r1), fmaxf(r2, r3));
      const float e0 = __expf(r0 - m), e1 = __expf(r1 - m), e2 = __expf(r2 - m), e3 = __expf(r3 - m);
      const float inv = 1.f / (e0 + e1 + e2 + e3);
      lbv = e1 * inv;
      if (l > 1) lbv += e2 * inv;
      if (l > 2) lbv += e3 * inv;
    }
    {
      u32x4 rq[4], rf[4];
#pragma unroll
      for (int i = 0; i < 4; i++) {
        const int idx = tid + i * 256, row = idx >> 4, c8 = (idx & 15) * 8;
        rq[i] = *(const u32x4*)(z + (size_t)(tok0 + row) * ZS + ZA_Q + hd * 128 + c8);
        rf[i] = *(const u32x4*)(z + (size_t)(tok0 + row) * ZS + ZA_F + hd * 128 + c8);
      }
#pragma unroll
      for (int i = 0; i < 4; i++) {
        const int idx = tid + i * 256, row = idx >> 4, c8 = (idx & 15) * 8;
        *(u32x4*)(sq + row * 136 + c8) = rq[i];
        *(u32x4*)(skt + row * 136 + c8) = rf[i];
      }
    }
    __syncthreads();
    float bb[32];
    float run = 0.f;
#pragma unroll
    for (int t = 0; t < 32; t++) {
      const float zf = bf2f(skt[(hb * 32 + t) * 136 + ch]);
      const float f = lbv + (1.f - lbv) * sigm(zf);
      const float logf = (lbv > 0.f) ? __logf(f) : (fminf(zf, 0.f) - __logf(1.f + __expf(-fabsf(zf))));
      run += logf;
      bb[t] = run;
    }
    const float blast = run;
#pragma unroll
    for (int t = 0; t < 32; t++) {
      const int o = (hb * 32 + t) * 136 + ch;
      const float zq = bf2f(sq[o]), zf = bf2f(skt[o]);
      const float qv = silu(zq), kv = (1.f - lbv) * sigm(-zf);
      sq[o] = f2bf(qv * __expf(bb[t]));
      skt[o] = f2bf(kv * __expf(fminf(-bb[t], 80.f)));
      skh[o] = f2bf(kv * __expf(blast - bb[t]));
    }
    sd[hb * 128 + ch] = __expf(blast);
  }
  __syncthreads();
  {
    u16* qk = (u16*)(p.ws + WS_HQK);
    const int ti = wid;
    for (int si = 0; si < 4; si++) {
      f32x4 acc = (f32x4){0.f, 0.f, 0.f, 0.f};
      const bool upper = (ti < 2 && si >= 2);
      const bool cross = (ti >= 2 && si < 2);
      if (!upper && !((ti >> 1) == (si >> 1) && si > ti))
        acc = mma_lds_<128>(lane, sq + ti * 16 * 136, 136, (cross ? skh : skt) + si * 16 * 136, 136, acc);
#pragma unroll
      for (int e = 0; e < 4; e++) {
        const int t = ti * 16 + fq * 4 + e, s = si * 16 + fr;
        float v = acc[e];
        if (!cross && s > t) v = 0.f;
        qk[(size_t)(tok0 + t) * 256 + hd * 64 + s] = f2bf(v);
      }
    }
  }
  {
#pragma unroll 4
    for (int i = 0; i < 32; i++) {
      const int e = tid + i * 256, t = e >> 7, ch = e & 127;
      float v = bf2f(sq[t * 136 + ch]);
      if (t >= 32) v *= sd[ch];
      z[(size_t)(tok0 + t) * ZS + ZA_Q + hd * 128 + ch] = f2bf(v);
    }
    u16* kpt = (u16*)(p.ws + WS_HKPT) + (size_t)(c * 4 + hd) * 128 * 64;
#pragma unroll 4
    for (int i = 0; i < 32; i++) {
      const int e = tid + i * 256, dk = e >> 6, t = e & 63;
      float v = bf2f(skh[t * 136 + dk]);
      if (t < 32) v *= sd[128 + dk];
      kpt[dk * 64 + t] = f2bf(v);
    }
    if (tid < 128) ((float*)(p.ws + WS_HDA))[c * 512 + hd * 128 + tid] = sd[tid] * sd[128 + tid];
  }
  __syncthreads();
}

__device__ __forceinline__ void gdn_prep(u16* smem, const Params& p, int l, int c, int hd) {
  const u16* z = (const u16*)(p.ws + WS_Z);
  u16* sq = smem;
  u16* sk = smem + 64 * 136;
  u16* sv = smem + 2 * 64 * 136;
  float* sAm = (float*)(smem + 3 * 64 * 136);
  float* sgc = sAm + 64 * 68;
  float* sbeta = sgc + 64;
  OPAQUE_TID(tid);
  const int lane = tid & 63, wid = tid >> 6, fr = lane & 15, fq = lane >> 4;
  const int tok0 = c * 64;
  const bool first = (c == 0) || (c >= 256);
  const int sb = c - 256;
  u16* sraw = (u16*)sAm;
  u32x4 rraw[3][5];
#pragma unroll
  for (int part = 0; part < 3; part++)
#pragma unroll
    for (int i = 0; i < 5; i++) {
      const int idx = tid + i * 256, row = idx >> 4, c8 = (idx & 15) * 8, rr = row - 3;
      const int colq = part * 512 + hd * 128 + c8;
      u32x4 v = (u32x4){0u, 0u, 0u, 0u};
      if (idx < 67 * 16) {
        if (rr >= 0 || !first) {
          v = *(const u32x4*)(z + (size_t)(tok0 + rr) * ZS + ZC_Q + colq);
        } else if (c >= 256) {
          const float* st = p.st_gdn_conv + ((size_t)(l * 32 + sb) * 3 + row) * 1536 + colq;
          const float4 f0 = *(const float4*)st, f1 = *(const float4*)(st + 4);
          v = (u32x4){pack2(f0.x, f0.y), pack2(f0.z, f0.w), pack2(f1.x, f1.y), pack2(f1.z, f1.w)};
        }
      }
      rraw[part][i] = v;
    }
#pragma unroll
  for (int part = 0; part < 3; part++) {
    if (part > 0) __syncthreads();
#pragma unroll
    for (int i = 0; i < 5; i++) {
      const int idx = tid + i * 256, row = idx >> 4, c8 = (idx & 15) * 8;
      if (idx < 67 * 16) *(u32x4*)(sraw + row * 136 + c8) = rraw[part][i];
    }
    __syncthreads();
    {
      const int cc = tid & 127, half = tid >> 7, colq = part * 512 + hd * 128 + cc;
      const float* cw = p.c_conv_w + (size_t)l * 4 * 1536 + colq;
      const float w0 = cw[0], w1 = cw[1536], w2 = cw[2 * 1536], w3 = cw[3 * 1536];
      const u16* src = sraw + (half * 32) * 136 + cc;
      u16* dst = smem + part * 64 * 136 + (half * 32) * 136 + cc;
      float x0 = bf2f(src[0]), x1 = bf2f(src[136]), x2 = bf2f(src[2 * 136]);
#pragma unroll 8
      for (int t = 0; t < 32; t++) {
        const float x3 = bf2f(src[(t + 3) * 136]);
        const float y = w0 * x0 + w1 * x1 + w2 * x2 + w3 * x3;
        dst[t * 136] = f2bf(silu(y));
        x0 = x1; x1 = x2; x2 = x3;
      }
      if ((c == 255 || c >= 256) && half == 0) {
        float* dsto = (c == 255) ? p.out + O_PGC + (size_t)l * 3 * 1536 : p.out + O_SGC + (size_t)(l * 32 + sb) * 3 * 1536;
#pragma unroll
        for (int j = 0; j < 3; j++) dsto[j * 1536 + colq] = bf2f(sraw[(64 + j) * 136 + cc]);
      }
    }
  }
  __syncthreads();
  {
    const int t = tid >> 2, qd = tid & 3;
#pragma unroll
    for (int part = 0; part < 2; part++) {
      u16* r = smem + part * 64 * 136 + t * 136 + qd * 32;
      float ss = 0.f;
#pragma unroll
      for (int i = 0; i < 32; i++) { const float v = bf2f(r[i]); ss += v * v; }
      ss += __shfl_xor(ss, 1);
      ss += __shfl_xor(ss, 2);
      const float sc = rsqrtf(ss + EPS) * (part == 0 ? 0.08838834764831845f : 1.f);
#pragma unroll
      for (int i = 0; i < 32; i++) r[i] = f2bf(bf2f(r[i]) * sc);
    }
  }
  if (tid < 64) {
    const float beta = sigm(bf2f(z[(size_t)(tok0 + tid) * ZS + ZC_BETA + hd]));
    const float al = bf2f(z[(size_t)(tok0 + tid) * ZS + ZC_ALPHA + hd]);
    float g = -__expf(p.c_a_log[l * 4 + hd]) * softplus(al + p.c_dt_bias[l * 4 + hd]);
#pragma unroll
    for (int o = 1; o < 64; o <<= 1) {
      const float v = __shfl_up(g, o);
      if (lane >= o) g += v;
    }
    sgc[tid] = g;
    sbeta[tid] = beta;
  }
  __syncthreads();
  {
    u16* gqk = (u16*)(p.ws + WS_G) + G_QK;
    const int ti = wid;
    for (int si = 0; si < 4; si++) {
      f32x4 a1 = (f32x4){0.f, 0.f, 0.f, 0.f}, a2 = (f32x4){0.f, 0.f, 0.f, 0.f};
      if (si <= ti) {
        a1 = mma_lds_<128>(lane, sk + ti * 16 * 136, 136, sk + si * 16 * 136, 136, a1);
        a2 = mma_lds_<128>(lane, sq + ti * 16 * 136, 136, sk + si * 16 * 136, 136, a2);
      }
#pragma unroll
      for (int e = 0; e < 4; e++) {
        const int t = ti * 16 + fq * 4 + e, s = si * 16 + fr;
        const float dec = (s <= t) ? __expf(sgc[t] - sgc[s]) : 0.f;
        sAm[s * 68 + t] = (s < t) ? sbeta[t] * a1[e] * dec : 0.f;
        gqk[(size_t)(tok0 + t) * 256 + hd * 64 + s] = f2bf((s <= t) ? a2[e] * dec : 0.f);
      }
    }
  }
  __syncthreads();
  {
    const int col = tid & 127, isw = tid >> 7;
    const u16* src = isw ? sk : sv;
    u16* dst = (u16*)(p.ws + WS_G) + (isw ? G_W : G_U) + (size_t)tok0 * 512 + hd * 128 + col;
    float r[64];
#pragma unroll
    for (int t = 0; t < 64; t++) {
      float a = bf2f(src[t * 136 + col]) * sbeta[t];
      if (isw) a *= __expf(sgc[t]);
      r[t] = a;
    }
#pragma unroll
    for (int j = 0; j < 64; j++) {
      const float xj = r[j];
      *dst = f2bf(xj);
      dst += 512;
#pragma unroll
      for (int g = (j + 1) / 4; g < 16; g++) {
        const float4 a4 = *(const float4*)(sAm + j * 68 + g * 4);
        if (g * 4 > j) r[g * 4] -= a4.x * xj;
        if (g * 4 + 1 > j) r[g * 4 + 1] -= a4.y * xj;
        if (g * 4 + 2 > j) r[g * 4 + 2] -= a4.z * xj;
        if (g * 4 + 3 > j) r[g * 4 + 3] -= a4.w * xj;
      }
    }
  }
  {
    u16* gqp = (u16*)(p.ws + WS_G) + G_QP;
    const float gl = sgc[63];
#pragma unroll 4
    for (int i = 0; i < 32; i++) {
      const int e = tid + i * 256, t = e >> 7, cc = e & 127;
      gqp[(size_t)(tok0 + t) * 512 + hd * 128 + cc] = f2bf(bf2f(sq[t * 136 + cc]) * __expf(sgc[t]));
    }
    u16* kpt = (u16*)(p.ws + WS_G) + G_KPT + (size_t)(c * 4 + hd) * 128 * 64;
#pragma unroll 4
    for (int i = 0; i < 32; i++) {
      const int e = tid + i * 256, dk = e >> 6, t = e & 63;
      kpt[dk * 64 + t] = f2bf(bf2f(sk[t * 136 + dk]) * __expf(gl - sgc[t]));
    }
    if (tid == 0) ((float*)(p.ws + WS_GGL))[c * 4 + hd] = __expf(gl);
  }
  __syncthreads();
}

__device__ __forceinline__ void rglru_prep(u16* smem, const Params& p, int l, int c, int n) {
  const u16* z = (const u16*)(p.ws + WS_Z);
  float* sx = (float*)smem;
  float* su = sx + 64 * 65;
  u16* sxb = (u16*)(su + 64 * 65);
  u16* swa = sxb + 64 * 72;
  u16* swx = swa + 64 * 72;
  OPAQUE_TID(tid);
  const int lane = tid & 63, wid = tid >> 6, fr = lane & 15, fq = lane >> 4;
  const int tok0 = c * 64;
  const bool first = (c == 0) || (c >= 256);
  const int sb = c - 256;
  {
    const int ch = tid & 63, tq = tid >> 6, col = n * 64 + ch;
    const float* cw = p.b_conv_w + (size_t)l * 4 * 512 + col;
    const float w0 = cw[0], w1 = cw[512], w2 = cw[1024], w3 = cw[1536], bias = p.b_conv_b[l * 512 + col];
    u16* sraw = swx + 64 * 72;
    float gwa[16], gwx[16];
    {
      const float* wa = p.b_ga_w + ((size_t)l * 8 + n) * 4096;
      const float* wx = p.b_gx_w + ((size_t)l * 8 + n) * 4096;
#pragma unroll
      for (int i = 0; i < 16; i++) { gwa[i] = wa[tid + i * 256]; gwx[i] = wx[tid + i * 256]; }
    }
    {
      u32x4 rr4[3];
#pragma unroll
      for (int i = 0; i < 3; i++) {
        const int idx = tid + i * 256, row = idx >> 3, c8 = (idx & 7) * 8, rr = row - 3;
        u32x4 v = (u32x4){0u, 0u, 0u, 0u};
        if (idx < 67 * 8) {
          if (rr >= 0 || !first) {
            v = *(const u32x4*)(z + (size_t)(tok0 + rr) * ZS + ZB_X + n * 64 + c8);
          } else if (c >= 256) {
            const float* st = p.st_rglru_conv + ((size_t)(l * 32 + sb) * 3 + row) * 512 + n * 64 + c8;
            const float4 f0 = *(const float4*)st, f1 = *(const float4*)(st + 4);
            v = (u32x4){pack2(f0.x, f0.y), pack2(f0.z, f0.w), pack2(f1.x, f1.y), pack2(f1.z, f1.w)};
          }
        }
        rr4[i] = v;
      }
#pragma unroll
      for (int i = 0; i < 3; i++) {
        const int idx = tid + i * 256, row = idx >> 3, c8 = (idx & 7) * 8;
        if (idx < 67 * 8) *(u32x4*)(sraw + row * 72 + c8) = rr4[i];
      }
    }
    __syncthreads();
    {
      const u16* src = sraw + (tq * 16) * 72 + ch;
      float x0 = bf2f(src[0]), x1 = bf2f(src[72]), x2 = bf2f(src[2 * 72]);
#pragma unroll 8
      for (int i = 0; i < 16; i++) {
        const int t = tq * 16 + i;
        const float x3 = bf2f(src[(i + 3) * 72]);
        const float y = w0 * x0 + w1 * x1 + w2 * x2 + w3 * x3 + bias;
        sx[t * 65 + ch] = y;
        sxb[t * 72 + ch] = f2bf(y);
        x0 = x1; x1 = x2; x2 = x3;
      }
    }
#pragma unroll
    for (int i = 0; i < 16; i++) {
      const int e = tid + i * 256, cin = e >> 6, d = e & 63;
      swa[d * 72 + cin] = f2bf(gwa[i]);
      swx[d * 72 + cin] = f2bf(gwx[i]);
    }
    if (c == 255 || c >= 256) {
      float* dst = (c == 255) ? p.out + O_PRC + (size_t)l * 3 * 512 : p.out + O_SRC + (size_t)(l * 32 + sb) * 3 * 512;
      if (tid < 192) {
        const int j = tid >> 6;
        dst[j * 512 + col] = bf2f(sraw[(64 + j) * 72 + ch]);
      }
    }
  }
  __syncthreads();
  f32x4 ra[4], rx[4];
  {
    const int ti = wid;
#pragma unroll
    for (int si = 0; si < 4; si++) {
      ra[si] = mma_lds_<64>(lane, sxb + ti * 16 * 72, 72, swa + si * 16 * 72, 72, (f32x4){0.f, 0.f, 0.f, 0.f});
      rx[si] = mma_lds_<64>(lane, sxb + ti * 16 * 72, 72, swx + si * 16 * 72, 72, (f32x4){0.f, 0.f, 0.f, 0.f});
    }
  }
  float lav[4][4], uv[4][4];
  {
    const int ti = wid;
#pragma unroll
    for (int si = 0; si < 4; si++) {
      const int d = si * 16 + fr, col = n * 64 + d;
      const float ba = p.b_ga_b[l * 512 + col], bx = p.b_gx_b[l * 512 + col];
      const float sp = softplus(-p.b_lambda[l * 512 + col]);
#pragma unroll
      for (int e = 0; e < 4; e++) {
        const int t = ti * 16 + fq * 4 + e;
        const float r = sigm(ra[si][e] + ba), ig = sigm(rx[si][e] + bx);
        const float la = -8.f * r * sp;
        float mult = sqrtf(fmaxf(1.f - __expf(2.f * la), 0.f));
        if (c == 0 && t == 0) mult = 1.f;
        const float u = mult * ig * sx[t * 65 + d];
        lav[si][e] = bf2f(f2bf(la));
        uv[si][e] = bf2f(f2bf(u));
      }
    }
  }
  __syncthreads();
  {
    const int ti = wid;
    u16* rla = (u16*)(p.ws + WS_RLA);
    u16* ru = (u16*)(p.ws + WS_RU);
#pragma unroll
    for (int si = 0; si < 4; si++) {
      const int d = si * 16 + fr, col = n * 64 + d;
#pragma unroll
      for (int e = 0; e < 4; e++) {
        const int t = ti * 16 + fq * 4 + e;
        sx[t * 65 + d] = lav[si][e];
        su[t * 65 + d] = uv[si][e];
        rla[(size_t)(tok0 + t) * 512 + col] = f2bf(lav[si][e]);
        ru[(size_t)(tok0 + t) * 512 + col] = f2bf(uv[si][e]);
      }
    }
  }
  __syncthreads();
  if (tid < 64) {
    float h = 0.f, sl = 0.f;
    for (int t = 0; t < 64; t++) {
      const float la = sx[t * 65 + tid];
      h = __expf(la) * h + su[t * 65 + tid];
      sl += la;
    }
    float* agg = (float*)(p.ws + WS_RAGG) + ((size_t)c * 512 + n * 64 + tid) * 2;
    agg[0] = sl;
    agg[1] = h;
  }
  __syncthreads();
}

__device__ __forceinline__ void rglru_scan(const Params& p, int l, int c, int hf) {
  OPAQUE_TID(tid);
  const int col = hf * 256 + tid;
  const int tok0 = c * 64;
  float h = 0.f;
  if (c >= 256) {
    h = p.st_rglru[(size_t)(l * 32 + (c - 256)) * 512 + col];
  } else {
    const float* agg = (const float*)(p.ws + WS_RAGG) + (size_t)col * 2;
    for (int cc = 0; cc < c; cc += 16) {
      float2 ab[16];
#pragma unroll
      for (int i = 0; i < 16; i++) ab[i] = *(const float2*)(agg + (size_t)min(cc + i, c - 1) * 1024);
#pragma unroll
      for (int i = 0; i < 16; i++) if (cc + i < c) h = __expf(ab[i].x) * h + ab[i].y;
    }
  }
  const u16* rla = (const u16*)(p.ws + WS_RLA) + (size_t)tok0 * 512 + col;
  u16* ru = (u16*)(p.ws + WS_RU) + (size_t)tok0 * 512 + col;
  for (int t0 = 0; t0 < 64; t0 += 32) {
    float la[32], u[32];
#pragma unroll
    for (int i = 0; i < 32; i++) { la[i] = bf2f(rla[(size_t)(t0 + i) * 512]); u[i] = bf2f(ru[(size_t)(t0 + i) * 512]); }
#pragma unroll
    for (int i = 0; i < 32; i++) {
      h = __expf(la[i]) * h + u[i];
      ru[(size_t)(t0 + i) * 512] = f2bf(h);
    }
  }
  if (c == 255) p.out[O_PR + (size_t)l * 512 + col] = h;
  else if (c >= 256) p.out[O_SR + (size_t)(l * 32 + (c - 256)) * 512 + col] = h;
}

template <bool GDN>
__device__ __forceinline__ void mat_scan(u16* smem, const Params& p, int l, int kind, int seg, int seq, int hd, int sl) {
  u16* z = (u16*)(p.ws + WS_Z);
  u16* sW = smem;
  u16* sQP = smem + 64 * 136;
  u16* sKT = smem + 2 * 64 * 136;
  u16* sQK = sKT + 128 * 72;
  u16* sSt = sQK + 64 * 72;
  u16* sVt = sSt + 32 * 136;
  OPAQUE_TID(tid);
  const int lane = tid & 63, wid = tid >> 6, fr = lane & 15, fq = lane >> 4;
  const int nchunk = (kind == 0) ? 1 : 16;
  const int c0 = (kind == 0) ? 255 + seq : seg * 16;
  const int cg = sl & 3;
  const int dvc = cg * 32 + fr;
  const bool full = (kind != 1);
  const bool uzero = (kind == 1 && sl >= 4);
  const int r16 = tid >> 4, c16 = (tid & 15) * 8;
  const int r8 = tid >> 3, c8 = (tid & 7) * 8;
  f32x4 S[2][2];
  f32x4 Dacc[2];
  { float one_ = 1.f; asm volatile("" : "+v"(one_)); Dacc[0] = (f32x4){one_, one_, one_, one_}; Dacc[1] = Dacc[0]; }
  if (kind == 0) {
    const float* st = (GDN ? p.st_gdn : p.st_hgrn) + ((size_t)(l * 32 + (seq - 1)) * 4 + hd) * 16384;
#pragma unroll
    for (int i = 0; i < 2; i++)
#pragma unroll
      for (int n = 0; n < 2; n++)
#pragma unroll
        for (int e = 0; e < 4; e++) S[i][n][e] = st[((wid * 2 + i) * 16 + fq * 4 + e) * 128 + dvc + n * 16];
  } else if (kind == 1) {
#pragma unroll
    for (int i = 0; i < 2; i++)
#pragma unroll
      for (int n = 0; n < 2; n++)
#pragma unroll
        for (int e = 0; e < 4; e++)
          S[i][n][e] = (sl >= 4 && ((wid * 2 + i) * 16 + fq * 4 + e) == (sl - 4) * 32 + n * 16 + fr) ? 1.f : 0.f;
  } else {
#pragma unroll
    for (int i = 0; i < 2; i++)
#pragma unroll
      for (int n = 0; n < 2; n++) S[i][n] = (f32x4){0.f, 0.f, 0.f, 0.f};
    if (!GDN) {
      const float* hs = (const float*)(p.ws + WS_HS);
      const float* hdp = (const float*)(p.ws + WS_HD);
#pragma unroll 4
      for (int j = 0; j < seg; j++) {
        f32x4 dj[2], sj[2][2];
#pragma unroll
        for (int i = 0; i < 2; i++) {
          dj[i] = *(const f32x4*)(hdp + (size_t)(j * 4 + hd) * 128 + (wid * 2 + i) * 16 + fq * 4);
#pragma unroll
          for (int n = 0; n < 2; n++)
#pragma unroll
            for (int e = 0; e < 4; e++)
              sj[i][n][e] = hs[((size_t)(j * 4 + hd) * 128 + (wid * 2 + i) * 16 + fq * 4 + e) * 128 + dvc + n * 16];
        }
#pragma unroll
        for (int i = 0; i < 2; i++)
#pragma unroll
          for (int n = 0; n < 2; n++) S[i][n] = S[i][n] * dj[i] + sj[i][n];
      }
    } else {
      const float* gb = (const float*)(p.ws + WS_GB);
      const u16* gp = (const u16*)(p.ws + WS_GP);
      u16* sP = smem;
      u32x4 rP[8];
      if (seg > 1) {
#pragma unroll
        for (int i = 0; i < 8; i++) rP[i] = *(const u32x4*)(gp + ((size_t)(1 * 4 + hd) * 128 + r16 + i * 16) * 128 + c16);
      }
      f32x4 bn[2][2];
#pragma unroll
      for (int i = 0; i < 2; i++)
#pragma unroll
        for (int n = 0; n < 2; n++)
#pragma unroll
          for (int e = 0; e < 4; e++)
            bn[i][n][e] = gb[((size_t)(0 * 4 + hd) * 128 + (wid * 2 + i) * 16 + fq * 4 + e) * 128 + dvc + n * 16];
      for (int j = 0; j < seg; j++) {
        f32x4 bj[2][2];
#pragma unroll
        for (int i = 0; i < 2; i++)
#pragma unroll
          for (int n = 0; n < 2; n++) bj[i][n] = bn[i][n];
        if (j == 0) {
#pragma unroll
          for (int i = 0; i < 2; i++)
#pragma unroll
            for (int n = 0; n < 2; n++) S[i][n] = bj[i][n];
          if (seg > 1) {
#pragma unroll
            for (int i = 0; i < 2; i++)
#pragma unroll
              for (int n = 0; n < 2; n++)
#pragma unroll
                for (int e = 0; e < 4; e++)
                  bn[i][n][e] = gb[((size_t)(1 * 4 + hd) * 128 + (wid * 2 + i) * 16 + fq * 4 + e) * 128 + dvc + n * 16];
          }
        } else {
          __syncthreads();
#pragma unroll
          for (int i = 0; i < 8; i++) *(u32x4*)(sP + (r16 + i * 16) * 136 + c16) = rP[i];
#pragma unroll
          for (int i = 0; i < 2; i++)
#pragma unroll
            for (int n = 0; n < 2; n++) {
              uint2 o2;
              o2.x = pack2(S[i][n][0], S[i][n][1]);
              o2.y = pack2(S[i][n][2], S[i][n][3]);
              *(uint2*)(sSt + (n * 16 + fr) * 136 + (wid * 2 + i) * 16 + fq * 4) = o2;
            }
          __syncthreads();
          if (j + 1 < seg) {
#pragma unroll
            for (int i = 0; i < 8; i++) rP[i] = *(const u32x4*)(gp + ((size_t)((j + 1) * 4 + hd) * 128 + r16 + i * 16) * 128 + c16);
#pragma unroll
            for (int i = 0; i < 2; i++)
#pragma unroll
              for (int n = 0; n < 2; n++)
#pragma unroll
                for (int e = 0; e < 4; e++)
                  bn[i][n][e] = gb[((size_t)((j + 1) * 4 + hd) * 128 + (wid * 2 + i) * 16 + fq * 4 + e) * 128 + dvc + n * 16];
          }
#pragma unroll
          for (int i = 0; i < 2; i++)
#pragma unroll
            for (int n = 0; n < 2; n++)
              S[i][n] = mma_lds_<128>(lane, sP + (wid * 2 + i) * 16 * 136, 136, sSt + n * 16 * 136, 136, bj[i][n]);
        }
      }
    }
  }
  const u16* gQP = GDN ? (const u16*)(p.ws + WS_G) + G_QP + hd * 128 : z + ZA_Q + hd * 128;
  const int ldqp = GDN ? 512 : ZS;
  const u16* gKT = GDN ? (const u16*)(p.ws + WS_G) + G_KPT : (const u16*)(p.ws + WS_HKPT);
  const u16* gQK = (GDN ? (const u16*)(p.ws + WS_G) + G_QK : (const u16*)(p.ws + WS_HQK)) + hd * 64;
  const u16* gW = (const u16*)(p.ws + WS_G) + G_W + hd * 128;
  const u16* gU = (const u16*)(p.ws + WS_G) + G_U + hd * 128 + dvc;
  u16* gO = z + (GDN ? ZC_V : ZA_I) + hd * 128 + dvc;

  u32x4 rQP[2][4], rW[2][4], rKT[2][4], rQK[2][2];
  unsigned rV[2][8];
  f32x4 rDv[2][2];
  float rG[2];
#define LOAD_REGS(ST, cx) do { \
    const int c_ = (cx); \
    const size_t tk0_ = (size_t)c_ * 64; \
    _Pragma("unroll") \
    for (int i = 0; i < 4; i++) { \
      if (full) rQP[ST][i] = *(const u32x4*)(gQP + (tk0_ + r16 + i * 16) * ldqp + c16); \
      if (GDN) rW[ST][i] = *(const u32x4*)(gW + (tk0_ + r16 + i * 16) * 512 + c16); \
      rKT[ST][i] = *(const u32x4*)(gKT + ((size_t)(c_ * 4 + hd) * 128 + r8 + i * 32) * 64 + c8); \
    } \
    if (full) { \
    _Pragma("unroll") \
      for (int i = 0; i < 2; i++) rQK[ST][i] = *(const u32x4*)(gQK + (tk0_ + r8 + i * 32) * 256 + c8); \
    } \
    if (GDN) { \
    _Pragma("unroll") \
      for (int n = 0; n < 2; n++) \
    _Pragma("unroll") \
        for (int e = 0; e < 4; e++) rV[ST][n * 4 + e] = uzero ? 0u : (unsigned)gU[(tk0_ + wid * 16 + fq * 4 + e) * 512 + n * 16]; \
      rG[ST] = ((const float*)(p.ws + WS_GGL))[c_ * 4 + hd]; \
    } else { \
    _Pragma("unroll") \
      for (int i = 0; i < 8; i++) { \
        const int e = tid + i * 256; \
        rV[ST][i] = z[(tk0_ + (e >> 5)) * ZS + ZA_I + hd * 128 + cg * 32 + (e & 31)]; \
      } \
      const float* da = (const float*)(p.ws + WS_HDA) + (size_t)c_ * 512 + hd * 128; \
    _Pragma("unroll") \
      for (int i = 0; i < 2; i++) rDv[ST][i] = *(const f32x4*)(da + (wid * 2 + i) * 16 + fq * 4); \
    } \
  } while (0)
#define SCAN_STEP(ST, cix) do { \
    const int ci_ = (cix); \
    const int c = c0 + ci_; \
    const size_t tok0 = (size_t)c * 64; \
    __syncthreads(); \
    _Pragma("unroll") \
    for (int i = 0; i < 4; i++) { \
      if (full) *(u32x4*)(sQP + (r16 + i * 16) * 136 + c16) = rQP[ST][i]; \
      if (GDN) *(u32x4*)(sW + (r16 + i * 16) * 136 + c16) = rW[ST][i]; \
      *(u32x4*)(sKT + (r8 + i * 32) * 72 + c8) = rKT[ST][i]; \
    } \
    if (full) { \
    _Pragma("unroll") \
      for (int i = 0; i < 2; i++) *(u32x4*)(sQK + (r8 + i * 32) * 72 + c8) = rQK[ST][i]; \
    } \
    _Pragma("unroll") \
    for (int i = 0; i < 2; i++) \
    _Pragma("unroll") \
      for (int n = 0; n < 2; n++) { \
        uint2 o2; \
        o2.x = pack2(S[i][n][0], S[i][n][1]); \
        o2.y = pack2(S[i][n][2], S[i][n][3]); \
        *(uint2*)(sSt + (n * 16 + fr) * 136 + (wid * 2 + i) * 16 + fq * 4) = o2; \
      } \
    float uu[8]; \
    if (GDN) { \
    _Pragma("unroll") \
      for (int e = 0; e < 8; e++) uu[e] = bf2f((u16)rV[ST][e]); \
    } else { \
    _Pragma("unroll") \
      for (int i = 0; i < 8; i++) { \
        const int e = tid + i * 256; \
        sVt[(e & 31) * 72 + (e >> 5)] = (u16)rV[ST][i]; \
      } \
    } \
    __syncthreads(); \
    float g_ = 0.f; f32x4 dv0_, dv1_; \
    if (GDN) { g_ = rG[ST]; asm volatile("" : "+v"(g_), "+v"(uu[0]), "+v"(uu[1]), "+v"(uu[2]), "+v"(uu[3]), "+v"(uu[4]), "+v"(uu[5]), "+v"(uu[6]), "+v"(uu[7]) :: "memory"); } \
    else { dv0_ = rDv[ST][0]; dv1_ = rDv[ST][1]; asm volatile("" : "+v"(dv0_), "+v"(dv1_) :: "memory"); } \
    if (ci_ + 2 < nchunk) LOAD_REGS(ST, c + 2); \
    f32x4 o[2]; \
    o[0] = (f32x4){0.f, 0.f, 0.f, 0.f}; o[1] = o[0]; \
    if (full) { \
    _Pragma("unroll") \
      for (int n = 0; n < 2; n++) o[n] = mma_lds_<128>(lane, sQP + wid * 16 * 136, 136, sSt + n * 16 * 136, 136, o[n]); \
    } \
    if (GDN) { \
    _Pragma("unroll") \
      for (int n = 0; n < 2; n++) { \
        f32x4 a = mma_lds_<128>(lane, sW + wid * 16 * 136, 136, sSt + n * 16 * 136, 136, (f32x4){0.f, 0.f, 0.f, 0.f}); \
        uint2 ov; \
        ov.x = pack2(uu[n * 4 + 0] - a[0], uu[n * 4 + 1] - a[1]); \
        ov.y = pack2(uu[n * 4 + 2] - a[2], uu[n * 4 + 3] - a[3]); \
        *(uint2*)(sVt + (n * 16 + fr) * 72 + wid * 16 + fq * 4) = ov; \
      } \
      __syncthreads(); \
    } \
    if (full) { \
    _Pragma("unroll") \
      for (int n = 0; n < 2; n++) { \
        o[n] = mma_lds_<64>(lane, sQK + wid * 16 * 72, 72, sVt + n * 16 * 72, 72, o[n]); \
    _Pragma("unroll") \
        for (int e = 0; e < 4; e++) gO[(tok0 + wid * 16 + fq * 4 + e) * ZS + n * 16] = f2bf(o[n][e]); \
      } \
    } \
    if (GDN) { \
      const float gs_ = __int_as_float(__builtin_amdgcn_readfirstlane(__float_as_int(g_))); \
    _Pragma("unroll") \
      for (int i = 0; i < 2; i++) { S[i][0] *= gs_; S[i][1] *= gs_; } \
    } else { \
      S[0][0] *= dv0_; S[0][1] *= dv0_; S[1][0] *= dv1_; S[1][1] *= dv1_; \
      Dacc[0] *= dv0_; Dacc[1] *= dv1_; \
    } \
    _Pragma("unroll") \
    for (int i = 0; i < 2; i++) \
    _Pragma("unroll") \
      for (int n = 0; n < 2; n++) \
        S[i][n] = mma_lds_<64>(lane, sKT + (wid * 2 + i) * 16 * 72, 72, sVt + n * 16 * 72, 72, S[i][n]); \
  } while (0)
  __syncthreads();
  LOAD_REGS(0, c0);
  if (nchunk > 1) LOAD_REGS(1, c0 + 1);
  for (int ci = 0; ci < nchunk; ci += 2) {
    SCAN_STEP(0, ci);
    if (ci + 1 < nchunk) SCAN_STEP(1, ci + 1);
  }
  if (kind == 1) {
    if (GDN && sl >= 4) {
      u16* gp = (u16*)(p.ws + WS_GP) + (size_t)(seg * 4 + hd) * 16384;
#pragma unroll
      for (int i = 0; i < 2; i++)
#pragma unroll
        for (int n = 0; n < 2; n++)
#pragma unroll
          for (int e = 0; e < 4; e++) gp[((wid * 2 + i) * 16 + fq * 4 + e) * 128 + (sl - 4) * 32 + n * 16 + fr] = f2bf(S[i][n][e]);
    } else {
      float* dst = (float*)(p.ws + (GDN ? WS_GB : WS_HS)) + (size_t)(seg * 4 + hd) * 16384;
#pragma unroll
      for (int i = 0; i < 2; i++)
#pragma unroll
        for (int n = 0; n < 2; n++)
#pragma unroll
          for (int e = 0; e < 4; e++) dst[((wid * 2 + i) * 16 + fq * 4 + e) * 128 + dvc + n * 16] = S[i][n][e];
      if (!GDN && sl == 0 && fr == 0) {
        float* dd = (float*)(p.ws + WS_HD) + (size_t)(seg * 4 + hd) * 128;
#pragma unroll
        for (int i = 0; i < 2; i++) *(f32x4*)(dd + (wid * 2 + i) * 16 + fq * 4) = Dacc[i];
      }
    }
  } else if (kind == 0 || seg == 15) {
    float* dst;
    if (kind == 2) dst = p.out + (GDN ? O_PG : O_PH) + ((size_t)l * 4 + hd) * 16384;
    else dst = p.out + (GDN ? O_SG : O_SH) + ((size_t)(l * 32 + (seq - 1)) * 4 + hd) * 16384;
#pragma unroll
    for (int i = 0; i < 2; i++)
#pragma unroll
      for (int n = 0; n < 2; n++)
#pragma unroll
        for (int e = 0; e < 4; e++) dst[((wid * 2 + i) * 16 + fq * 4 + e) * 128 + dvc + n * 16] = S[i][n][e];
  }
  __syncthreads();
}

__device__ __forceinline__ void onorm_phase(const Params& p, int l) {
  u16* z = (u16*)(p.ws + WS_Z);
  u16* ru = (u16*)(p.ws + WS_RU);
  OPAQUE_TID(tid);
  const int lane = tid & 63, wid = tid >> 6;
  for (int row = blockIdx.x * 4 + wid; row < NTOK; row += gridDim.x * 4) {
    u16* zr = z + (size_t)row * ZS;
#pragma unroll
    for (int br = 0; br < 2; br++) {
      u16* po = zr + (br == 0 ? ZA_I : ZC_V) + lane * 8;
      const u16* pg = zr + (br == 0 ? ZA_G : ZC_G) + lane * 8;
      const float* nw = (br == 0 ? p.a_norm : p.c_norm) + l * 128 + (lane & 15) * 8;
      const uint4 vo = *(const uint4*)po, vg = *(const uint4*)pg;
      const unsigned uo[4] = {vo.x, vo.y, vo.z, vo.w}, ug[4] = {vg.x, vg.y, vg.z, vg.w};
      float o[8], g[8];
#pragma unroll
      for (int i = 0; i < 4; i++) {
        o[2 * i] = bf2f((u16)(uo[i] & 0xffff)); o[2 * i + 1] = bf2f((u16)(uo[i] >> 16));
        g[2 * i] = bf2f((u16)(ug[i] & 0xffff)); g[2 * i + 1] = bf2f((u16)(ug[i] >> 16));
      }
      float ss = 0.f;
#pragma unroll
      for (int i = 0; i < 8; i++) ss += o[i] * o[i];
      ss += __shfl_xor(ss, 1); ss += __shfl_xor(ss, 2); ss += __shfl_xor(ss, 4); ss += __shfl_xor(ss, 8);
      const float r = rsqrtf(ss * (1.f / 128.f) + EPS);
      unsigned res[4];
#pragma unroll
      for (int i = 0; i < 4; i++)
        res[i] = pack2(o[2 * i] * r * nw[2 * i] * silu(g[2 * i]), o[2 * i + 1] * r * nw[2 * i + 1] * silu(g[2 * i + 1]));
      *(uint4*)po = make_uint4(res[0], res[1], res[2], res[3]);
    }
    {
      u16* ph = ru + (size_t)row * 512 + lane * 8;
      const u16* pg = zr + ZB_G + lane * 8;
      const uint4 vo = *(const uint4*)ph, vg = *(const uint4*)pg;
      const unsigned uo[4] = {vo.x, vo.y, vo.z, vo.w}, ug[4] = {vg.x, vg.y, vg.z, vg.w};
      unsigned res[4];
#pragma unroll
      for (int i = 0; i < 4; i++) {
        const float h0 = bf2f((u16)(uo[i] & 0xffff)), h1 = bf2f((u16)(uo[i] >> 16));
        const float g0 = bf2f((u16)(ug[i] & 0xffff)), g1 = bf2f((u16)(ug[i] >> 16));
        res[i] = pack2(gelu_t(g0) * h0, gelu_t(g1) * h1);
      }
      *(uint4*)ph = make_uint4(res[0], res[1], res[2], res[3]);
    }
  }
}

__device__ __forceinline__ void prep_phase(u16* smem, const Params& p, int l, bool dup) {
  for (int t = blockIdx.x; t < 4608; t += gridDim.x) {
    if (t < 1152) gdn_prep(smem, p, l, t >> 2, t & 3);
    else if (t < 2304) { if (!dup) hgrn_prep(smem, p, l, (t - 1152) >> 2, (t - 1152) & 3); }
    else rglru_prep(smem, p, l, (t - 2304) >> 3, (t - 2304) & 7);
  }
}

__device__ __forceinline__ void scan_phase(u16* smem, const Params& p, int l, int pass) {
  const int ntask = pass ? 512 : (720 + 576 + 1024);
  for (int t = blockIdx.x; t < ntask; t += gridDim.x) {
    bool isg; int kind, seg = 0, seq = 0, hd, sl;
    if (pass) {
      kind = 2;
      if (t < 256) { isg = true; seg = 15 - (t >> 4); hd = (t >> 2) & 3; sl = t & 3; }
      else { const int u = t - 256; isg = false; seg = u >> 4; hd = (u >> 2) & 3; sl = u & 3; }
    } else {
      if (t >= 720 && t < 1296) { rglru_scan(p, l, (t - 720) >> 1, (t - 720) & 1); continue; }
      if (t < 480) { kind = 1; isg = true; seg = t >> 5; hd = (t >> 3) & 3; sl = t & 7; }
      else if (t < 720) { const int u = t - 480; kind = 1; isg = false; seg = u >> 4; hd = (u >> 2) & 3; sl = u & 3; }
      else if (t < 1296 + 512) { const int u = t - 1296; kind = 0; isg = true; seq = 1 + (u >> 4); hd = (u >> 2) & 3; sl = u & 3; }
      else { const int u = t - 1808; kind = 0; isg = false; seq = 1 + (u >> 4); hd = (u >> 2) & 3; sl = u & 3; }
    }
    if (isg) mat_scan<true>(smem, p, l, kind, seg, seq, hd, sl);
    else mat_scan<false>(smem, p, l, kind, seg, seq, hd, sl);
  }
}

__device__ __forceinline__ void run_phase(u16* smem, const Params& p, int l, int ph, bool dup = false) {
#ifdef ONLY_PH
  if (ph != ONLY_PH) return;
  ph = ONLY_PH;
#endif
  u16* Z = (u16*)(p.ws + WS_Z);
  u16* WB = (u16*)(p.ws + WS_WB);
  u16* H = (u16*)(p.ws + WS_H);
  u16* Y = (u16*)(p.ws + WS_Y);
  if (ph == 0 || ph == 7 || ph == 10) {
    const bool fi = (ph == 0);
    const u16* y = fi ? nullptr : Y;
    const float* postw = ((ph == 7) ? opq(p.n_post_mix) : opq(p.n_post_mlp)) + l * D;
    const float* npm = opq(p.n_pre_mix);
    const float* prew = (ph == 0) ? npm : (ph == 7) ? opq(p.n_pre_mlp) + l * D : ((l + 1 < DEPTH) ? npm + (l + 1) * D : nullptr);
    rowpass_phase(p, fi, y, postw, prew, H);
    const int wl = (ph == 0) ? 0 : l + 1;
    if (ph != 7 && wl < DEPTH) wconv_phase(smem, p, wl);
  } else if (ph == 1 || ph == 6 || ph == 8 || ph == 9) {
    const u16* A = (ph == 9) ? Z : H;
    const int lda = (ph == 9) ? 4096 : 1024;
    const u16* Bt = WB + ((ph == 1) ? WB_IN : (ph == 6) ? WB_OUT : (ph == 8) ? WB_UP : WB_DN);
    const int K = (ph == 9) ? 4096 : 1024;
    const int N = (ph == 1) ? ZS : (ph == 8) ? 4096 : 1024;
    u16* C = (ph == 1 || ph == 8) ? Z : Y;
    const int ldc = (ph == 1) ? ZS : (ph == 8) ? 4096 : 1024;
    gemm_big_phase(smem, A, lda, Bt, K, N, K, C, ldc, ph == 8 ? 1 : 0);
  } else if (ph == 2) prep_phase(smem, p, l, dup);
  else if (ph == 3 || ph == 11) scan_phase(smem, p, l, ph == 11 ? 1 : 0);
  else if (ph == 4) onorm_phase(p, l);
  else if (ph == 5) merge_big_phase(smem, p);
}

#if MULTI_LAUNCH
__global__ void __launch_bounds__(256, 2) phase_kernel(Params p, int l, int ph) {
  __shared__ __attribute__((aligned(16))) u16 smem[SMEM_BYTES / 2];
  run_phase(smem, p, l, ph);
}
#endif

#if !MULTI_LAUNCH
#define XB_TMO      128
#define XB_XCNT(j)  (256  + 64 * (j))
#define XB_XSUB(j)  (1280 + 64 * (j))
#define XB_XGEN(j)  (2304 + 64 * (j))
#define XB_TOP      3328
#define XB_TOPGEN   3392
#define XCD_BAR_WORDS 3456
#define XB_SPIN_CAP (1u << 18)
#define LAS __attribute__((address_space(3)))

__device__ __forceinline__ unsigned xb_ld(unsigned* p)              { return __hip_atomic_load(p, __ATOMIC_RELAXED, __HIP_MEMORY_SCOPE_AGENT); }
__device__ __forceinline__ unsigned xb_add(unsigned* p, unsigned v) { return __hip_atomic_fetch_add(p, v, __ATOMIC_RELAXED, __HIP_MEMORY_SCOPE_AGENT); }
__device__ __forceinline__ unsigned xb_xcc_id() { return (unsigned)__builtin_amdgcn_s_getreg((3 << 11) | 20) & 0xFu; }
#define XB_SPIN(cond, bar) do { unsigned _sp = 0; while (cond) { __builtin_amdgcn_s_sleep(1); \
    if ((++_sp & 255u) == 0u) { if (xb_ld(&(bar)[XB_TMO])) break; if (_sp > XB_SPIN_CAP) { atomicAdd(&(bar)[XB_TMO], 1u); break; } } } } while (0)

struct XcdBarrier {
    unsigned* bar; unsigned x;
    volatile LAS unsigned* st;
};

__device__ __forceinline__ XcdBarrier xcd_barrier_post(unsigned* bar, volatile LAS unsigned* st) {
    XcdBarrier b; b.bar = bar; b.x = xb_xcc_id(); b.st = st;
    if (threadIdx.x == 0) (void)xb_add(&bar[XB_XCNT(b.x)], 1u);
    return b;
}
__device__ __forceinline__ void xcd_barrier_complete(unsigned* bar, unsigned x, unsigned& nloc, unsigned& nx) {
    const unsigned G = gridDim.x * gridDim.y * gridDim.z;
    unsigned sum, cnt, mine, sp = 0u;
    for (;;) {
        sum = 0u; cnt = 0u; mine = 0u;
#pragma unroll
        for (unsigned j = 0; j < 16; ++j) { const unsigned c = xb_ld(&bar[XB_XCNT(j)]); sum += c; cnt += (c > 0u) ? 1u : 0u; mine = (j == x) ? c : mine; }
        if (sum == G) break;
        __builtin_amdgcn_s_sleep(1);
        if ((++sp & 255u) == 0u) { if (xb_ld(&bar[XB_TMO])) break; if (sp > XB_SPIN_CAP) { atomicAdd(&bar[XB_TMO], 1u); break; } }
    }
    nloc = mine > 0u ? mine : 1u; nx = cnt > 0u ? cnt : 1u;
}

__device__ __forceinline__ void xcd_barrier(const XcdBarrier& b) {
    asm volatile("s_waitcnt vmcnt(0)" ::: "memory");
    __syncthreads();
    if (threadIdx.x == 0) {
        unsigned* bar = b.bar;
        __builtin_amdgcn_s_waitcnt(0);
        unsigned nloc = b.st[0], nx = b.st[1];
        if (nloc == 0u) { xcd_barrier_complete(bar, b.x, nloc, nx); b.st[0] = nloc; b.st[1] = nx; }
        const unsigned old = xb_add(&bar[XB_XSUB(b.x)], 1u);
        const unsigned gen = old / nloc;
        if (old + 1u == (gen + 1u) * nloc) {
            __builtin_amdgcn_fence(__ATOMIC_RELEASE, "agent");
            asm volatile("s_waitcnt vmcnt(0)" ::: "memory");
            const unsigned og = xb_add(&bar[XB_TOP], 1u);
            const unsigned tg = og / nx;
            if (og + 1u == (tg + 1u) * nx) xb_add(&bar[XB_TOPGEN], 1u);
            else XB_SPIN(xb_ld(&bar[XB_TOPGEN]) == tg, bar);
            __builtin_amdgcn_fence(__ATOMIC_ACQUIRE, "agent");
            xb_add(&bar[XB_XGEN(b.x)], 1u);
            asm volatile("s_waitcnt vmcnt(0)" ::: "memory");
        } else {
            XB_SPIN(xb_ld(&bar[XB_XGEN(b.x)]) == gen, bar);
            __builtin_amdgcn_fence(__ATOMIC_ACQUIRE, "agent");
            asm volatile("s_waitcnt vmcnt(0)" ::: "memory");
        }
    }
    __syncthreads();
}


__global__ void __launch_bounds__(256, 2) mega_kernel(Params p) {
  __shared__ __attribute__((aligned(16))) u16 smem[SMEM_BYTES / 2 + 8];
  cg::grid_group grid = cg::this_grid();
  unsigned* xbw = (unsigned*)(smem + SMEM_BYTES / 2);
  if (threadIdx.x == 0) { xbw[0] = 0u; xbw[1] = 0u; xbw[2] = 0u; xbw[3] = 0u; }
  __syncthreads();
  XcdBarrier xb = xcd_barrier_post((unsigned*)(p.ws + WS_BAR), (volatile LAS unsigned*)xbw);
  if (p.ws == nullptr) grid.sync();
  for (int s = 0; s < 1 + DEPTH * 11; s++) {
    int l = 0, ph = 0;
    if (s > 0) {
      l = (s - 1) / 11;
      const int pi = (s - 1) % 11 + 1;
      ph = (pi <= 3) ? pi : (pi == 4) ? 11 : pi - 1;
    }
    run_phase(smem, p, l, ph);
    xcd_barrier(xb);
#ifdef DUP_MASK
    if (s > 0 && ((DUP_MASK >> ph) & 1)) { run_phase(smem, p, l, ph, true); xcd_barrier(xb); }
#endif
#ifdef EXTRA_SYNCS
    for (int i = 0; i < EXTRA_SYNCS; i++) xcd_barrier(xb);
#endif
  }
}
#endif

extern "C" void kernel_launch(void* const* d_in, const int* in_sizes, int n_in, void* d_out, int out_size, void* d_ws,
                              size_t ws_size, hipStream_t stream) {
  if (ws_size < WS_END) { fprintf(stderr, "workspace too small: %zu < %zu\n", ws_size, (size_t)WS_END); return; }
  Params p{};
  const float** pp = (const float**)&p;
  for (int i = 0; i < 31; i++) pp[i] = (const float*)d_in[i];
  p.out = (float*)d_out;
  p.ws = (char*)d_ws;
  static int grid_blocks = 0;
  if (!grid_blocks) {
    int dev = 0, cus = 0, per_cu = 0;
    hipGetDevice(&dev);
    hipDeviceGetAttribute(&cus, hipDeviceAttributeMultiprocessorCount, dev);
#if MULTI_LAUNCH
    hipOccupancyMaxActiveBlocksPerMultiprocessor(&per_cu, phase_kernel, 256, 0);
#else
    hipOccupancyMaxActiveBlocksPerMultiprocessor(&per_cu, mega_kernel, 256, 0);
#endif
    if (per_cu > 2) per_cu = 2;
    if (per_cu < 1) per_cu = 1;
    grid_blocks = cus * per_cu;
  }
#if MULTI_LAUNCH
  phase_kernel<<<grid_blocks, 256, 0, stream>>>(p, 0, 0);
  for (int l = 0; l < DEPTH; l++)
    for (int pi = 1; pi <= 11; pi++) phase_kernel<<<grid_blocks, 256, 0, stream>>>(p, l, (pi <= 3) ? pi : (pi == 4) ? 11 : pi - 1);
#else
  hipMemsetAsync((char*)d_ws + WS_BAR, 0, 16384, stream);
  void* args[] = {&p};
  hipError_t e = hipLaunchCooperativeKernel((void*)mega_kernel, dim3(grid_blocks), dim3(256), args, 0, stream);
  if (e != hipSuccess) fprintf(stderr, "cooperative launch failed: %s (grid %d)\n", hipGetErrorString(e), grid_blocks);
#endif
}
```

```cpp
#include <hip/hip_runtime.h>
#include <hip/hip_cooperative_groups.h>
#include <cstdio>
namespace cg = cooperative_groups;

#ifndef MULTI_LAUNCH
#define MULTI_LAUNCH 0
#endif

typedef unsigned short u16;
typedef __attribute__((ext_vector_type(8))) short bf16x8;
typedef __attribute__((ext_vector_type(4))) float f32x4;
typedef __attribute__((ext_vector_type(4))) unsigned int u32x4;

constexpr int D = 1024, NTOK = 18432, TP = 16384, NCHUNK = 288, DEPTH = 4, DFF = 4096;
constexpr int DIN = 8200, ZS = 8320;
constexpr int ZA_Q = 0, ZA_F = 512, ZA_I = 1024, ZA_G = 1536, ZB_X = 2048, ZB_G = 2560, ZC_Q = 3072, ZC_V = 4096,
              ZC_G = 4608, ZC_BETA = 5120, ZC_ALPHA = 5124, Z_MERGE = 5128;
constexpr float EPS = 1e-6f;

constexpr size_t O_YP = 0, O_YS = 16777216, O_PH = 18874368, O_PR = 19136512, O_PRC = 19138560, O_PG = 19144704,
                 O_PGC = 19406848, O_SH = 19425280, O_SR = 27813888, O_SRC = 27879424, O_SG = 28076032, O_SGC = 36464640;

constexpr size_t WS_Z = 0;
constexpr size_t WS_WB = WS_Z + (size_t)NTOK * ZS * 2;
constexpr size_t WB_IN = 0, WB_BR = (size_t)ZS * 1024, WB_OUT = WB_BR + 3 * 1024 * 512, WB_UP = WB_OUT + 1024 * 1024,
                 WB_DN = WB_UP + 4096 * 1024, WB_END = WB_DN + 4096 * 1024;
constexpr size_t WS_G = WS_WB + WB_END * 2;
constexpr size_t G_U = 0, G_W = (size_t)NTOK * 512, G_QP = 2 * G_W, G_KPT = 3 * G_W, G_QK = 4 * G_W, G_END = 4 * G_W + (size_t)NTOK * 256;
constexpr size_t WS_H = WS_G, WS_Y = WS_G + (size_t)NTOK * 1024 * 2;
constexpr size_t WS_HKPT = WS_G + G_END * 2;
constexpr size_t WS_HQK = WS_HKPT + (size_t)NTOK * 512 * 2;
constexpr size_t WS_HDA = WS_HQK + (size_t)NTOK * 256 * 2;
constexpr size_t WS_GGL = WS_HDA + (size_t)NCHUNK * 512 * 4;
constexpr size_t WS_RLA = WS_GGL + 8192;
constexpr size_t WS_RU = WS_RLA + (size_t)NTOK * 512 * 2;
constexpr size_t WS_RAGG = WS_RU + (size_t)NTOK * 512 * 2;
constexpr size_t WS_BAR = WS_RAGG + (size_t)NCHUNK * 512 * 8;
constexpr size_t WS_HS = WS_BAR + 16384;
constexpr size_t WS_HD = WS_HS + (size_t)15 * 4 * 16384 * 4;
constexpr size_t WS_GB = WS_HD + (size_t)15 * 4 * 128 * 4;
constexpr size_t WS_GP = WS_GB + (size_t)15 * 4 * 16384 * 4;
constexpr size_t WS_END = WS_GP + (size_t)15 * 4 * 16384 * 2;

struct Params {
  const float *x_prompt, *x_sample, *st_hgrn, *st_rglru, *st_rglru_conv, *st_gdn, *st_gdn_conv, *lb_raw, *n_pre_mix,
      *n_post_mix, *n_pre_mlp, *n_post_mlp, *w_in, *a_norm, *b_conv_w, *b_conv_b, *b_ga_w, *b_ga_b, *b_gx_w, *b_gx_b,
      *b_lambda, *c_conv_w, *c_a_log, *c_dt_bias, *c_norm, *w_br_a, *w_br_b, *w_br_c, *w_out, *w_up, *w_down;
  float* out;
  char* ws;
};

__device__ __forceinline__ u16 f2bf(float f) {
  unsigned u = __float_as_uint(f);
  u += 0x7fffu + ((u >> 16) & 1u);
  return (u16)(u >> 16);
}
__device__ __forceinline__ float bf2f(u16 h) { return __uint_as_float(((unsigned)h) << 16); }
__device__ __forceinline__ float sigm(float x) { return 1.f / (1.f + __expf(-x)); }
__device__ __forceinline__ float silu(float x) { return x * sigm(x); }
__device__ __forceinline__ float softplus(float x) { return fmaxf(x, 0.f) + __logf(1.f + __expf(-fabsf(x))); }
__device__ __forceinline__ float gelu_t(float x) {
  const float u = 1.5957691216f * (x + 0.044715f * x * x * x);
  return x * sigm(u);
}
__device__ __forceinline__ unsigned pack2(float a, float b) { return (unsigned)f2bf(a) | ((unsigned)f2bf(b) << 16); }

template <class T> __device__ __forceinline__ T* opq(T* x) { asm volatile("" : "+s"(x)); return x; }
#define OPAQUE_TID(t) int t = threadIdx.x; asm volatile("" : "+v"(t))

template <int K>
__device__ __forceinline__ f32x4 mma_lds_(int lane, const u16* a, int lda, const u16* b, int ldb, f32x4 acc) {
  const int r = lane & 15, q = lane >> 4;
  const u16* pa = a + r * lda + q * 8;
  const u16* pb = b + r * ldb + q * 8;
#pragma unroll
  for (int k = 0; k < K; k += 32) {
    bf16x8 af = *(const bf16x8*)(pa + k);
    bf16x8 bf = *(const bf16x8*)(pb + k);
    acc = __builtin_amdgcn_mfma_f32_16x16x32_bf16(af, bf, acc, 0, 0, 0);
  }
  return acc;
}

constexpr int BM = 128, BK = 64, LDT = 72;
constexpr int SMEM_BYTES = 75776;

template <int NJ>
__device__ __forceinline__ void gemm_tile(u16* smem, const u16* __restrict__ A, int lda, const u16* __restrict__ Bt,
                                          int ldb, int K, int m0, int n0, f32x4 (&acc)[4][NJ]) {
  OPAQUE_TID(tid);
  const int lane = tid & 63, wid = tid >> 6, wr = wid >> 1, wc = wid & 1, fr = lane & 15, fq = lane >> 4;
#pragma unroll
  for (int i = 0; i < 4; i++)
#pragma unroll
    for (int j = 0; j < NJ; j++) acc[i][j] = (f32x4){0.f, 0.f, 0.f, 0.f};
  const int lrow = tid >> 3, lc8 = (tid & 7) * 8;
  const u16* ga = A + (size_t)(m0 + lrow) * lda + lc8;
  const u16* gb = Bt + (size_t)(n0 + lrow) * ldb + lc8;
  u32x4 ra[4], rb[NJ];
#pragma unroll
  for (int i = 0; i < 4; i++) {
    ra[i] = *(const u32x4*)(ga + (size_t)i * 32 * lda);
    if (i < NJ) rb[i] = *(const u32x4*)(gb + (size_t)i * 32 * ldb);
  }
#pragma unroll
  for (int i = 0; i < 4; i++) {
    *(u32x4*)(smem + (lrow + i * 32) * LDT + lc8) = ra[i];
    if (i < NJ) *(u32x4*)(smem + BM * LDT + (lrow + i * 32) * LDT + lc8) = rb[i];
  }
  __syncthreads();
  const int nk = K / BK;
  for (int kt = 0; kt < nk; kt++) {
    const int cur = kt & 1;
    const bool more = (kt + 1 < nk);
    if (more) {
      ga += BK; gb += BK;
#pragma unroll
      for (int i = 0; i < 4; i++) {
        ra[i] = *(const u32x4*)(ga + (size_t)i * 32 * lda);
        if (i < NJ) rb[i] = *(const u32x4*)(gb + (size_t)i * 32 * ldb);
      }
    }
    const u16* a = smem + cur * 2 * BM * LDT + (wr * 64 + fr) * LDT + fq * 8;
    const u16* b = smem + cur * 2 * BM * LDT + BM * LDT + (wc * 16 * NJ + fr) * LDT + fq * 8;
#pragma unroll
    for (int ks = 0; ks < 2; ks++) {
      bf16x8 af[4], bf[NJ];
#pragma unroll
      for (int i = 0; i < 4; i++) {
        af[i] = *(const bf16x8*)(a + i * 16 * LDT + ks * 32);
        if (i < NJ) bf[i] = *(const bf16x8*)(b + i * 16 * LDT + ks * 32);
      }
#pragma unroll
      for (int i = 0; i < 4; i++)
#pragma unroll
        for (int j = 0; j < NJ; j++) acc[i][j] = __builtin_amdgcn_mfma_f32_16x16x32_bf16(af[i], bf[j], acc[i][j], 0, 0, 0);
    }
    if (more) {
      u16* sa = smem + (cur ^ 1) * 2 * BM * LDT;
#pragma unroll
      for (int i = 0; i < 4; i++) {
        *(u32x4*)(sa + (lrow + i * 32) * LDT + lc8) = ra[i];
        if (i < NJ) *(u32x4*)(sa + BM * LDT + (lrow + i * 32) * LDT + lc8) = rb[i];
      }
    }
    __syncthreads();
  }
}

__device__ __forceinline__ void tile_coords(int tile, int NT, int& mt, int& nt) {
  const int band = tile / (8 * NT), within = tile % (8 * NT);
  mt = band * 8 + (within & 7);
  nt = within >> 3;
}

__device__ __forceinline__ void gemm_phase(u16* smem, const u16* A, int lda, const u16* Bt, int ldb, int N, int K, u16* C, int ldc, int EPI) {
  const int NT = N / 128, MT = NTOK / 128;
  OPAQUE_TID(tid);
  const int lane = tid & 63, wid = tid >> 6, wr = wid >> 1, wc = wid & 1, fr = lane & 15, fq = lane >> 4;
  for (int tile = blockIdx.x; tile < MT * NT; tile += gridDim.x) {
    int mt, nt;
    tile_coords(tile, NT, mt, nt);
    f32x4 acc[4][4];
    gemm_tile<4>(smem, A, lda, Bt, ldb, K, mt * 128, nt * 128, acc);
#pragma unroll
    for (int i = 0; i < 4; i++)
#pragma unroll
      for (int j = 0; j < 4; j++)
#pragma unroll
        for (int e = 0; e < 4; e++) {
          const int row = mt * 128 + wr * 64 + i * 16 + fq * 4 + e, col = nt * 128 + wc * 64 + j * 16 + fr;
          float v = acc[i][j][e];
          if (EPI == 1) { v = fmaxf(v, 0.f); v = v * v; }
          C[(size_t)row * ldc + col] = f2bf(v);
        }
  }
}

__device__ __forceinline__ void glds16(const void* gsrc, unsigned lds_dst) {
  unsigned keep;
  asm volatile("s_mov_b32 %0, m0\n\ts_mov_b32 m0, %2\n\ts_nop 0\n\tglobal_load_lds_dwordx4 %1, off\n\ts_mov_b32 m0, %0"
               : "=&s"(keep) : "v"(gsrc), "s"(lds_dst) : "memory");
}

constexpr int BMB = 288, LDB_ = 40, STG = (BMB + 128) * LDB_;
constexpr int STGG = (BMB + 128) * 32;
__device__ __forceinline__ void gemm_big_phase(u16* smem, const u16* __restrict__ A, int lda, const u16* __restrict__ Bt, int ldb,
                                               int N, int K, u16* C, int ldc, int EPI) {
  const int NT = N / 128, MT = NTOK / BMB;
  OPAQUE_TID(tid);
  const int lane = tid & 63, wid = tid >> 6, wr = wid >> 1, wc = wid & 1, fr = lane & 15, fq = lane >> 4;
  const int nmc = (NT + 7) >> 3;
  const bool xcd_order = (gridDim.x == 512);
  const int nwork = xcd_order ? 8 * nmc * 64 : MT * NT;
  for (int w = blockIdx.x; w < nwork; w += gridDim.x) {
    int mt, nt;
    if (xcd_order) {
      const int q = (w >> 9) * 8 + (w & 7), slot = (w >> 3) & 63;
      mt = (q & 7) * 8 + (slot & 7); nt = (q >> 3) * 8 + (slot >> 3);
      if (nt >= NT) continue;
    } else {
      tile_coords(w, NT, mt, nt);
    }
    const int m0 = mt * BMB, n0 = nt * 128;
    f32x4 acc[9][4];
#pragma unroll
    for (int i = 0; i < 9; i++)
#pragma unroll
      for (int j = 0; j < 4; j++) acc[i][j] = (f32x4){0.f, 0.f, 0.f, 0.f};
    const int gl_row = lane >> 2, gl_c = (lane & 3) ^ ((lane >> 4) & 3);
    const unsigned oA = ((unsigned)(m0 + gl_row) * (unsigned)lda + gl_c * 8) * 2u;
    const unsigned oB = ((unsigned)(n0 + gl_row) * (unsigned)ldb + gl_c * 8) * 2u;
    const char* Ab = (const char*)A; const char* Bb = (const char*)Bt;
    const int pc = fq ^ (fr >> 2);
    const int nk = K / 32;
    const int uw = __builtin_amdgcn_readfirstlane(wid);
    const unsigned lds0 = (unsigned)__builtin_amdgcn_readfirstlane((int)(unsigned)(size_t)smem);
#define GG_STAGE(st_, kt_) do { \
      _Pragma("unroll") \
      for (int k_ = 0; k_ < 5; k_++) { \
        const int a_ = uw + 4 * k_; \
        if (a_ < 18) glds16(Ab + (oA + (unsigned)((16 * a_) * lda + (kt_) * 32) * 2u), lds0 + (unsigned)(((st_) * STGG + a_ * 512) * 2)); \
      } \
      _Pragma("unroll") \
      for (int k_ = 0; k_ < 2; k_++) { \
        const int b_ = uw + 4 * k_; \
        glds16(Bb + (oB + (unsigned)((16 * b_) * ldb + (kt_) * 32) * 2u), lds0 + (unsigned)(((st_) * STGG + 9216 + b_ * 512) * 2)); \
      } \
    } while (0)
    GG_STAGE(0, 0);
    asm volatile("s_waitcnt vmcnt(0)" ::: "memory");
    __syncthreads();
    for (int kt = 0; kt < nk; kt++) {
      const int cur = kt & 1;
      if (kt + 1 < nk) GG_STAGE(cur ^ 1, kt + 1);
      const u16* a = smem + cur * STGG + (wr * 144 + fr) * 32 + pc * 8;
      const u16* b = smem + cur * STGG + 9216 + (wc * 64 + fr) * 32 + pc * 8;
      bf16x8 bf[4];
#pragma unroll
      for (int j = 0; j < 4; j++) bf[j] = *(const bf16x8*)(b + j * 512);
#pragma unroll
      for (int i = 0; i < 9; i++) {
        const bf16x8 af = *(const bf16x8*)(a + i * 512);
#pragma unroll
        for (int j = 0; j < 4; j++) acc[i][j] = __builtin_amdgcn_mfma_f32_16x16x32_bf16(af, bf[j], acc[i][j], 0, 0, 0);
      }
      __builtin_amdgcn_sched_barrier(0);
      asm volatile("s_waitcnt vmcnt(0)" ::: "memory");
      __syncthreads();
    }
    {
      u16* scr = smem + STGG + wid * 16 * 72;
#pragma unroll
      for (int i = 0; i < 9; i++) {
#pragma unroll
        for (int j = 0; j < 4; j++)
#pragma unroll
          for (int e = 0; e < 4; e++) {
            float v = acc[i][j][e];
            if (EPI == 1) { v = fmaxf(v, 0.f); v = v * v; }
            scr[(fq * 4 + e) * 72 + j * 16 + fr] = f2bf(v);
          }
#pragma unroll
        for (int h = 0; h < 2; h++) {
          const int rr = h * 8 + (lane >> 3), cc = (lane & 7) * 8;
          const u32x4 v = *(const u32x4*)(scr + rr * 72 + cc);
          *(u32x4*)(C + (size_t)(m0 + wr * 144 + i * 16 + rr) * ldc + n0 + wc * 64 + cc) = v;
        }
      }
    }
  }
}

__device__ __forceinline__ void merge_phase(u16* smem, const Params& p) {
  const u16* z = (const u16*)(p.ws + WS_Z);
  const u16* wb = (const u16*)(p.ws + WS_WB) + WB_BR;
  const u16* ru = (const u16*)(p.ws + WS_RU);
  u16* H = (u16*)(p.ws + WS_H);
  const int NT = 8, MT = NTOK / 128;
  OPAQUE_TID(tid);
  const int lane = tid & 63, wid = tid >> 6, wr = wid >> 1, wc = wid & 1, fr = lane & 15, fq = lane >> 4;
  const int lrow = tid >> 3, lc8 = (tid & 7) * 8;
  for (int tile = blockIdx.x; tile < MT * NT; tile += gridDim.x) {
    int mt, nt;
    tile_coords(tile, NT, mt, nt);
    const int m0 = mt * 128, n0 = nt * 128;
    f32x4 tot[4][4], acc[4][4];
#pragma unroll
    for (int i = 0; i < 4; i++)
#pragma unroll
      for (int j = 0; j < 4; j++) { tot[i][j] = (f32x4){0.f, 0.f, 0.f, 0.f}; acc[i][j] = tot[i][j]; }
    u32x4 ra[4], rb[4];
    unsigned gv[4][4][2];
#define MG_LOAD(it_) do { \
      const int sg_ = (it_) >> 3, kk_ = (it_) & 7; \
      const u16* A_ = (sg_ == 0) ? z + ZA_I : (sg_ == 1) ? ru : z + ZC_V; \
      const int lda_ = (sg_ == 1) ? 512 : ZS; \
      const u16* ga_ = A_ + (size_t)(m0 + lrow) * lda_ + kk_ * 64 + lc8; \
      const u16* gb_ = wb + (size_t)sg_ * 1024 * 512 + (size_t)(n0 + lrow) * 512 + kk_ * 64 + lc8; \
      _Pragma("unroll") \
      for (int i = 0; i < 4; i++) ra[i] = *(const u32x4*)(ga_ + (size_t)i * 32 * lda_); \
      _Pragma("unroll") \
      for (int i = 0; i < 4; i++) rb[i] = *(const u32x4*)(gb_ + (size_t)i * 32 * 512); \
    } while (0)
#define MG_STORE(st_) do { \
      u16* sa_ = smem + (st_) * 2 * BM * LDT; \
      _Pragma("unroll") \
      for (int i = 0; i < 4; i++) *(u32x4*)(sa_ + (lrow + i * 32) * LDT + lc8) = ra[i]; \
      _Pragma("unroll") \
      for (int i = 0; i < 4; i++) *(u32x4*)(sa_ + BM * LDT + (lrow + i * 32) * LDT + lc8) = rb[i]; \
    } while (0)
    MG_LOAD(0);
    MG_STORE(0);
    __syncthreads();
    for (int it = 0; it < 24; it++) {
      const int cur = it & 1, sg = it >> 3, kk = it & 7;
      if (kk == 0) {
#pragma unroll
        for (int i = 0; i < 4; i++)
#pragma unroll
          for (int j = 0; j < 4; j++) {
            const u16* gp = z + (size_t)(m0 + wr * 64 + i * 16 + fq * 4) * ZS + Z_MERGE + sg * 1024 + n0 + wc * 64 + j * 16 + fr;
            gv[i][j][0] = (unsigned)gp[0] | ((unsigned)gp[ZS] << 16);
            gv[i][j][1] = (unsigned)gp[2 * ZS] | ((unsigned)gp[3 * ZS] << 16);
          }
      }
      if (it + 1 < 24) MG_LOAD(it + 1);
      const u16* a = smem + cur * 2 * BM * LDT + (wr * 64 + fr) * LDT + fq * 8;
      const u16* b = smem + cur * 2 * BM * LDT + BM * LDT + (wc * 64 + fr) * LDT + fq * 8;
#pragma unroll
      for (int ks = 0; ks < 2; ks++) {
        bf16x8 af[4], bf[4];
#pragma unroll
        for (int i = 0; i < 4; i++) af[i] = *(const bf16x8*)(a + i * 16 * LDT + ks * 32);
#pragma unroll
        for (int j = 0; j < 4; j++) bf[j] = *(const bf16x8*)(b + j * 16 * LDT + ks * 32);
#pragma unroll
        for (int i = 0; i < 4; i++)
#pragma unroll
          for (int j = 0; j < 4; j++) acc[i][j] = __builtin_amdgcn_mfma_f32_16x16x32_bf16(af[i], bf[j], acc[i][j], 0, 0, 0);
      }
      if (it + 1 < 24) MG_STORE(cur ^ 1);
      if (kk == 7) {
#pragma unroll
        for (int i = 0; i < 4; i++)
#pragma unroll
          for (int j = 0; j < 4; j++) {
            tot[i][j][0] += sigm(bf2f((u16)(gv[i][j][0] & 0xffff))) * acc[i][j][0];
            tot[i][j][1] += sigm(bf2f((u16)(gv[i][j][0] >> 16))) * acc[i][j][1];
            tot[i][j][2] += sigm(bf2f((u16)(gv[i][j][1] & 0xffff))) * acc[i][j][2];
            tot[i][j][3] += sigm(bf2f((u16)(gv[i][j][1] >> 16))) * acc[i][j][3];
            acc[i][j] = (f32x4){0.f, 0.f, 0.f, 0.f};
          }
      }
      __syncthreads();
    }
#pragma unroll
    for (int i = 0; i < 4; i++)
#pragma unroll
      for (int j = 0; j < 4; j++)
#pragma unroll
        for (int e = 0; e < 4; e++) {
          const int row = m0 + wr * 64 + i * 16 + fq * 4 + e, col = n0 + wc * 64 + j * 16 + fr;
          H[(size_t)row * 1024 + col] = f2bf(tot[i][j][e]);
        }
  }
}

__device__ __forceinline__ void merge_big_phase(u16* smem, const Params& p) {
  const u16* z = (const u16*)(p.ws + WS_Z);
  const u16* wb = (const u16*)(p.ws + WS_WB) + WB_BR;
  const u16* ru = (const u16*)(p.ws + WS_RU);
  u16* H = (u16*)(p.ws + WS_H);
  const int NT = 8, MT = NTOK / BMB;
  OPAQUE_TID(tid);
  const int lane = tid & 63, wid = tid >> 6, wr = wid >> 1, wc = wid & 1, fr = lane & 15, fq = lane >> 4;
  const int lrow = tid >> 2, lc8 = (tid & 3) * 8;
  for (int tile = blockIdx.x; tile < MT * NT; tile += gridDim.x) {
    int mt, nt;
    tile_coords(tile, NT, mt, nt);
    const int m0 = mt * BMB, n0 = nt * 128;
    f32x4 acc[9][4];
#pragma unroll
    for (int i = 0; i < 9; i++)
#pragma unroll
      for (int j = 0; j < 4; j++) acc[i][j] = (f32x4){0.f, 0.f, 0.f, 0.f};
    u32x4 ra[5], rb[2];
#define MB_LOAD() do { \
      _Pragma("unroll") \
      for (int i = 0; i < 4; i++) ra[i] = *(const u32x4*)(ga + (size_t)i * 64 * lda); \
      if (tid < 128) ra[4] = *(const u32x4*)(ga + (size_t)256 * lda); \
      _Pragma("unroll") \
      for (int i = 0; i < 2; i++) rb[i] = *(const u32x4*)(gb + (size_t)i * 64 * 512); \
    } while (0)
#define MB_STORE(stg_) do { \
      u16* sa_ = smem + (stg_) * STG; \
      _Pragma("unroll") \
      for (int i = 0; i < 4; i++) *(u32x4*)(sa_ + (lrow + i * 64) * LDB_ + lc8) = ra[i]; \
      if (tid < 128) *(u32x4*)(sa_ + (lrow + 256) * LDB_ + lc8) = ra[4]; \
      _Pragma("unroll") \
      for (int i = 0; i < 2; i++) *(u32x4*)(sa_ + (BMB + lrow + i * 64) * LDB_ + lc8) = rb[i]; \
    } while (0)
#define MB_GSTRIP_LOAD(G_, i_) do { \
        int t_ = tid; asm volatile("" : "+v"(t_)); \
        const int ln_ = t_ & 63, wd_ = t_ >> 6; \
        _Pragma("unroll") \
        for (int h = 0; h < 2; h++) { \
          const int rr = h * 8 + (ln_ >> 3), cc = (ln_ & 7) * 8; \
          nv[h] = *(const u32x4*)(z + (size_t)(m0 + (wd_ >> 1) * 144 + (i_) * 16 + rr) * ZS + Z_MERGE + (G_) * 1024 + n0 + (wd_ & 1) * 64 + cc); \
        } \
      } while (0)
#define MB_GATE(G_, INV) do { \
      u32x4 nv[2]; \
      MB_GSTRIP_LOAD(G_, 0); \
      _Pragma("unroll") \
      for (int i = 0; i < 9; i++) { \
        int t_ = tid; asm volatile("" : "+v"(t_));     \
        const int ln_ = t_ & 63, wd_ = t_ >> 6, fr_ = ln_ & 15, fq_ = ln_ >> 4; \
        u16* scr_ = smem + 2 * STG + wd_ * 16 * 72; \
        _Pragma("unroll") \
        for (int h = 0; h < 2; h++) { \
          const int rr = h * 8 + (ln_ >> 3), cc = (ln_ & 7) * 8; \
          *(u32x4*)(scr_ + rr * 72 + cc) = nv[h]; \
        } \
        if (i + 1 < 9) MB_GSTRIP_LOAD(G_, i + 1);     \
        _Pragma("unroll") \
        for (int j = 0; j < 4; j++) \
        _Pragma("unroll") \
          for (int e = 0; e < 4; e++) { \
            const float x_ = 1.f + __expf(-bf2f(scr_[(fq_ * 4 + e) * 72 + j * 16 + fr_])); \
            acc[i][j][e] *= (INV) ? x_ : __frcp_rn(x_); \
          } \
      } \
    } while (0)
    int lda = ZS;
    const u16* ga = z + ZA_I + (size_t)(m0 + lrow) * ZS + lc8;
    const u16* gb = wb + (size_t)(n0 + lrow) * 512 + lc8;
    MB_LOAD();
    MB_STORE(0);
    __syncthreads();
#pragma unroll 1
    for (int it = 0; it < 48; it++) {
      const int cur = it & 1;
      const bool more = (it + 1 < 48);
      if (more) {
        if (((it + 1) & 15) == 0) {
          const int sg_ = (it + 1) >> 4;
          lda = (sg_ == 1) ? 512 : ZS;
          ga = ((sg_ == 1) ? ru : z + ZC_V) + (size_t)(m0 + lrow) * lda + lc8;
          gb = wb + (size_t)sg_ * 1024 * 512 + (size_t)(n0 + lrow) * 512 + lc8;
        } else {
          ga += 32; gb += 32;
        }
        MB_LOAD();
      }
      const u16* a = smem + cur * STG + (wr * 144 + fr) * LDB_ + fq * 8;
      const u16* b = smem + cur * STG + (BMB + wc * 64 + fr) * LDB_ + fq * 8;
      bf16x8 bf[4];
#pragma unroll
      for (int j = 0; j < 4; j++) bf[j] = *(const bf16x8*)(b + j * 16 * LDB_);
#pragma unroll
      for (int i = 0; i < 9; i++) {
        const bf16x8 af = *(const bf16x8*)(a + i * 16 * LDB_);
#pragma unroll
        for (int j = 0; j < 4; j++) acc[i][j] = __builtin_amdgcn_mfma_f32_16x16x32_bf16(af, bf[j], acc[i][j], 0, 0, 0);
      }
      if (more) MB_STORE(cur ^ 1);
      if ((it & 15) == 15) {
        const int sg = it >> 4, napply = (sg < 2) ? 2 : 1;
#pragma unroll 1
        for (int q = 0; q < napply; q++) { MB_GATE(sg + q, q); }
      }
      __syncthreads();
    }
    {
#pragma unroll
      for (int i = 0; i < 9; i++) {
        int t_ = tid; asm volatile("" : "+v"(t_));
        const int ln_ = t_ & 63, wd_ = t_ >> 6, fr_ = ln_ & 15, fq_ = ln_ >> 4;
        u16* scr_ = smem + 2 * STG + wd_ * 16 * 72;
#pragma unroll
        for (int j = 0; j < 4; j++)
#pragma unroll
          for (int e = 0; e < 4; e++) scr_[(fq_ * 4 + e) * 72 + j * 16 + fr_] = f2bf(acc[i][j][e]);
#pragma unroll
        for (int h = 0; h < 2; h++) {
          const int rr = h * 8 + (ln_ >> 3), cc = (ln_ & 7) * 8;
          const u32x4 v = *(const u32x4*)(scr_ + rr * 72 + cc);
          *(u32x4*)(H + (size_t)(m0 + (wd_ >> 1) * 144 + i * 16 + rr) * 1024 + n0 + (wd_ & 1) * 64 + cc) = v;
        }
      }
    }
  }
}

__device__ __forceinline__ void conv_w_tile(float* sm, const float* __restrict__ W, int K, int N, u16* Wt, int kt, int nt) {
  OPAQUE_TID(tid);
  const int lane = tid & 63, wid = tid >> 6;
  const int n = nt * 64 + lane;
#pragma unroll
  for (int i = 0; i < 16; i++) {
    const int k = wid * 16 + i;
    sm[lane * 65 + k] = (n < N) ? W[(size_t)(kt * 64 + k) * N + n] : 0.f;
  }
  __syncthreads();
  const int nn = tid >> 2, ks = (tid & 3) * 16;
  const float* s = sm + nn * 65 + ks;
  uint4 o0, o1;
  o0.x = pack2(s[0], s[1]); o0.y = pack2(s[2], s[3]); o0.z = pack2(s[4], s[5]); o0.w = pack2(s[6], s[7]);
  o1.x = pack2(s[8], s[9]); o1.y = pack2(s[10], s[11]); o1.z = pack2(s[12], s[13]); o1.w = pack2(s[14], s[15]);
  u16* dst = Wt + (size_t)(nt * 64 + nn) * K + kt * 64 + ks;
  *(uint4*)dst = o0;
  *(uint4*)(dst + 8) = o1;
  __syncthreads();
}

__device__ __forceinline__ void wconv_phase(u16* smem, const Params& p, int l) {
  float* sm = (float*)smem;
  u16* wb = (u16*)(p.ws + WS_WB);
  const int total = 2080 + 384 + 256 + 1024 + 1024;
  for (int t = blockIdx.x; t < total; t += gridDim.x) {
    const float* src; u16* dst; int K, N, kt, nt;
    if (t < 2080) {
      src = opq(p.w_in) + (size_t)l * 1024 * DIN; K = 1024; N = DIN; dst = wb + WB_IN; kt = t / 130; nt = t % 130;
    } else if (t < 2080 + 384) {
      const int u = t - 2080, br = u / 128, v = u % 128;
      src = (br == 0 ? opq(p.w_br_a) : br == 1 ? opq(p.w_br_b) : opq(p.w_br_c)) + (size_t)l * 512 * 1024;
      K = 512; N = 1024; dst = wb + WB_BR + (size_t)br * 1024 * 512; kt = v / 16; nt = v % 16;
    } else if (t < 2080 + 384 + 256) {
      const int u = t - 2464;
      src = opq(p.w_out) + (size_t)l * 1024 * 1024; K = 1024; N = 1024; dst = wb + WB_OUT; kt = u / 16; nt = u % 16;
    } else if (t < 2080 + 384 + 256 + 1024) {
      const int u = t - 2720;
      src = opq(p.w_up) + (size_t)l * 1024 * 4096; K = 1024; N = 4096; dst = wb + WB_UP; kt = u / 64; nt = u % 64;
    } else {
      const int u = t - 3744;
      src = opq(p.w_down) + (size_t)l * 4096 * 1024; K = 4096; N = 1024; dst = wb + WB_DN; kt = u / 16; nt = u % 16;
    }
    conv_w_tile(sm, src, K, N, dst, kt, nt);
  }
}

__device__ __forceinline__ float wave_sum(float v) {
#pragma unroll
  for (int o = 32; o >= 1; o >>= 1) v += __shfl_xor(v, o);
  return v;
}

__device__ __forceinline__ void rowpass_phase(const Params& p, bool from_input, const u16* Y, const float* postw, const float* prew, u16* H) {
  OPAQUE_TID(tid);
  const int lane = tid & 63, wid = tid >> 6;
  const float* xpr = opq(p.x_prompt); const float* xsa = opq(p.x_sample); const float* xo = opq((const float*)p.out);
  const int stride = gridDim.x * 4;
  for (int row0 = blockIdx.x * 4 + wid; row0 < NTOK; row0 += 3 * stride) {
    float xv[3][16], yv[3][16];
#pragma unroll
    for (int k = 0; k < 3; k++) {
      const int row = min(row0 + k * stride, NTOK - 1);
      const float* xin = from_input ? (row < TP ? xpr + (size_t)row * D : xsa + (size_t)(row - TP) * D) : xo + (size_t)row * D;
#pragma unroll
      for (int i = 0; i < 4; i++) {
        const float4 v = *(const float4*)(xin + lane * 4 + i * 256);
        xv[k][i * 4] = v.x; xv[k][i * 4 + 1] = v.y; xv[k][i * 4 + 2] = v.z; xv[k][i * 4 + 3] = v.w;
      }
      if (Y) {
#pragma unroll
        for (int i = 0; i < 4; i++) {
          const uint2 v = *(const uint2*)(Y + (size_t)row * D + lane * 4 + i * 256);
          yv[k][i * 4] = bf2f((u16)(v.x & 0xffff)); yv[k][i * 4 + 1] = bf2f((u16)(v.x >> 16));
          yv[k][i * 4 + 2] = bf2f((u16)(v.y & 0xffff)); yv[k][i * 4 + 3] = bf2f((u16)(v.y >> 16));
        }
      }
    }
#pragma unroll
    for (int k = 0; k < 3; k++) {
      const int row = row0 + k * stride;
      if (row < NTOK) {
        if (Y) {
          float ss = 0.f;
#pragma unroll
          for (int i = 0; i < 16; i++) ss += yv[k][i] * yv[k][i];
          ss = wave_sum(ss);
          const float r = rsqrtf(ss * (1.f / D) + EPS);
#pragma unroll
          for (int i = 0; i < 4; i++) {
            const float4 w = *(const float4*)(postw + lane * 4 + i * 256);
            xv[k][i * 4] += yv[k][i * 4] * r * w.x; xv[k][i * 4 + 1] += yv[k][i * 4 + 1] * r * w.y;
            xv[k][i * 4 + 2] += yv[k][i * 4 + 2] * r * w.z; xv[k][i * 4 + 3] += yv[k][i * 4 + 3] * r * w.w;
          }
        }
        if (Y || from_input) {
#pragma unroll
          for (int i = 0; i < 4; i++)
            *(float4*)(p.out + (size_t)row * D + lane * 4 + i * 256) =
                make_float4(xv[k][i * 4], xv[k][i * 4 + 1], xv[k][i * 4 + 2], xv[k][i * 4 + 3]);
        }
        if (prew) {
          float ss = 0.f;
#pragma unroll
          for (int i = 0; i < 16; i++) ss += xv[k][i] * xv[k][i];
          ss = wave_sum(ss);
          const float r = rsqrtf(ss * (1.f / D) + EPS);
#pragma unroll
          for (int i = 0; i < 4; i++) {
            const float4 w = *(const float4*)(prew + lane * 4 + i * 256);
            uint2 o;
            o.x = pack2(xv[k][i * 4] * r * w.x, xv[k][i * 4 + 1] * r * w.y);
            o.y = pack2(xv[k][i * 4 + 2] * r * w.z, xv[k][i * 4 + 3] * r * w.w);
            *(uint2*)(H + (size_t)row * D + lane * 4 + i * 256) = o;
          }
        }
      }
    }
  }
}

__device__ __forceinline__ void hgrn_prep(u16* smem, const Params& p, int l, int c, int hd) {
  u16* z = (u16*)(p.ws + WS_Z);
  u16* sq = smem;
  u16* skt = smem + 64 * 136;
  u16* skh = smem + 2 * 64 * 136;
  float* sd = (float*)(smem + 3 * 64 * 136);
  OPAQUE_TID(tid);
  const int lane = tid & 63, wid = tid >> 6, fr = lane & 15, fq = lane >> 4;
  const int tok0 = c * 64;
  {
    const int hb = tid >> 7, ch = tid & 127, col = hd * 128 + ch;
    float lbv = 0.f;
    if (l > 0) {
      const float r0 = p.lb_raw[col], r1 = p.lb_raw[512 + col], r2 = p.lb_raw[1024 + col], r3 = p.lb_raw[1536 + col];
      const float m = fmaxf(fmaxf(r0, r1), fmaxf(r2, r3));
      const float e0 = __expf(r0 - m), e1 = __expf(r1 - m), e2 = __expf(r2 - m), e3 = __expf(r3 - m);
      const float inv = 1.f / (e0 + e1 + e2 + e3);
      lbv = e1 * inv;
      if (l > 1) lbv += e2 * inv;
      if (l > 2) lbv += e3 * inv;
    }
    {
      u32x4 rq[4], rf[4];
#pragma unroll
      for (int i = 0; i < 4; i++) {
        const int idx = tid + i * 256, row = idx >> 4, c8 = (idx & 15) * 8;
        rq[i] = *(const u32x4*)(z + (size_t)(tok0 + row) * ZS + ZA_Q + hd * 128 + c8);
        rf[i] = *(const u32x4*)(z + (size_t)(tok0 + row) * ZS + ZA_F + hd * 128 + c8);
      }
#pragma unroll
      for (int i = 0; i < 4; i++) {
        const int idx = tid + i * 256, row = idx >> 4, c8 = (idx & 15) * 8;
        *(u32x4*)(sq + row * 136 + c8) = rq[i];
        *(u32x4*)(skt + row * 136 + c8) = rf[i];
      }
    }
    __syncthreads();
    float bb[32];
    float run = 0.f;
#pragma unroll
    for (int t = 0; t < 32; t++) {
      const float zf = bf2f(skt[(hb * 32 + t) * 136 + ch]);
      const float f = lbv + (1.f - lbv) * sigm(zf);
      const float logf = (lbv > 0.f) ? __logf(f) : (fminf(zf, 0.f) - __logf(1.f + __expf(-fabsf(zf))));
      run += logf;
      bb[t] = run;
    }
    const float blast = run;
#pragma unroll
    for (int t = 0; t < 32; t++) {
      const int o = (hb * 32 + t) * 136 + ch;
      const float zq = bf2f(sq[o]), zf = bf2f(skt[o]);
      const float qv = silu(zq), kv = (1.f - lbv) * sigm(-zf);
      sq[o] = f2bf(qv * __expf(bb[t]));
      skt[o] = f2bf(kv * __expf(fminf(-bb[t], 80.f)));
      skh[o] = f2bf(kv * __expf(blast - bb[t]));
    }
    sd[hb * 128 + ch] = __expf(blast);
  }
  __syncthreads();
  {
    u16* qk = (u16*)(p.ws + WS_HQK);
    const int ti = wid;
    for (int si = 0; si < 4; si++) {
      f32x4 acc = (f32x4){0.f, 0.f, 0.f, 0.f};
      const bool upper = (ti < 2 && si >= 2);
      const bool cross = (ti >= 2 && si < 2);
      if (!upper && !((ti >> 1) == (si >> 1) && si > ti))
        acc = mma_lds_<128>(lane, sq + ti * 16 * 136, 136, (cross ? skh : skt) + si * 16 * 136, 136, acc);
#pragma unroll
      for (int e = 0; e < 4; e++) {
        const int t = ti * 16 + fq * 4 + e, s = si * 16 + fr;
        float v = acc[e];
        if (!cross && s > t) v = 0.f;
        qk[(size_t)(tok0 + t) * 256 + hd * 64 + s] = f2bf(v);
      }
    }
  }
  {
#pragma unroll 4
    for (int i = 0; i < 32; i++) {
      const int e = tid + i * 256, t = e >> 7, ch = e & 127;
      float v = bf2f(sq[t * 136 + ch]);
      if (t >= 32) v *= sd[ch];
      z[(size_t)(tok0 + t) * ZS + ZA_Q + hd * 128 + ch] = f2bf(v);
    }
    u16* kpt = (u16*)(p.ws + WS_HKPT) + (size_t)(c * 4 + hd) * 128 * 64;
#pragma unroll 4
    for (int i = 0; i < 32; i++) {
      const int e = tid + i * 256, dk = e >> 6, t = e & 63;
      float v = bf2f(skh[t * 136 + dk]);
      if (t < 32) v *= sd[128 + dk];
      kpt[dk * 64 + t] = f2bf(v);
    }
    if (tid < 128) ((float*)(p.ws + WS_HDA))[c * 512 + hd * 128 + tid] = sd[tid] * sd[128 + tid];
  }
  __syncthreads();
}

__device__ __forceinline__ void gdn_prep(u16* smem, const Params& p, int l, int c, int hd) {
  const u16* z = (const u16*)(p.ws + WS_Z);
  u16* sq = smem;
  u16* sk = smem + 64 * 136;
  u16* sv = smem + 2 * 64 * 136;
  float* sAm = (float*)(smem + 3 * 64 * 136);
  float* sgc = sAm + 64 * 68;
  float* sbeta = sgc + 64;
  OPAQUE_TID(tid);
  const int lane = tid & 63, wid = tid >> 6, fr = lane & 15, fq = lane >> 4;
  const int tok0 = c * 64;
  const bool first = (c == 0) || (c >= 256);
  const int sb = c - 256;
  u16* sraw = (u16*)sAm;
  u32x4 rraw[3][5];
#pragma unroll
  for (int part = 0; part < 3; part++)
#pragma unroll
    for (int i = 0; i < 5; i++) {
      const int idx = tid + i * 256, row = idx >> 4, c8 = (idx & 15) * 8, rr = row - 3;
      const int colq = part * 512 + hd * 128 + c8;
      u32x4 v = (u32x4){0u, 0u, 0u, 0u};
      if (idx < 67 * 16) {
        if (rr >= 0 || !first) {
          v = *(const u32x4*)(z + (size_t)(tok0 + rr) * ZS + ZC_Q + colq);
        } else if (c >= 256) {
          const float* st = p.st_gdn_conv + ((size_t)(l * 32 + sb) * 3 + row) * 1536 + colq;
          const float4 f0 = *(const float4*)st, f1 = *(const float4*)(st + 4);
          v = (u32x4){pack2(f0.x, f0.y), pack2(f0.z, f0.w), pack2(f1.x, f1.y), pack2(f1.z, f1.w)};
        }
      }
      rraw[part][i] = v;
    }
#pragma unroll
  for (int part = 0; part < 3; part++) {
    if (part > 0) __syncthreads();
#pragma unroll
    for (int i = 0; i < 5; i++) {
      const int idx = tid + i * 256, row = idx >> 4, c8 = (idx & 15) * 8;
      if (idx < 67 * 16) *(u32x4*)(sraw + row * 136 + c8) = rraw[part][i];
    }
    __syncthreads();
    {
      const int cc = tid & 127, half = tid >> 7, colq = part * 512 + hd * 128 + cc;
      const float* cw = p.c_conv_w + (size_t)l * 4 * 1536 + colq;
      const float w0 = cw[0], w1 = cw[1536], w2 = cw[2 * 1536], w3 = cw[3 * 1536];
      const u16* src = sraw + (half * 32) * 136 + cc;
      u16* dst = smem + part * 64 * 136 + (half * 32) * 136 + cc;
      float x0 = bf2f(src[0]), x1 = bf2f(src[136]), x2 = bf2f(src[2 * 136]);
#pragma unroll 8
      for (int t = 0; t < 32; t++) {
        const float x3 = bf2f(src[(t + 3) * 136]);
        const float y = w0 * x0 + w1 * x1 + w2 * x2 + w3 * x3;
        dst[t * 136] = f2bf(silu(y));
        x0 = x1; x1 = x2; x2 = x3;
      }
      if ((c == 255 || c >= 256) && half == 0) {
        float* dsto = (c == 255) ? p.out + O_PGC + (size_t)l * 3 * 1536 : p.out + O_SGC + (size_t)(l * 32 + sb) * 3 * 1536;
#pragma unroll
        for (int j = 0; j < 3; j++) dsto[j * 1536 + colq] = bf2f(sraw[(64 + j) * 136 + cc]);
      }
    }
  }
  __syncthreads();
  {
    const int t = tid >> 2, qd = tid & 3;
#pragma unroll
    for (int part = 0; part < 2; part++) {
      u16* r = smem + part * 64 * 136 + t * 136 + qd * 32;
      float ss = 0.f;
#pragma unroll
      for (int i = 0; i < 32; i++) { const float v = bf2f(r[i]); ss += v * v; }
      ss += __shfl_xor(ss, 1);
      ss += __shfl_xor(ss, 2);
      const float sc = rsqrtf(ss + EPS) * (part == 0 ? 0.08838834764831845f : 1.f);
#pragma unroll
      for (int i = 0; i < 32; i++) r[i] = f2bf(bf2f(r[i]) * sc);
    }
  }
  if (tid < 64) {
    const float beta = sigm(bf2f(z[(size_t)(tok0 + tid) * ZS + ZC_BETA + hd]));
    const float al = bf2f(z[(size_t)(tok0 + tid) * ZS + ZC_ALPHA + hd]);
    float g = -__expf(p.c_a_log[l * 4 + hd]) * softplus(al + p.c_dt_bias[l * 4 + hd]);
#pragma unroll
    for (int o = 1; o < 64; o <<= 1) {
      const float v = __shfl_up(g, o);
      if (lane >= o) g += v;
    }
    sgc[tid] = g;
    sbeta[tid] = beta;
  }
  __syncthreads();
  {
    u16* gqk = (u16*)(p.ws + WS_G) + G_QK;
    const int ti = wid;
    for (int si = 0; si < 4; si++) {
      f32x4 a1 = (f32x4){0.f, 0.f, 0.f, 0.f}, a2 = (f32x4){0.f, 0.f, 0.f, 0.f};
      if (si <= ti) {
        a1 = mma_lds_<128>(lane, sk + ti * 16 * 136, 136, sk + si * 16 * 136, 136, a1);
        a2 = mma_lds_<128>(lane, sq + ti * 16 * 136, 136, sk + si * 16 * 136, 136, a2);
      }
#pragma unroll
      for (int e = 0; e < 4; e++) {
        const int t = ti * 16 + fq * 4 + e, s = si * 16 + fr;
        const float dec = (s <= t) ? __expf(sgc[t] - sgc[s]) : 0.f;
        sAm[s * 68 + t] = (s < t) ? sbeta[t] * a1[e] * dec : 0.f;
        gqk[(size_t)(tok0 + t) * 256 + hd * 64 + s] = f2bf((s <= t) ? a2[e] * dec : 0.f);
      }
    }
  }
  __syncthreads();
  {
    const int col = tid & 127, isw = tid >> 7;
    const u16* src = isw ? sk : sv;
    u16* dst = (u16*)(p.ws + WS_G) + (isw ? G_W : G_U) + (size_t)tok0 * 512 + hd * 128 + col;
    float r[64];
#pragma unroll
    for (int t = 0; t < 64; t++) {
      float a = bf2f(src[t * 136 + col]) * sbeta[t];
      if (isw) a *= __expf(sgc[t]);
      r[t] = a;
    }
#pragma unroll
    for (int j = 0; j < 64; j++) {
      const float xj = r[j];
      *dst = f2bf(xj);
      dst += 512;
#pragma unroll
      for (int g = (j + 1) / 4; g < 16; g++) {
        const float4 a4 = *(const float4*)(sAm + j * 68 + g * 4);
        if (g * 4 > j) r[g * 4] -= a4.x * xj;
        if (g * 4 + 1 > j) r[g * 4 + 1] -= a4.y * xj;
        if (g * 4 + 2 > j) r[g * 4 + 2] -= a4.z * xj;
        if (g * 4 + 3 > j) r[g * 4 + 3] -= a4.w * xj;
      }
    }
  }
  {
    u16* gqp = (u16*)(p.ws + WS_G) + G_QP;
    const float gl = sgc[63];
#pragma unroll 4
    for (int i = 0; i < 32; i++) {
      const int e = tid + i * 256, t = e >> 7, cc = e & 127;
      gqp[(size_t)(tok0 + t) * 512 + hd * 128 + cc] = f2bf(bf2f(sq[t * 136 + cc]) * __expf(sgc[t]));
    }
    u16* kpt = (u16*)(p.ws + WS_G) + G_KPT + (size_t)(c * 4 + hd) * 128 * 64;
#pragma unroll 4
    for (int i = 0; i < 32; i++) {
      const int e = tid + i * 256, dk = e >> 6, t = e & 63;
      kpt[dk * 64 + t] = f2bf(bf2f(sk[t * 136 + dk]) * __expf(gl - sgc[t]));
    }
    if (tid == 0) ((float*)(p.ws + WS_GGL))[c * 4 + hd] = __expf(gl);
  }
  __syncthreads();
}

__device__ __forceinline__ void rglru_prep(u16* smem, const Params& p, int l, int c, int n) {
  const u16* z = (const u16*)(p.ws + WS_Z);
  float* sx = (float*)smem;
  float* su = sx + 64 * 65;
  u16* sxb = (u16*)(su + 64 * 65);
  u16* swa = sxb + 64 * 72;
  u16* swx = swa + 64 * 72;
  OPAQUE_TID(tid);
  const int lane = tid & 63, wid = tid >> 6, fr = lane & 15, fq = lane >> 4;
  const int tok0 = c * 64;
  const bool first = (c == 0) || (c >= 256);
  const int sb = c - 256;
  {
    const int ch = tid & 63, tq = tid >> 6, col = n * 64 + ch;
    const float* cw = p.b_conv_w + (size_t)l * 4 * 512 + col;
    const float w0 = cw[0], w1 = cw[512], w2 = cw[1024], w3 = cw[1536], bias = p.b_conv_b[l * 512 + col];
    u16* sraw = swx + 64 * 72;
    {
      u32x4 rr4[3];
#pragma unroll
      for (int i = 0; i < 3; i++) {
        const int idx = tid + i * 256, row = idx >> 3, c8 = (idx & 7) * 8, rr = row - 3;
        u32x4 v = (u32x4){0u, 0u, 0u, 0u};
        if (idx < 67 * 8) {
          if (rr >= 0 || !first) {
            v = *(const u32x4*)(z + (size_t)(tok0 + rr) * ZS + ZB_X + n * 64 + c8);
          } else if (c >= 256) {
            const float* st = p.st_rglru_conv + ((size_t)(l * 32 + sb) * 3 + row) * 512 + n * 64 + c8;
            const float4 f0 = *(const float4*)st, f1 = *(const float4*)(st + 4);
            v = (u32x4){pack2(f0.x, f0.y), pack2(f0.z, f0.w), pack2(f1.x, f1.y), pack2(f1.z, f1.w)};
          }
        }
        rr4[i] = v;
      }
#pragma unroll
      for (int i = 0; i < 3; i++) {
        const int idx = tid + i * 256, row = idx >> 3, c8 = (idx & 7) * 8;
        if (idx < 67 * 8) *(u32x4*)(sraw + row * 72 + c8) = rr4[i];
      }
    }
    __syncthreads();
    {
      const u16* src = sraw + (tq * 16) * 72 + ch;
      float x0 = bf2f(src[0]), x1 = bf2f(src[72]), x2 = bf2f(src[2 * 72]);
#pragma unroll 8
      for (int i = 0; i < 16; i++) {
        const int t = tq * 16 + i;
        const float x3 = bf2f(src[(i + 3) * 72]);
        const float y = w0 * x0 + w1 * x1 + w2 * x2 + w3 * x3 + bias;
        sx[t * 65 + ch] = y;
        sxb[t * 72 + ch] = f2bf(y);
        x0 = x1; x1 = x2; x2 = x3;
      }
    }
    const float* wa = p.b_ga_w + ((size_t)l * 8 + n) * 4096;
    const float* wx = p.b_gx_w + ((size_t)l * 8 + n) * 4096;
#pragma unroll
    for (int i = 0; i < 16; i++) {
      const int e = tid + i * 256, cin = e >> 6, d = e & 63;
      swa[d * 72 + cin] = f2bf(wa[e]);
      swx[d * 72 + cin] = f2bf(wx[e]);
    }
    if (c == 255 || c >= 256) {
      float* dst = (c == 255) ? p.out + O_PRC + (size_t)l * 3 * 512 : p.out + O_SRC + (size_t)(l * 32 + sb) * 3 * 512;
      if (tid < 192) {
        const int j = tid >> 6;
        dst[j * 512 + col] = bf2f(sraw[(64 + j) * 72 + ch]);
      }
    }
  }
  __syncthreads();
  f32x4 ra[4], rx[4];
  {
    const int ti = wid;
#pragma unroll
    for (int si = 0; si < 4; si++) {
      ra[si] = mma_lds_<64>(lane, sxb + ti * 16 * 72, 72, swa + si * 16 * 72, 72, (f32x4){0.f, 0.f, 0.f, 0.f});
      rx[si] = mma_lds_<64>(lane, sxb + ti * 16 * 72, 72, swx + si * 16 * 72, 72, (f32x4){0.f, 0.f, 0.f, 0.f});
    }
  }
  float lav[4][4], uv[4][4];
  {
    const int ti = wid;
#pragma unroll
    for (int si = 0; si < 4; si++) {
      const int d = si * 16 + fr, col = n * 64 + d;
      const float ba = p.b_ga_b[l * 512 + col], bx = p.b_gx_b[l * 512 + col];
      const float sp = softplus(-p.b_lambda[l * 512 + col]);
#pragma unroll
      for (int e = 0; e < 4; e++) {
        const int t = ti * 16 + fq * 4 + e;
        const float r = sigm(ra[si][e] + ba), ig = sigm(rx[si][e] + bx);
        const float la = -8.f * r * sp;
        float mult = sqrtf(fmaxf(1.f - __expf(2.f * la), 0.f));
        if (c == 0 && t == 0) mult = 1.f;
        const float u = mult * ig * sx[t * 65 + d];
        lav[si][e] = bf2f(f2bf(la));
        uv[si][e] = bf2f(f2bf(u));
      }
    }
  }
  __syncthreads();
  {
    const int ti = wid;
    u16* rla = (u16*)(p.ws + WS_RLA);
    u16* ru = (u16*)(p.ws + WS_RU);
#pragma unroll
    for (int si = 0; si < 4; si++) {
      const int d = si * 16 + fr, col = n * 64 + d;
#pragma unroll
      for (int e = 0; e < 4; e++) {
        const int t = ti * 16 + fq * 4 + e;
        sx[t * 65 + d] = lav[si][e];
        su[t * 65 + d] = uv[si][e];
        rla[(size_t)(tok0 + t) * 512 + col] = f2bf(lav[si][e]);
        ru[(size_t)(tok0 + t) * 512 + col] = f2bf(uv[si][e]);
      }
    }
  }
  __syncthreads();
  if (tid < 64) {
    float h = 0.f, sl = 0.f;
    for (int t = 0; t < 64; t++) {
      const float la = sx[t * 65 + tid];
      h = __expf(la) * h + su[t * 65 + tid];
      sl += la;
    }
    float* agg = (float*)(p.ws + WS_RAGG) + ((size_t)c * 512 + n * 64 + tid) * 2;
    agg[0] = sl;
    agg[1] = h;
  }
  __syncthreads();
}

__device__ __forceinline__ void rglru_scan(const Params& p, int l, int c, int hf) {
  OPAQUE_TID(tid);
  const int col = hf * 256 + tid;
  const int tok0 = c * 64;
  float h = 0.f;
  if (c >= 256) {
    h = p.st_rglru[(size_t)(l * 32 + (c - 256)) * 512 + col];
  } else {
    const float* agg = (const float*)(p.ws + WS_RAGG) + (size_t)col * 2;
    for (int cc = 0; cc < c; cc += 16) {
      float2 ab[16];
#pragma unroll
      for (int i = 0; i < 16; i++) ab[i] = *(const float2*)(agg + (size_t)min(cc + i, c - 1) * 1024);
#pragma unroll
      for (int i = 0; i < 16; i++) if (cc + i < c) h = __expf(ab[i].x) * h + ab[i].y;
    }
  }
  const u16* rla = (const u16*)(p.ws + WS_RLA) + (size_t)tok0 * 512 + col;
  u16* ru = (u16*)(p.ws + WS_RU) + (size_t)tok0 * 512 + col;
  for (int t0 = 0; t0 < 64; t0 += 32) {
    float la[32], u[32];
#pragma unroll
    for (int i = 0; i < 32; i++) { la[i] = bf2f(rla[(size_t)(t0 + i) * 512]); u[i] = bf2f(ru[(size_t)(t0 + i) * 512]); }
#pragma unroll
    for (int i = 0; i < 32; i++) {
      h = __expf(la[i]) * h + u[i];
      ru[(size_t)(t0 + i) * 512] = f2bf(h);
    }
  }
  if (c == 255) p.out[O_PR + (size_t)l * 512 + col] = h;
  else if (c >= 256) p.out[O_SR + (size_t)(l * 32 + (c - 256)) * 512 + col] = h;
}

template <bool GDN>
__device__ __forceinline__ void mat_scan(u16* smem, const Params& p, int l, int kind, int seg, int seq, int hd, int sl) {
  u16* z = (u16*)(p.ws + WS_Z);
  u16* sW = smem;
  u16* sQP = smem + 64 * 136;
  u16* sKT = smem + 2 * 64 * 136;
  u16* sQK = sKT + 128 * 72;
  u16* sSt = sQK + 64 * 72;
  u16* sVt = sSt + 32 * 136;
  OPAQUE_TID(tid);
  const int lane = tid & 63, wid = tid >> 6, fr = lane & 15, fq = lane >> 4;
  const int nchunk = (kind == 0) ? 1 : 16;
  const int c0 = (kind == 0) ? 255 + seq : seg * 16;
  const int cg = sl & 3;
  const int dvc = cg * 32 + fr;
  const bool full = (kind != 1);
  const bool uzero = (kind == 1 && sl >= 4);
  const int r16 = tid >> 4, c16 = (tid & 15) * 8;
  const int r8 = tid >> 3, c8 = (tid & 7) * 8;
  f32x4 S[2][2];
  f32x4 Dacc[2];
  { float one_ = 1.f; asm volatile("" : "+v"(one_)); Dacc[0] = (f32x4){one_, one_, one_, one_}; Dacc[1] = Dacc[0]; }
  if (kind == 0) {
    const float* st = (GDN ? p.st_gdn : p.st_hgrn) + ((size_t)(l * 32 + (seq - 1)) * 4 + hd) * 16384;
#pragma unroll
    for (int i = 0; i < 2; i++)
#pragma unroll
      for (int n = 0; n < 2; n++)
#pragma unroll
        for (int e = 0; e < 4; e++) S[i][n][e] = st[((wid * 2 + i) * 16 + fq * 4 + e) * 128 + dvc + n * 16];
  } else if (kind == 1) {
#pragma unroll
    for (int i = 0; i < 2; i++)
#pragma unroll
      for (int n = 0; n < 2; n++)
#pragma unroll
        for (int e = 0; e < 4; e++)
          S[i][n][e] = (sl >= 4 && ((wid * 2 + i) * 16 + fq * 4 + e) == (sl - 4) * 32 + n * 16 + fr) ? 1.f : 0.f;
  } else {
#pragma unroll
    for (int i = 0; i < 2; i++)
#pragma unroll
      for (int n = 0; n < 2; n++) S[i][n] = (f32x4){0.f, 0.f, 0.f, 0.f};
    if (!GDN) {
      const float* hs = (const float*)(p.ws + WS_HS);
      const float* hdp = (const float*)(p.ws + WS_HD);
#pragma unroll 4
      for (int j = 0; j < seg; j++) {
        f32x4 dj[2], sj[2][2];
#pragma unroll
        for (int i = 0; i < 2; i++) {
          dj[i] = *(const f32x4*)(hdp + (size_t)(j * 4 + hd) * 128 + (wid * 2 + i) * 16 + fq * 4);
#pragma unroll
          for (int n = 0; n < 2; n++)
#pragma unroll
            for (int e = 0; e < 4; e++)
              sj[i][n][e] = hs[((size_t)(j * 4 + hd) * 128 + (wid * 2 + i) * 16 + fq * 4 + e) * 128 + dvc + n * 16];
        }
#pragma unroll
        for (int i = 0; i < 2; i++)
#pragma unroll
          for (int n = 0; n < 2; n++) S[i][n] = S[i][n] * dj[i] + sj[i][n];
      }
    } else {
      const float* gb = (const float*)(p.ws + WS_GB);
      const u16* gp = (const u16*)(p.ws + WS_GP);
      u16* sP = smem;
      u32x4 rP[8];
      if (seg > 1) {
#pragma unroll
        for (int i = 0; i < 8; i++) rP[i] = *(const u32x4*)(gp + ((size_t)(1 * 4 + hd) * 128 + r16 + i * 16) * 128 + c16);
      }
      f32x4 bn[2][2];
#pragma unroll
      for (int i = 0; i < 2; i++)
#pragma unroll
        for (int n = 0; n < 2; n++)
#pragma unroll
          for (int e = 0; e < 4; e++)
            bn[i][n][e] = gb[((size_t)(0 * 4 + hd) * 128 + (wid * 2 + i) * 16 + fq * 4 + e) * 128 + dvc + n * 16];
      for (int j = 0; j < seg; j++) {
        f32x4 bj[2][2];
#pragma unroll
        for (int i = 0; i < 2; i++)
#pragma unroll
          for (int n = 0; n < 2; n++) bj[i][n] = bn[i][n];
        if (j == 0) {
#pragma unroll
          for (int i = 0; i < 2; i++)
#pragma unroll
            for (int n = 0; n < 2; n++) S[i][n] = bj[i][n];
          if (seg > 1) {
#pragma unroll
            for (int i = 0; i < 2; i++)
#pragma unroll
              for (int n = 0; n < 2; n++)
#pragma unroll
                for (int e = 0; e < 4; e++)
                  bn[i][n][e] = gb[((size_t)(1 * 4 + hd) * 128 + (wid * 2 + i) * 16 + fq * 4 + e) * 128 + dvc + n * 16];
          }
        } else {
          __syncthreads();
#pragma unroll
          for (int i = 0; i < 8; i++) *(u32x4*)(sP + (r16 + i * 16) * 136 + c16) = rP[i];
#pragma unroll
          for (int i = 0; i < 2; i++)
#pragma unroll
            for (int n = 0; n < 2; n++) {
              uint2 o2;
              o2.x = pack2(S[i][n][0], S[i][n][1]);
              o2.y = pack2(S[i][n][2], S[i][n][3]);
              *(uint2*)(sSt + (n * 16 + fr) * 136 + (wid * 2 + i) * 16 + fq * 4) = o2;
            }
          __syncthreads();
          if (j + 1 < seg) {
#pragma unroll
            for (int i = 0; i < 8; i++) rP[i] = *(const u32x4*)(gp + ((size_t)((j + 1) * 4 + hd) * 128 + r16 + i * 16) * 128 + c16);
#pragma unroll
            for (int i = 0; i < 2; i++)
#pragma unroll
              for (int n = 0; n < 2; n++)
#pragma unroll
                for (int e = 0; e < 4; e++)
                  bn[i][n][e] = gb[((size_t)((j + 1) * 4 + hd) * 128 + (wid * 2 + i) * 16 + fq * 4 + e) * 128 + dvc + n * 16];
          }
#pragma unroll
          for (int i = 0; i < 2; i++)
#pragma unroll
            for (int n = 0; n < 2; n++)
              S[i][n] = mma_lds_<128>(lane, sP + (wid * 2 + i) * 16 * 136, 136, sSt + n * 16 * 136, 136, bj[i][n]);
        }
      }
    }
  }
  const u16* gQP = GDN ? (const u16*)(p.ws + WS_G) + G_QP + hd * 128 : z + ZA_Q + hd * 128;
  const int ldqp = GDN ? 512 : ZS;
  const u16* gKT = GDN ? (const u16*)(p.ws + WS_G) + G_KPT : (const u16*)(p.ws + WS_HKPT);
  const u16* gQK = (GDN ? (const u16*)(p.ws + WS_G) + G_QK : (const u16*)(p.ws + WS_HQK)) + hd * 64;
  const u16* gW = (const u16*)(p.ws + WS_G) + G_W + hd * 128;
  const u16* gU = (const u16*)(p.ws + WS_G) + G_U + hd * 128 + dvc;
  u16* gO = z + (GDN ? ZC_V : ZA_I) + hd * 128 + dvc;

  u32x4 rQP[2][4], rW[2][4], rKT[2][4], rQK[2][2];
  unsigned rV[2][8];
  f32x4 rDv[2][2];
  float rG[2];
#define LOAD_REGS(ST, cx) do { \
    const int c_ = (cx); \
    const size_t tk0_ = (size_t)c_ * 64; \
    _Pragma("unroll") \
    for (int i = 0; i < 4; i++) { \
      if (full) rQP[ST][i] = *(const u32x4*)(gQP + (tk0_ + r16 + i * 16) * ldqp + c16); \
      if (GDN) rW[ST][i] = *(const u32x4*)(gW + (tk0_ + r16 + i * 16) * 512 + c16); \
      rKT[ST][i] = *(const u32x4*)(gKT + ((size_t)(c_ * 4 + hd) * 128 + r8 + i * 32) * 64 + c8); \
    } \
    if (full) { \
    _Pragma("unroll") \
      for (int i = 0; i < 2; i++) rQK[ST][i] = *(const u32x4*)(gQK + (tk0_ + r8 + i * 32) * 256 + c8); \
    } \
    if (GDN) { \
    _Pragma("unroll") \
      for (int n = 0; n < 2; n++) \
    _Pragma("unroll") \
        for (int e = 0; e < 4; e++) rV[ST][n * 4 + e] = uzero ? 0u : (unsigned)gU[(tk0_ + wid * 16 + fq * 4 + e) * 512 + n * 16]; \
      rG[ST] = ((const float*)(p.ws + WS_GGL))[c_ * 4 + hd]; \
    } else { \
    _Pragma("unroll") \
      for (int i = 0; i < 8; i++) { \
        const int e = tid + i * 256; \
        rV[ST][i] = z[(tk0_ + (e >> 5)) * ZS + ZA_I + hd * 128 + cg * 32 + (e & 31)]; \
      } \
      const float* da = (const float*)(p.ws + WS_HDA) + (size_t)c_ * 512 + hd * 128; \
    _Pragma("unroll") \
      for (int i = 0; i < 2; i++) rDv[ST][i] = *(const f32x4*)(da + (wid * 2 + i) * 16 + fq * 4); \
    } \
  } while (0)
#define SCAN_STEP(ST, cix) do { \
    const int ci_ = (cix); \
    const int c = c0 + ci_; \
    const size_t tok0 = (size_t)c * 64; \
    __syncthreads(); \
    _Pragma("unroll") \
    for (int i = 0; i < 4; i++) { \
      if (full) *(u32x4*)(sQP + (r16 + i * 16) * 136 + c16) = rQP[ST][i]; \
      if (GDN) *(u32x4*)(sW + (r16 + i * 16) * 136 + c16) = rW[ST][i]; \
      *(u32x4*)(sKT + (r8 + i * 32) * 72 + c8) = rKT[ST][i]; \
    } \
    if (full) { \
    _Pragma("unroll") \
      for (int i = 0; i < 2; i++) *(u32x4*)(sQK + (r8 + i * 32) * 72 + c8) = rQK[ST][i]; \
    } \
    _Pragma("unroll") \
    for (int i = 0; i < 2; i++) \
    _Pragma("unroll") \
      for (int n = 0; n < 2; n++) { \
        uint2 o2; \
        o2.x = pack2(S[i][n][0], S[i][n][1]); \
        o2.y = pack2(S[i][n][2], S[i][n][3]); \
        *(uint2*)(sSt + (n * 16 + fr) * 136 + (wid * 2 + i) * 16 + fq * 4) = o2; \
      } \
    float uu[8]; \
    if (GDN) { \
    _Pragma("unroll") \
      for (int e = 0; e < 8; e++) uu[e] = bf2f((u16)rV[ST][e]); \
    } else { \
    _Pragma("unroll") \
      for (int i = 0; i < 8; i++) { \
        const int e = tid + i * 256; \
        sVt[(e & 31) * 72 + (e >> 5)] = (u16)rV[ST][i]; \
      } \
    } \
    __syncthreads(); \
    float g_ = 0.f; f32x4 dv0_, dv1_; \
    if (GDN) { g_ = rG[ST]; asm volatile("" : "+v"(g_), "+v"(uu[0]), "+v"(uu[1]), "+v"(uu[2]), "+v"(uu[3]), "+v"(uu[4]), "+v"(uu[5]), "+v"(uu[6]), "+v"(uu[7]) :: "memory"); } \
    else { dv0_ = rDv[ST][0]; dv1_ = rDv[ST][1]; asm volatile("" : "+v"(dv0_), "+v"(dv1_) :: "memory"); } \
    if (ci_ + 2 < nchunk) LOAD_REGS(ST, c + 2); \
    f32x4 o[2]; \
    o[0] = (f32x4){0.f, 0.f, 0.f, 0.f}; o[1] = o[0]; \
    if (full) { \
    _Pragma("unroll") \
      for (int n = 0; n < 2; n++) o[n] = mma_lds_<128>(lane, sQP + wid * 16 * 136, 136, sSt + n * 16 * 136, 136, o[n]); \
    } \
    if (GDN) { \
    _Pragma("unroll") \
      for (int n = 0; n < 2; n++) { \
        f32x4 a = mma_lds_<128>(lane, sW + wid * 16 * 136, 136, sSt + n * 16 * 136, 136, (f32x4){0.f, 0.f, 0.f, 0.f}); \
        uint2 ov; \
        ov.x = pack2(uu[n * 4 + 0] - a[0], uu[n * 4 + 1] - a[1]); \
        ov.y = pack2(uu[n * 4 + 2] - a[2], uu[n * 4 + 3] - a[3]); \
        *(uint2*)(sVt + (n * 16 + fr) * 72 + wid * 16 + fq * 4) = ov; \
      } \
      __syncthreads(); \
    } \
    if (full) { \
    _Pragma("unroll") \
      for (int n = 0; n < 2; n++) { \
        o[n] = mma_lds_<64>(lane, sQK + wid * 16 * 72, 72, sVt + n * 16 * 72, 72, o[n]); \
    _Pragma("unroll") \
        for (int e = 0; e < 4; e++) gO[(tok0 + wid * 16 + fq * 4 + e) * ZS + n * 16] = f2bf(o[n][e]); \
      } \
    } \
    if (GDN) { \
      const float gs_ = __int_as_float(__builtin_amdgcn_readfirstlane(__float_as_int(g_))); \
    _Pragma("unroll") \
      for (int i = 0; i < 2; i++) { S[i][0] *= gs_; S[i][1] *= gs_; } \
    } else { \
      S[0][0] *= dv0_; S[0][1] *= dv0_; S[1][0] *= dv1_; S[1][1] *= dv1_; \
      Dacc[0] *= dv0_; Dacc[1] *= dv1_; \
    } \
    _Pragma("unroll") \
    for (int i = 0; i < 2; i++) \
    _Pragma("unroll") \
      for (int n = 0; n < 2; n++) \
        S[i][n] = mma_lds_<64>(lane, sKT + (wid * 2 + i) * 16 * 72, 72, sVt + n * 16 * 72, 72, S[i][n]); \
  } while (0)
  __syncthreads();
  LOAD_REGS(0, c0);
  if (nchunk > 1) LOAD_REGS(1, c0 + 1);
  for (int ci = 0; ci < nchunk; ci += 2) {
    SCAN_STEP(0, ci);
    if (ci + 1 < nchunk) SCAN_STEP(1, ci + 1);
  }
  if (kind == 1) {
    if (GDN && sl >= 4) {
      u16* gp = (u16*)(p.ws + WS_GP) + (size_t)(seg * 4 + hd) * 16384;
#pragma unroll
      for (int i = 0; i < 2; i++)
#pragma unroll
        for (int n = 0; n < 2; n++)
#pragma unroll
          for (int e = 0; e < 4; e++) gp[((wid * 2 + i) * 16 + fq * 4 + e) * 128 + (sl - 4) * 32 + n * 16 + fr] = f2bf(S[i][n][e]);
    } else {
      float* dst = (float*)(p.ws + (GDN ? WS_GB : WS_HS)) + (size_t)(seg * 4 + hd) * 16384;
#pragma unroll
      for (int i = 0; i < 2; i++)
#pragma unroll
        for (int n = 0; n < 2; n++)
#pragma unroll
          for (int e = 0; e < 4; e++) dst[((wid * 2 + i) * 16 + fq * 4 + e) * 128 + dvc + n * 16] = S[i][n][e];
      if (!GDN && sl == 0 && fr == 0) {
        float* dd = (float*)(p.ws + WS_HD) + (size_t)(seg * 4 + hd) * 128;
#pragma unroll
        for (int i = 0; i < 2; i++) *(f32x4*)(dd + (wid * 2 + i) * 16 + fq * 4) = Dacc[i];
      }
    }
  } else if (kind == 0 || seg == 15) {
    float* dst;
    if (kind == 2) dst = p.out + (GDN ? O_PG : O_PH) + ((size_t)l * 4 + hd) * 16384;
    else dst = p.out + (GDN ? O_SG : O_SH) + ((size_t)(l * 32 + (seq - 1)) * 4 + hd) * 16384;
#pragma unroll
    for (int i = 0; i < 2; i++)
#pragma unroll
      for (int n = 0; n < 2; n++)
#pragma unroll
        for (int e = 0; e < 4; e++) dst[((wid * 2 + i) * 16 + fq * 4 + e) * 128 + dvc + n * 16] = S[i][n][e];
  }
  __syncthreads();
}

__device__ __forceinline__ void onorm_phase(const Params& p, int l) {
  u16* z = (u16*)(p.ws + WS_Z);
  u16* ru = (u16*)(p.ws + WS_RU);
  OPAQUE_TID(tid);
  const int lane = tid & 63, wid = tid >> 6;
  for (int row = blockIdx.x * 4 + wid; row < NTOK; row += gridDim.x * 4) {
    u16* zr = z + (size_t)row * ZS;
#pragma unroll
    for (int br = 0; br < 2; br++) {
      u16* po = zr + (br == 0 ? ZA_I : ZC_V) + lane * 8;
      const u16* pg = zr + (br == 0 ? ZA_G : ZC_G) + lane * 8;
      const float* nw = (br == 0 ? p.a_norm : p.c_norm) + l * 128 + (lane & 15) * 8;
      const uint4 vo = *(const uint4*)po, vg = *(const uint4*)pg;
      const unsigned uo[4] = {vo.x, vo.y, vo.z, vo.w}, ug[4] = {vg.x, vg.y, vg.z, vg.w};
      float o[8], g[8];
#pragma unroll
      for (int i = 0; i < 4; i++) {
        o[2 * i] = bf2f((u16)(uo[i] & 0xffff)); o[2 * i + 1] = bf2f((u16)(uo[i] >> 16));
        g[2 * i] = bf2f((u16)(ug[i] & 0xffff)); g[2 * i + 1] = bf2f((u16)(ug[i] >> 16));
      }
      float ss = 0.f;
#pragma unroll
      for (int i = 0; i < 8; i++) ss += o[i] * o[i];
      ss += __shfl_xor(ss, 1); ss += __shfl_xor(ss, 2); ss += __shfl_xor(ss, 4); ss += __shfl_xor(ss, 8);
      const float r = rsqrtf(ss * (1.f / 128.f) + EPS);
      unsigned res[4];
#pragma unroll
      for (int i = 0; i < 4; i++)
        res[i] = pack2(o[2 * i] * r * nw[2 * i] * silu(g[2 * i]), o[2 * i + 1] * r * nw[2 * i + 1] * silu(g[2 * i + 1]));
      *(uint4*)po = make_uint4(res[0], res[1], res[2], res[3]);
    }
    {
      u16* ph = ru + (size_t)row * 512 + lane * 8;
      const u16* pg = zr + ZB_G + lane * 8;
      const uint4 vo = *(const uint4*)ph, vg = *(const uint4*)pg;
      const unsigned uo[4] = {vo.x, vo.y, vo.z, vo.w}, ug[4] = {vg.x, vg.y, vg.z, vg.w};
      unsigned res[4];
#pragma unroll
      for (int i = 0; i < 4; i++) {
        const float h0 = bf2f((u16)(uo[i] & 0xffff)), h1 = bf2f((u16)(uo[i] >> 16));
        const float g0 = bf2f((u16)(ug[i] & 0xffff)), g1 = bf2f((u16)(ug[i] >> 16));
        res[i] = pack2(gelu_t(g0) * h0, gelu_t(g1) * h1);
      }
      *(uint4*)ph = make_uint4(res[0], res[1], res[2], res[3]);
    }
  }
}

__device__ __forceinline__ void prep_phase(u16* smem, const Params& p, int l, bool dup) {
  for (int t = blockIdx.x; t < 4608; t += gridDim.x) {
    if (t < 1152) gdn_prep(smem, p, l, t >> 2, t & 3);
    else if (t < 2304) { if (!dup) hgrn_prep(smem, p, l, (t - 1152) >> 2, (t - 1152) & 3); }
    else rglru_prep(smem, p, l, (t - 2304) >> 3, (t - 2304) & 7);
  }
}

__device__ __forceinline__ void scan_phase(u16* smem, const Params& p, int l, int pass) {
  const int ntask = pass ? 512 : (720 + 576 + 1024);
  for (int t = blockIdx.x; t < ntask; t += gridDim.x) {
    bool isg; int kind, seg = 0, seq = 0, hd, sl;
    if (pass) {
      kind = 2;
      if (t < 256) { isg = true; seg = 15 - (t >> 4); hd = (t >> 2) & 3; sl = t & 3; }
      else { const int u = t - 256; isg = false; seg = u >> 4; hd = (u >> 2) & 3; sl = u & 3; }
    } else {
      if (t >= 720 && t < 1296) { rglru_scan(p, l, (t - 720) >> 1, (t - 720) & 1); continue; }
      if (t < 480) { kind = 1; isg = true; seg = t >> 5; hd = (t >> 3) & 3; sl = t & 7; }
      else if (t < 720) { const int u = t - 480; kind = 1; isg = false; seg = u >> 4; hd = (u >> 2) & 3; sl = u & 3; }
      else if (t < 1296 + 512) { const int u = t - 1296; kind = 0; isg = true; seq = 1 + (u >> 4); hd = (u >> 2) & 3; sl = u & 3; }
      else { const int u = t - 1808; kind = 0; isg = false; seq = 1 + (u >> 4); hd = (u >> 2) & 3; sl = u & 3; }
    }
    if (isg) mat_scan<true>(smem, p, l, kind, seg, seq, hd, sl);
    else mat_scan<false>(smem, p, l, kind, seg, seq, hd, sl);
  }
}

__device__ __forceinline__ void run_phase(u16* smem, const Params& p, int l, int ph, bool dup = false) {
#ifdef ONLY_PH
  if (ph != ONLY_PH) return;
  ph = ONLY_PH;
#endif
  u16* Z = (u16*)(p.ws + WS_Z);
  u16* WB = (u16*)(p.ws + WS_WB);
  u16* H = (u16*)(p.ws + WS_H);
  u16* Y = (u16*)(p.ws + WS_Y);
  if (ph == 0 || ph == 7 || ph == 10) {
    const bool fi = (ph == 0);
    const u16* y = fi ? nullptr : Y;
    const float* postw = ((ph == 7) ? opq(p.n_post_mix) : opq(p.n_post_mlp)) + l * D;
    const float* npm = opq(p.n_pre_mix);
    const float* prew = (ph == 0) ? npm : (ph == 7) ? opq(p.n_pre_mlp) + l * D : ((l + 1 < DEPTH) ? npm + (l + 1) * D : nullptr);
    rowpass_phase(p, fi, y, postw, prew, H);
    const int wl = (ph == 0) ? 0 : l + 1;
    if (ph != 7 && wl < DEPTH) wconv_phase(smem, p, wl);
  } else if (ph == 1 || ph == 6 || ph == 8 || ph == 9) {
    const u16* A = (ph == 9) ? Z : H;
    const int lda = (ph == 9) ? 4096 : 1024;
    const u16* Bt = WB + ((ph == 1) ? WB_IN : (ph == 6) ? WB_OUT : (ph == 8) ? WB_UP : WB_DN);
    const int K = (ph == 9) ? 4096 : 1024;
    const int N = (ph == 1) ? ZS : (ph == 8) ? 4096 : 1024;
    u16* C = (ph == 1 || ph == 8) ? Z : Y;
    const int ldc = (ph == 1) ? ZS : (ph == 8) ? 4096 : 1024;
    gemm_big_phase(smem, A, lda, Bt, K, N, K, C, ldc, ph == 8 ? 1 : 0);
  } else if (ph == 2) prep_phase(smem, p, l, dup);
  else if (ph == 3 || ph == 11) scan_phase(smem, p, l, ph == 11 ? 1 : 0);
  else if (ph == 4) onorm_phase(p, l);
  else if (ph == 5) merge_big_phase(smem, p);
}

#if MULTI_LAUNCH
__global__ void __launch_bounds__(256, 2) phase_kernel(Params p, int l, int ph) {
  __shared__ __attribute__((aligned(16))) u16 smem[SMEM_BYTES / 2];
  run_phase(smem, p, l, ph);
}
#endif

#if !MULTI_LAUNCH
#define XB_TMO      128
#define XB_XCNT(j)  (256  + 64 * (j))
#define XB_XSUB(j)  (1280 + 64 * (j))
#define XB_XGEN(j)  (2304 + 64 * (j))
#define XB_TOP      3328
#define XB_TOPGEN   3392
#define XCD_BAR_WORDS 3456
#define XB_SPIN_CAP (1u << 18)
#define LAS __attribute__((address_space(3)))

__device__ __forceinline__ unsigned xb_ld(unsigned* p)              { return __hip_atomic_load(p, __ATOMIC_RELAXED, __HIP_MEMORY_SCOPE_AGENT); }
__device__ __forceinline__ unsigned xb_add(unsigned* p, unsigned v) { return __hip_atomic_fetch_add(p, v, __ATOMIC_RELAXED, __HIP_MEMORY_SCOPE_AGENT); }
__device__ __forceinline__ unsigned xb_xcc_id() { return (unsigned)__builtin_amdgcn_s_getreg((3 << 11) | 20) & 0xFu; }
#define XB_SPIN(cond, bar) do { unsigned _sp = 0; while (cond) { __builtin_amdgcn_s_sleep(1); \
    if ((++_sp & 255u) == 0u) { if (xb_ld(&(bar)[XB_TMO])) break; if (_sp > XB_SPIN_CAP) { atomicAdd(&(bar)[XB_TMO], 1u); break; } } } } while (0)

struct XcdBarrier {
    unsigned* bar; unsigned x;
    volatile LAS unsigned* st;
};

__device__ __forceinline__ XcdBarrier xcd_barrier_post(unsigned* bar, volatile LAS unsigned* st) {
    XcdBarrier b; b.bar = bar; b.x = xb_xcc_id(); b.st = st;
    if (threadIdx.x == 0) (void)xb_add(&bar[XB_XCNT(b.x)], 1u);
    return b;
}
__device__ __forceinline__ void xcd_barrier_complete(unsigned* bar, unsigned x, unsigned& nloc, unsigned& nx) {
    const unsigned G = gridDim.x * gridDim.y * gridDim.z;
    unsigned sum, cnt, mine, sp = 0u;
    for (;;) {
        sum = 0u; cnt = 0u; mine = 0u;
#pragma unroll
        for (unsigned j = 0; j < 16; ++j) { const unsigned c = xb_ld(&bar[XB_XCNT(j)]); sum += c; cnt += (c > 0u) ? 1u : 0u; mine = (j == x) ? c : mine; }
        if (sum == G) break;
        __builtin_amdgcn_s_sleep(1);
        if ((++sp & 255u) == 0u) { if (xb_ld(&bar[XB_TMO])) break; if (sp > XB_SPIN_CAP) { atomicAdd(&bar[XB_TMO], 1u); break; } }
    }
    nloc = mine > 0u ? mine : 1u; nx = cnt > 0u ? cnt : 1u;
}

__device__ __forceinline__ void xcd_barrier(const XcdBarrier& b) {
    asm volatile("s_waitcnt vmcnt(0)" ::: "memory");
    __syncthreads();
    if (threadIdx.x == 0) {
        unsigned* bar = b.bar;
        __builtin_amdgcn_s_waitcnt(0);
        unsigned nloc = b.st[0], nx = b.st[1];
        if (nloc == 0u) { xcd_barrier_complete(bar, b.x, nloc, nx); b.st[0] = nloc; b.st[1] = nx; }
        const unsigned old = xb_add(&bar[XB_XSUB(b.x)], 1u);
        const unsigned gen = old / nloc;
        if (old + 1u == (gen + 1u) * nloc) {
            __builtin_amdgcn_fence(__ATOMIC_RELEASE, "agent");
            asm volatile("s_waitcnt vmcnt(0)" ::: "memory");
            const unsigned og = xb_add(&bar[XB_TOP], 1u);
            const unsigned tg = og / nx;
            if (og + 1u == (tg + 1u) * nx) xb_add(&bar[XB_TOPGEN], 1u);
            else XB_SPIN(xb_ld(&bar[XB_TOPGEN]) == tg, bar);
            __builtin_amdgcn_fence(__ATOMIC_ACQUIRE, "agent");
            xb_add(&bar[XB_XGEN(b.x)], 1u);
            asm volatile("s_waitcnt vmcnt(0)" ::: "memory");
        } else {
            XB_SPIN(xb_ld(&bar[XB_XGEN(b.x)]) == gen, bar);
            __builtin_amdgcn_fence(__ATOMIC_ACQUIRE, "agent");
            asm volatile("s_waitcnt vmcnt(0)" ::: "memory");
        }
    }
    __syncthreads();
}


__global__ void __launch_bounds__(256, 2) mega_kernel(Params p) {
  __shared__ __attribute__((aligned(16))) u16 smem[SMEM_BYTES / 2 + 8];
  cg::grid_group grid = cg::this_grid();
  unsigned* xbw = (unsigned*)(smem + SMEM_BYTES / 2);
  if (threadIdx.x == 0) { xbw[0] = 0u; xbw[1] = 0u; xbw[2] = 0u; xbw[3] = 0u; }
  __syncthreads();
  XcdBarrier xb = xcd_barrier_post((unsigned*)(p.ws + WS_BAR), (volatile LAS unsigned*)xbw);
  if (p.ws == nullptr) grid.sync();
  for (int s = 0; s < 1 + DEPTH * 11; s++) {
    int l = 0, ph = 0;
    if (s > 0) {
      l = (s - 1) / 11;
      const int pi = (s - 1) % 11 + 1;
      ph = (pi <= 3) ? pi : (pi == 4) ? 11 : pi - 1;
    }
    run_phase(smem, p, l, ph);
    xcd_barrier(xb);
#ifdef DUP_MASK
    if (s > 0 && ((DUP_MASK >> ph) & 1)) { run_phase(smem, p, l, ph, true); xcd_barrier(xb); }
#endif
#ifdef EXTRA_SYNCS
    for (int i = 0; i < EXTRA_SYNCS; i++) xcd_barrier(xb);
#endif
  }
}
#endif

extern "C" void kernel_launch(void* const* d_in, const int* in_sizes, int n_in, void* d_out, int out_size, void* d_ws,
                              size_t ws_size, hipStream_t stream) {
  if (ws_size < WS_END) { fprintf(stderr, "workspace too small: %zu < %zu\n", ws_size, (size_t)WS_END); return; }
  Params p{};
  const float** pp = (const float**)&p;
  for (int i = 0; i < 31; i++) pp[i] = (const float*)d_in[i];
  p.out = (float*)d_out;
  p.ws = (char*)d_ws;
  static int grid_blocks = 0;
  if (!grid_blocks) {
    int dev = 0, cus = 0, per_cu = 0;
    hipGetDevice(&dev);
    hipDeviceGetAttribute(&cus, hipDeviceAttributeMultiprocessorCount, dev);
#if MULTI_LAUNCH
    hipOccupancyMaxActiveBlocksPerMultiprocessor(&per_cu, phase_kernel, 256, 0);
#else
    hipOccupancyMaxActiveBlocksPerMultiprocessor(&per_cu, mega_kernel, 256, 0);
#endif
    if (per_cu > 2) per_cu = 2;
    if (per_cu < 1) per_cu = 1;
    grid_blocks = cus * per_cu;
  }
#if MULTI_LAUNCH
  phase_kernel<<<grid_blocks, 256, 0, stream>>>(p, 0, 0);
  for (int l = 0; l < DEPTH; l++)
    for (int pi = 1; pi <= 11; pi++) phase_kernel<<<grid_blocks, 256, 0, stream>>>(p, l, (pi <= 3) ? pi : (pi == 4) ? 11 : pi - 1);
#else
  hipMemsetAsync((char*)d_ws + WS_BAR, 0, 16384, stream);
  void* args[] = {&p};
  hipError_t e = hipLaunchCooperativeKernel((void*)mega_kernel, dim3(grid_blocks), dim3(256), args, 0, stream);
  if (e != hipSuccess) fprintf(stderr, "cooperative launch failed: %s (grid %d)\n", hipGetErrorString(e), grid_blocks);
#endif
}
```

```cpp
#include <hip/hip_runtime.h>
#include <hip/hip_cooperative_groups.h>
#include <cstdio>
namespace cg = cooperative_groups;

#ifndef MULTI_LAUNCH
#define MULTI_LAUNCH 0
#endif

typedef unsigned short u16;
typedef __attribute__((ext_vector_type(8))) short bf16x8;
typedef __attribute__((ext_vector_type(4))) float f32x4;
typedef __attribute__((ext_vector_type(4))) unsigned int u32x4;

constexpr int D = 1024, NTOK = 18432, TP = 16384, NCHUNK = 288, DEPTH = 4, DFF = 4096;
constexpr int DIN = 8200, ZS = 8320;
constexpr int ZA_Q = 0, ZA_F = 512, ZA_I = 1024, ZA_G = 1536, ZB_X = 2048, ZB_G = 2560, ZC_Q = 3072, ZC_V = 4096,
              ZC_G = 4608, ZC_BETA = 5120, ZC_ALPHA = 5124, Z_MERGE = 5128;
constexpr float EPS = 1e-6f;

constexpr size_t O_YP = 0, O_YS = 16777216, O_PH = 18874368, O_PR = 19136512, O_PRC = 19138560, O_PG = 19144704,
                 O_PGC = 19406848, O_SH = 19425280, O_SR = 27813888, O_SRC = 27879424, O_SG = 28076032, O_SGC = 36464640;

constexpr size_t WS_Z = 0;
constexpr size_t WS_WB = WS_Z + (size_t)NTOK * ZS * 2;
constexpr size_t WB_IN = 0, WB_BR = (size_t)ZS * 1024, WB_OUT = WB_BR + 3 * 1024 * 512, WB_UP = WB_OUT + 1024 * 1024,
                 WB_DN = WB_UP + 4096 * 1024, WB_END = WB_DN + 4096 * 1024;
constexpr size_t WS_G = WS_WB + WB_END * 2;
constexpr size_t G_U = 0, G_W = (size_t)NTOK * 512, G_QP = 2 * G_W, G_KPT = 3 * G_W, G_QK = 4 * G_W, G_END = 4 * G_W + (size_t)NTOK * 256;
constexpr size_t WS_H = WS_G, WS_Y = WS_G + (size_t)NTOK * 1024 * 2;
constexpr size_t WS_HKPT = WS_G + G_END * 2;
constexpr size_t WS_HQK = WS_HKPT + (size_t)NTOK * 512 * 2;
constexpr size_t WS_HDA = WS_HQK + (size_t)NTOK * 256 * 2;
constexpr size_t WS_GGL = WS_HDA + (size_t)NCHUNK * 512 * 4;
constexpr size_t WS_RLA = WS_GGL + 8192;
constexpr size_t WS_RU = WS_RLA + (size_t)NTOK * 512 * 2;
constexpr size_t WS_RAGG = WS_RU + (size_t)NTOK * 512 * 2;
constexpr size_t WS_BAR = WS_RAGG + (size_t)NCHUNK * 512 * 8;
constexpr size_t WS_HS = WS_BAR + 16384;
constexpr size_t WS_HD = WS_HS + (size_t)15 * 4 * 16384 * 4;
constexpr size_t WS_GB = WS_HD + (size_t)15 * 4 * 128 * 4;
constexpr size_t WS_GP = WS_GB + (size_t)15 * 4 * 16384 * 4;
constexpr size_t WS_END = WS_GP + (size_t)15 * 4 * 16384 * 2;

struct Params {
  const float *x_prompt, *x_sample, *st_hgrn, *st_rglru, *st_rglru_conv, *st_gdn, *st_gdn_conv, *lb_raw, *n_pre_mix,
      *n_post_mix, *n_pre_mlp, *n_post_mlp, *w_in, *a_norm, *b_conv_w, *b_conv_b, *b_ga_w, *b_ga_b, *b_gx_w, *b_gx_b,
      *b_lambda, *c_conv_w, *c_a_log, *c_dt_bias, *c_norm, *w_br_a, *w_br_b, *w_br_c, *w_out, *w_up, *w_down;
  float* out;
  char* ws;
};

__device__ __forceinline__ u16 f2bf(float f) {
  unsigned u = __float_as_uint(f);
  u += 0x7fffu + ((u >> 16) & 1u);
  return (u16)(u >> 16);
}
__device__ __forceinline__ float bf2f(u16 h) { return __uint_as_float(((unsigned)h) << 16); }
__device__ __forceinline__ float sigm(float x) { return 1.f / (1.f + __expf(-x)); }
__device__ __forceinline__ float silu(float x) { return x * sigm(x); }
__device__ __forceinline__ float softplus(float x) { return fmaxf(x, 0.f) + __logf(1.f + __expf(-fabsf(x))); }
__device__ __forceinline__ float gelu_t(float x) {
  const float u = 1.5957691216f * (x + 0.044715f * x * x * x);
  return x * sigm(u);
}
__device__ __forceinline__ unsigned pack2(float a, float b) { return (unsigned)f2bf(a) | ((unsigned)f2bf(b) << 16); }

template <class T> __device__ __forceinline__ T* opq(T* x) { asm volatile("" : "+s"(x)); return x; }
#define OPAQUE_TID(t) int t = threadIdx.x; asm volatile("" : "+v"(t))

template <int K>
__device__ __forceinline__ f32x4 mma_lds_(int lane, const u16* a, int lda, const u16* b, int ldb, f32x4 acc) {
  const int r = lane & 15, q = lane >> 4;
  const u16* pa = a + r * lda + q * 8;
  const u16* pb = b + r * ldb + q * 8;
#pragma unroll
  for (int k = 0; k < K; k += 32) {
    bf16x8 af = *(const bf16x8*)(pa + k);
    bf16x8 bf = *(const bf16x8*)(pb + k);
    acc = __builtin_amdgcn_mfma_f32_16x16x32_bf16(af, bf, acc, 0, 0, 0);
  }
  return acc;
}

constexpr int BM = 128, BK = 64, LDT = 72;
constexpr int SMEM_BYTES = 75776;

template <int NJ>
__device__ __forceinline__ void gemm_tile(u16* smem, const u16* __restrict__ A, int lda, const u16* __restrict__ Bt,
                                          int ldb, int K, int m0, int n0, f32x4 (&acc)[4][NJ]) {
  OPAQUE_TID(tid);
  const int lane = tid & 63, wid = tid >> 6, wr = wid >> 1, wc = wid & 1, fr = lane & 15, fq = lane >> 4;
#pragma unroll
  for (int i = 0; i < 4; i++)
#pragma unroll
    for (int j = 0; j < NJ; j++) acc[i][j] = (f32x4){0.f, 0.f, 0.f, 0.f};
  const int lrow = tid >> 3, lc8 = (tid & 7) * 8;
  const u16* ga = A + (size_t)(m0 + lrow) * lda + lc8;
  const u16* gb = Bt + (size_t)(n0 + lrow) * ldb + lc8;
  u32x4 ra[4], rb[NJ];
#pragma unroll
  for (int i = 0; i < 4; i++) {
    ra[i] = *(const u32x4*)(ga + (size_t)i * 32 * lda);
    if (i < NJ) rb[i] = *(const u32x4*)(gb + (size_t)i * 32 * ldb);
  }
#pragma unroll
  for (int i = 0; i < 4; i++) {
    *(u32x4*)(smem + (lrow + i * 32) * LDT + lc8) = ra[i];
    if (i < NJ) *(u32x4*)(smem + BM * LDT + (lrow + i * 32) * LDT + lc8) = rb[i];
  }
  __syncthreads();
  const int nk = K / BK;
  for (int kt = 0; kt < nk; kt++) {
    const int cur = kt & 1;
    const bool more = (kt + 1 < nk);
    if (more) {
      ga += BK; gb += BK;
#pragma unroll
      for (int i = 0; i < 4; i++) {
        ra[i] = *(const u32x4*)(ga + (size_t)i * 32 * lda);
        if (i < NJ) rb[i] = *(const u32x4*)(gb + (size_t)i * 32 * ldb);
      }
    }
    const u16* a = smem + cur * 2 * BM * LDT + (wr * 64 + fr) * LDT + fq * 8;
    const u16* b = smem + cur * 2 * BM * LDT + BM * LDT + (wc * 16 * NJ + fr) * LDT + fq * 8;
#pragma unroll
    for (int ks = 0; ks < 2; ks++) {
      bf16x8 af[4], bf[NJ];
#pragma unroll
      for (int i = 0; i < 4; i++) {
        af[i] = *(const bf16x8*)(a + i * 16 * LDT + ks * 32);
        if (i < NJ) bf[i] = *(const bf16x8*)(b + i * 16 * LDT + ks * 32);
      }
#pragma unroll
      for (int i = 0; i < 4; i++)
#pragma unroll
        for (int j = 0; j < NJ; j++) acc[i][j] = __builtin_amdgcn_mfma_f32_16x16x32_bf16(af[i], bf[j], acc[i][j], 0, 0, 0);
    }
    if (more) {
      u16* sa = smem + (cur ^ 1) * 2 * BM * LDT;
#pragma unroll
      for (int i = 0; i < 4; i++) {
        *(u32x4*)(sa + (lrow + i * 32) * LDT + lc8) = ra[i];
        if (i < NJ) *(u32x4*)(sa + BM * LDT + (lrow + i * 32) * LDT + lc8) = rb[i];
      }
    }
    __syncthreads();
  }
}

__device__ __forceinline__ void tile_coords(int tile, int NT, int& mt, int& nt) {
  const int band = tile / (8 * NT), within = tile % (8 * NT);
  mt = band * 8 + (within & 7);
  nt = within >> 3;
}

__device__ __forceinline__ void gemm_phase(u16* smem, const u16* A, int lda, const u16* Bt, int ldb, int N, int K, u16* C, int ldc, int EPI) {
  const int NT = N / 128, MT = NTOK / 128;
  OPAQUE_TID(tid);
  const int lane = tid & 63, wid = tid >> 6, wr = wid >> 1, wc = wid & 1, fr = lane & 15, fq = lane >> 4;
  for (int tile = blockIdx.x; tile < MT * NT; tile += gridDim.x) {
    int mt, nt;
    tile_coords(tile, NT, mt, nt);
    f32x4 acc[4][4];
    gemm_tile<4>(smem, A, lda, Bt, ldb, K, mt * 128, nt * 128, acc);
#pragma unroll
    for (int i = 0; i < 4; i++)
#pragma unroll
      for (int j = 0; j < 4; j++)
#pragma unroll
        for (int e = 0; e < 4; e++) {
          const int row = mt * 128 + wr * 64 + i * 16 + fq * 4 + e, col = nt * 128 + wc * 64 + j * 16 + fr;
          float v = acc[i][j][e];
          if (EPI == 1) { v = fmaxf(v, 0.f); v = v * v; }
          C[(size_t)row * ldc + col] = f2bf(v);
        }
  }
}

__device__ __forceinline__ void glds16(const void* gsrc, unsigned lds_dst) {
  unsigned keep;
  asm volatile("s_mov_b32 %0, m0\n\ts_mov_b32 m0, %2\n\ts_nop 0\n\tglobal_load_lds_dwordx4 %1, off\n\ts_mov_b32 m0, %0"
               : "=&s"(keep) : "v"(gsrc), "s"(lds_dst) : "memory");
}

constexpr int BMB = 288, LDB_ = 40, STG = (BMB + 128) * LDB_;
constexpr int STGG = (BMB + 128) * 32;
__device__ __forceinline__ void gemm_big_phase(u16* smem, const u16* __restrict__ A, int lda, const u16* __restrict__ Bt, int ldb,
                                               int N, int K, u16* C, int ldc, int EPI) {
  const int NT = N / 128, MT = NTOK / BMB;
  OPAQUE_TID(tid);
  const int lane = tid & 63, wid = tid >> 6, wr = wid >> 1, wc = wid & 1, fr = lane & 15, fq = lane >> 4;
  const int nmc = (NT + 7) >> 3;
  const bool xcd_order = (gridDim.x == 512);
  const int nwork = xcd_order ? 8 * nmc * 64 : MT * NT;
  for (int w = blockIdx.x; w < nwork; w += gridDim.x) {
    int mt, nt;
    if (xcd_order) {
      const int q = (w >> 9) * 8 + (w & 7), slot = (w >> 3) & 63;
      mt = (q & 7) * 8 + (slot & 7); nt = (q >> 3) * 8 + (slot >> 3);
      if (nt >= NT) continue;
    } else {
      tile_coords(w, NT, mt, nt);
    }
    const int m0 = mt * BMB, n0 = nt * 128;
    f32x4 acc[9][4];
#pragma unroll
    for (int i = 0; i < 9; i++)
#pragma unroll
      for (int j = 0; j < 4; j++) acc[i][j] = (f32x4){0.f, 0.f, 0.f, 0.f};
    const int gl_row = lane >> 2, gl_c = (lane & 3) ^ ((lane >> 4) & 3);
    const unsigned oA = ((unsigned)(m0 + gl_row) * (unsigned)lda + gl_c * 8) * 2u;
    const unsigned oB = ((unsigned)(n0 + gl_row) * (unsigned)ldb + gl_c * 8) * 2u;
    const char* Ab = (const char*)A; const char* Bb = (const char*)Bt;
    const int pc = fq ^ (fr >> 2);
    const int nk = K / 32;
    const int uw = __builtin_amdgcn_readfirstlane(wid);
    const unsigned lds0 = (unsigned)__builtin_amdgcn_readfirstlane((int)(unsigned)(size_t)smem);
#define GG_STAGE(st_, kt_) do { \
      _Pragma("unroll") \
      for (int k_ = 0; k_ < 5; k_++) { \
        const int a_ = uw + 4 * k_; \
        if (a_ < 18) glds16(Ab + (oA + (unsigned)((16 * a_) * lda + (kt_) * 32) * 2u), lds0 + (unsigned)(((st_) * STGG + a_ * 512) * 2)); \
      } \
      _Pragma("unroll") \
      for (int k_ = 0; k_ < 2; k_++) { \
        const int b_ = uw + 4 * k_; \
        glds16(Bb + (oB + (unsigned)((16 * b_) * ldb + (kt_) * 32) * 2u), lds0 + (unsigned)(((st_) * STGG + 9216 + b_ * 512) * 2)); \
      } \
    } while (0)
    GG_STAGE(0, 0);
    asm volatile("s_waitcnt vmcnt(0)" ::: "memory");
    __syncthreads();
    for (int kt = 0; kt < nk; kt++) {
      const int cur = kt & 1;
      if (kt + 1 < nk) GG_STAGE(cur ^ 1, kt + 1);
      const u16* a = smem + cur * STGG + (wr * 144 + fr) * 32 + pc * 8;
      const u16* b = smem + cur * STGG + 9216 + (wc * 64 + fr) * 32 + pc * 8;
      bf16x8 bf[4];
#pragma unroll
      for (int j = 0; j < 4; j++) bf[j] = *(const bf16x8*)(b + j * 512);
#pragma unroll
      for (int i = 0; i < 9; i++) {
        const bf16x8 af = *(const bf16x8*)(a + i * 512);
#pragma unroll
        for (int j = 0; j < 4; j++) acc[i][j] = __builtin_amdgcn_mfma_f32_16x16x32_bf16(af, bf[j], acc[i][j], 0, 0, 0);
      }
      __builtin_amdgcn_sched_barrier(0);
      asm volatile("s_waitcnt vmcnt(0)" ::: "memory");
      __syncthreads();
    }
    {
      u16* scr = smem + STGG + wid * 16 * 72;
#pragma unroll
      for (int i = 0; i < 9; i++) {
#pragma unroll
        for (int j = 0; j < 4; j++)
#pragma unroll
          for (int e = 0; e < 4; e++) {
            float v = acc[i][j][e];
            if (EPI == 1) { v = fmaxf(v, 0.f); v = v * v; }
            scr[(fq * 4 + e) * 72 + j * 16 + fr] = f2bf(v);
          }
#pragma unroll
        for (int h = 0; h < 2; h++) {
          const int rr = h * 8 + (lane >> 3), cc = (lane & 7) * 8;
          const u32x4 v = *(const u32x4*)(scr + rr * 72 + cc);
          *(u32x4*)(C + (size_t)(m0 + wr * 144 + i * 16 + rr) * ldc + n0 + wc * 64 + cc) = v;
        }
      }
    }
  }
}

__device__ __forceinline__ void merge_phase(u16* smem, const Params& p) {
  const u16* z = (const u16*)(p.ws + WS_Z);
  const u16* wb = (const u16*)(p.ws + WS_WB) + WB_BR;
  const u16* ru = (const u16*)(p.ws + WS_RU);
  u16* H = (u16*)(p.ws + WS_H);
  const int NT = 8, MT = NTOK / 128;
  OPAQUE_TID(tid);
  const int lane = tid & 63, wid = tid >> 6, wr = wid >> 1, wc = wid & 1, fr = lane & 15, fq = lane >> 4;
  const int lrow = tid >> 3, lc8 = (tid & 7) * 8;
  for (int tile = blockIdx.x; tile < MT * NT; tile += gridDim.x) {
    int mt, nt;
    tile_coords(tile, NT, mt, nt);
    const int m0 = mt * 128, n0 = nt * 128;
    f32x4 tot[4][4], acc[4][4];
#pragma unroll
    for (int i = 0; i < 4; i++)
#pragma unroll
      for (int j = 0; j < 4; j++) { tot[i][j] = (f32x4){0.f, 0.f, 0.f, 0.f}; acc[i][j] = tot[i][j]; }
    u32x4 ra[4], rb[4];
    unsigned gv[4][4][2];
#define MG_LOAD(it_) do { \
      const int sg_ = (it_) >> 3, kk_ = (it_) & 7; \
      const u16* A_ = (sg_ == 0) ? z + ZA_I : (sg_ == 1) ? ru : z + ZC_V; \
      const int lda_ = (sg_ == 1) ? 512 : ZS; \
      const u16* ga_ = A_ + (size_t)(m0 + lrow) * lda_ + kk_ * 64 + lc8; \
      const u16* gb_ = wb + (size_t)sg_ * 1024 * 512 + (size_t)(n0 + lrow) * 512 + kk_ * 64 + lc8; \
      _Pragma("unroll") \
      for (int i = 0; i < 4; i++) ra[i] = *(const u32x4*)(ga_ + (size_t)i * 32 * lda_); \
      _Pragma("unroll") \
      for (int i = 0; i < 4; i++) rb[i] = *(const u32x4*)(gb_ + (size_t)i * 32 * 512); \
    } while (0)
#define MG_STORE(st_) do { \
      u16* sa_ = smem + (st_) * 2 * BM * LDT; \
      _Pragma("unroll") \
      for (int i = 0; i < 4; i++) *(u32x4*)(sa_ + (lrow + i * 32) * LDT + lc8) = ra[i]; \
      _Pragma("unroll") \
      for (int i = 0; i < 4; i++) *(u32x4*)(sa_ + BM * LDT + (lrow + i * 32) * LDT + lc8) = rb[i]; \
    } while (0)
    MG_LOAD(0);
    MG_STORE(0);
    __syncthreads();
    for (int it = 0; it < 24; it++) {
      const int cur = it & 1, sg = it >> 3, kk = it & 7;
      if (kk == 0) {
#pragma unroll
        for (int i = 0; i < 4; i++)
#pragma unroll
          for (int j = 0; j < 4; j++) {
            const u16* gp = z + (size_t)(m0 + wr * 64 + i * 16 + fq * 4) * ZS + Z_MERGE + sg * 1024 + n0 + wc * 64 + j * 16 + fr;
            gv[i][j][0] = (unsigned)gp[0] | ((unsigned)gp[ZS] << 16);
            gv[i][j][1] = (unsigned)gp[2 * ZS] | ((unsigned)gp[3 * ZS] << 16);
          }
      }
      if (it + 1 < 24) MG_LOAD(it + 1);
      const u16* a = smem + cur * 2 * BM * LDT + (wr * 64 + fr) * LDT + fq * 8;
      const u16* b = smem + cur * 2 * BM * LDT + BM * LDT + (wc * 64 + fr) * LDT + fq * 8;
#pragma unroll
      for (int ks = 0; ks < 2; ks++) {
        bf16x8 af[4], bf[4];
#pragma unroll
        for (int i = 0; i < 4; i++) af[i] = *(const bf16x8*)(a + i * 16 * LDT + ks * 32);
#pragma unroll
        for (int j = 0; j < 4; j++) bf[j] = *(const bf16x8*)(b + j * 16 * LDT + ks * 32);
#pragma unroll
        for (int i = 0; i < 4; i++)
#pragma unroll
          for (int j = 0; j < 4; j++) acc[i][j] = __builtin_amdgcn_mfma_f32_16x16x32_bf16(af[i], bf[j], acc[i][j], 0, 0, 0);
      }
      if (it + 1 < 24) MG_STORE(cur ^ 1);
      if (kk == 7) {
#pragma unroll
        for (int i = 0; i < 4; i++)
#pragma unroll
          for (int j = 0; j < 4; j++) {
            tot[i][j][0] += sigm(bf2f((u16)(gv[i][j][0] & 0xffff))) * acc[i][j][0];
            tot[i][j][1] += sigm(bf2f((u16)(gv[i][j][0] >> 16))) * acc[i][j][1];
            tot[i][j][2] += sigm(bf2f((u16)(gv[i][j][1] & 0xffff))) * acc[i][j][2];
            tot[i][j][3] += sigm(bf2f((u16)(gv[i][j][1] >> 16))) * acc[i][j][3];
            acc[i][j] = (f32x4){0.f, 0.f, 0.f, 0.f};
          }
      }
      __syncthreads();
    }
#pragma unroll
    for (int i = 0; i < 4; i++)
#pragma unroll
      for (int j = 0; j < 4; j++)
#pragma unroll
        for (int e = 0; e < 4; e++) {
          const int row = m0 + wr * 64 + i * 16 + fq * 4 + e, col = n0 + wc * 64 + j * 16 + fr;
          H[(size_t)row * 1024 + col] = f2bf(tot[i][j][e]);
        }
  }
}

__device__ __forceinline__ void merge_big_phase(u16* smem, const Params& p) {
  const u16* z = (const u16*)(p.ws + WS_Z);
  const u16* wb = (const u16*)(p.ws + WS_WB) + WB_BR;
  const u16* ru = (const u16*)(p.ws + WS_RU);
  u16* H = (u16*)(p.ws + WS_H);
  const int NT = 8, MT = NTOK / BMB;
  OPAQUE_TID(tid);
  const int lane = tid & 63, wid = tid >> 6, wr = wid >> 1, wc = wid & 1, fr = lane & 15, fq = lane >> 4;
  for (int tile = blockIdx.x; tile < MT * NT; tile += gridDim.x) {
    int mt, nt;
    tile_coords(tile, NT, mt, nt);
    const int m0 = mt * BMB, n0 = nt * 128;
    f32x4 acc[9][4];
#pragma unroll
    for (int i = 0; i < 9; i++)
#pragma unroll
      for (int j = 0; j < 4; j++) acc[i][j] = (f32x4){0.f, 0.f, 0.f, 0.f};
    const int gl_row = lane >> 2, gl_c = (lane & 3) ^ ((lane >> 4) & 3);
    const int pc = fq ^ (fr >> 2);
    const int uw = __builtin_amdgcn_readfirstlane(wid);
    const unsigned lds0 = (unsigned)__builtin_amdgcn_readfirstlane((int)(unsigned)(size_t)smem);
#define MB_STAGE(st_, it_) do { \
      const int sg_ = (it_) >> 4, kk_ = (it_) & 15; \
      const char* A_ = (const char*)((sg_ == 0) ? z + ZA_I : (sg_ == 1) ? ru : z + ZC_V); \
      const int lda_ = (sg_ == 1) ? 512 : ZS; \
      const char* B_ = (const char*)(wb + (size_t)sg_ * 1024 * 512); \
      const unsigned oA_ = ((unsigned)(m0 + gl_row) * (unsigned)lda_ + gl_c * 8 + kk_ * 32) * 2u; \
      const unsigned oB_ = ((unsigned)(n0 + gl_row) * 512u + gl_c * 8 + kk_ * 32) * 2u; \
      _Pragma("unroll") \
      for (int k_ = 0; k_ < 5; k_++) { \
        const int a_ = uw + 4 * k_; \
        if (a_ < 18) glds16(A_ + (oA_ + (unsigned)(16 * a_ * lda_) * 2u), lds0 + (unsigned)(((st_) * STGG + a_ * 512) * 2)); \
      } \
      _Pragma("unroll") \
      for (int k_ = 0; k_ < 2; k_++) { \
        const int b_ = uw + 4 * k_; \
        glds16(B_ + (oB_ + (unsigned)(16 * b_ * 512) * 2u), lds0 + (unsigned)(((st_) * STGG + 9216 + b_ * 512) * 2)); \
      } \
    } while (0)
#define MB_GSTRIP_LOAD(G_, i_) do { \
        int t_ = tid; asm volatile("" : "+v"(t_)); \
        const int ln_ = t_ & 63, wd_ = t_ >> 6; \
        _Pragma("unroll") \
        for (int h = 0; h < 2; h++) { \
          const int rr = h * 8 + (ln_ >> 3), cc = (ln_ & 7) * 8; \
          nv[h] = *(const u32x4*)(z + (size_t)(m0 + (wd_ >> 1) * 144 + (i_) * 16 + rr) * ZS + Z_MERGE + (G_) * 1024 + n0 + (wd_ & 1) * 64 + cc); \
        } \
      } while (0)
#define MB_GATE(G_, INV) do { \
      u32x4 nv[2]; \
      MB_GSTRIP_LOAD(G_, 0); \
      _Pragma("unroll") \
      for (int i = 0; i < 9; i++) { \
        int t_ = tid; asm volatile("" : "+v"(t_));     \
        const int ln_ = t_ & 63, wd_ = t_ >> 6, fr_ = ln_ & 15, fq_ = ln_ >> 4; \
        u16* scr_ = smem + 2 * STGG + wd_ * 16 * 72; \
        _Pragma("unroll") \
        for (int h = 0; h < 2; h++) { \
          const int rr = h * 8 + (ln_ >> 3), cc = (ln_ & 7) * 8; \
          *(u32x4*)(scr_ + rr * 72 + cc) = nv[h]; \
        } \
        if (i + 1 < 9) MB_GSTRIP_LOAD(G_, i + 1);     \
        _Pragma("unroll") \
        for (int j = 0; j < 4; j++) \
        _Pragma("unroll") \
          for (int e = 0; e < 4; e++) { \
            const float x_ = 1.f + __expf(-bf2f(scr_[(fq_ * 4 + e) * 72 + j * 16 + fr_])); \
            acc[i][j][e] *= (INV) ? x_ : __frcp_rn(x_); \
          } \
      } \
    } while (0)
    MB_STAGE(0, 0);
    asm volatile("s_waitcnt vmcnt(0)" ::: "memory");
    __syncthreads();
#pragma unroll 1
    for (int it = 0; it < 48; it++) {
      const int cur = it & 1;
      if (it + 1 < 48) MB_STAGE(cur ^ 1, it + 1);
      const u16* a = smem + cur * STGG + (wr * 144 + fr) * 32 + pc * 8;
      const u16* b = smem + cur * STGG + 9216 + (wc * 64 + fr) * 32 + pc * 8;
      bf16x8 bf[4];
#pragma unroll
      for (int j = 0; j < 4; j++) bf[j] = *(const bf16x8*)(b + j * 512);
#pragma unroll
      for (int i = 0; i < 9; i++) {
        const bf16x8 af = *(const bf16x8*)(a + i * 512);
#pragma unroll
        for (int j = 0; j < 4; j++) acc[i][j] = __builtin_amdgcn_mfma_f32_16x16x32_bf16(af, bf[j], acc[i][j], 0, 0, 0);
      }
      __builtin_amdgcn_sched_barrier(0);
      if ((it & 15) == 15) {
        const int sg = it >> 4, napply = (sg < 2) ? 2 : 1;
#pragma unroll 1
        for (int q = 0; q < napply; q++) { MB_GATE(sg + q, q); }
      }
      asm volatile("s_waitcnt vmcnt(0)" ::: "memory");
      __syncthreads();
    }
    {
#pragma unroll
      for (int i = 0; i < 9; i++) {
        int t_ = tid; asm volatile("" : "+v"(t_));
        const int ln_ = t_ & 63, wd_ = t_ >> 6, fr_ = ln_ & 15, fq_ = ln_ >> 4;
        u16* scr_ = smem + 2 * STGG + wd_ * 16 * 72;
#pragma unroll
        for (int j = 0; j < 4; j++)
#pragma unroll
          for (int e = 0; e < 4; e++) scr_[(fq_ * 4 + e) * 72 + j * 16 + fr_] = f2bf(acc[i][j][e]);
#pragma unroll
        for (int h = 0; h < 2; h++) {
          const int rr = h * 8 + (ln_ >> 3), cc = (ln_ & 7) * 8;
          const u32x4 v = *(const u32x4*)(scr_ + rr * 72 + cc);
          *(u32x4*)(H + (size_t)(m0 + (wd_ >> 1) * 144 + i * 16 + rr) * 1024 + n0 + (wd_ & 1) * 64 + cc) = v;
        }
      }
    }
  }
}

__device__ __forceinline__ void conv_w_tile(float* sm, const float* __restrict__ W, int K, int N, u16* Wt, int kt, int nt) {
  OPAQUE_TID(tid);
  const int lane = tid & 63, wid = tid >> 6;
  const int n = nt * 64 + lane;
#pragma unroll
  for (int i = 0; i < 16; i++) {
    const int k = wid * 16 + i;
    sm[lane * 65 + k] = (n < N) ? W[(size_t)(kt * 64 + k) * N + n] : 0.f;
  }
  __syncthreads();
  const int nn = tid >> 2, ks = (tid & 3) * 16;
  const float* s = sm + nn * 65 + ks;
  uint4 o0, o1;
  o0.x = pack2(s[0], s[1]); o0.y = pack2(s[2], s[3]); o0.z = pack2(s[4], s[5]); o0.w = pack2(s[6], s[7]);
  o1.x = pack2(s[8], s[9]); o1.y = pack2(s[10], s[11]); o1.z = pack2(s[12], s[13]); o1.w = pack2(s[14], s[15]);
  u16* dst = Wt + (size_t)(nt * 64 + nn) * K + kt * 64 + ks;
  *(uint4*)dst = o0;
  *(uint4*)(dst + 8) = o1;
  __syncthreads();
}

__device__ __forceinline__ void wconv_phase(u16* smem, const Params& p, int l) {
  float* sm = (float*)smem;
  u16* wb = (u16*)(p.ws + WS_WB);
  const int total = 2080 + 384 + 256 + 1024 + 1024;
  for (int t = blockIdx.x; t < total; t += gridDim.x) {
    const float* src; u16* dst; int K, N, kt, nt;
    if (t < 2080) {
      src = opq(p.w_in) + (size_t)l * 1024 * DIN; K = 1024; N = DIN; dst = wb + WB_IN; kt = t / 130; nt = t % 130;
    } else if (t < 2080 + 384) {
      const int u = t - 2080, br = u / 128, v = u % 128;
      src = (br == 0 ? opq(p.w_br_a) : br == 1 ? opq(p.w_br_b) : opq(p.w_br_c)) + (size_t)l * 512 * 1024;
      K = 512; N = 1024; dst = wb + WB_BR + (size_t)br * 1024 * 512; kt = v / 16; nt = v % 16;
    } else if (t < 2080 + 384 + 256) {
      const int u = t - 2464;
      src = opq(p.w_out) + (size_t)l * 1024 * 1024; K = 1024; N = 1024; dst = wb + WB_OUT; kt = u / 16; nt = u % 16;
    } else if (t < 2080 + 384 + 256 + 1024) {
      const int u = t - 2720;
      src = opq(p.w_up) + (size_t)l * 1024 * 4096; K = 1024; N = 4096; dst = wb + WB_UP; kt = u / 64; nt = u % 64;
    } else {
      const int u = t - 3744;
      src = opq(p.w_down) + (size_t)l * 4096 * 1024; K = 4096; N = 1024; dst = wb + WB_DN; kt = u / 16; nt = u % 16;
    }
    conv_w_tile(sm, src, K, N, dst, kt, nt);
  }
}

__device__ __forceinline__ float wave_sum(float v) {
#pragma unroll
  for (int o = 32; o >= 1; o >>= 1) v += __shfl_xor(v, o);
  return v;
}

__device__ __forceinline__ void rowpass_phase(const Params& p, bool from_input, const u16* Y, const float* postw, const float* prew, u16* H) {
  OPAQUE_TID(tid);
  const int lane = tid & 63, wid = tid >> 6;
  const float* xpr = opq(p.x_prompt); const float* xsa = opq(p.x_sample); const float* xo = opq((const float*)p.out);
  const int stride = gridDim.x * 4;
  for (int row0 = blockIdx.x * 4 + wid; row0 < NTOK; row0 += 3 * stride) {
    float xv[3][16], yv[3][16];
#pragma unroll
    for (int k = 0; k < 3; k++) {
      const int row = min(row0 + k * stride, NTOK - 1);
      const float* xin = from_input ? (row < TP ? xpr + (size_t)row * D : xsa + (size_t)(row - TP) * D) : xo + (size_t)row * D;
#pragma unroll
      for (int i = 0; i < 4; i++) {
        const float4 v = *(const float4*)(xin + lane * 4 + i * 256);
        xv[k][i * 4] = v.x; xv[k][i * 4 + 1] = v.y; xv[k][i * 4 + 2] = v.z; xv[k][i * 4 + 3] = v.w;
      }
      if (Y) {
#pragma unroll
        for (int i = 0; i < 4; i++) {
          const uint2 v = *(const uint2*)(Y + (size_t)row * D + lane * 4 + i * 256);
          yv[k][i * 4] = bf2f((u16)(v.x & 0xffff)); yv[k][i * 4 + 1] = bf2f((u16)(v.x >> 16));
          yv[k][i * 4 + 2] = bf2f((u16)(v.y & 0xffff)); yv[k][i * 4 + 3] = bf2f((u16)(v.y >> 16));
        }
      }
    }
#pragma unroll
    for (int k = 0; k < 3; k++) {
      const int row = row0 + k * stride;
      if (row < NTOK) {
        if (Y) {
          float ss = 0.f;
#pragma unroll
          for (int i = 0; i < 16; i++) ss += yv[k][i] * yv[k][i];
          ss = wave_sum(ss);
          const float r = rsqrtf(ss * (1.f / D) + EPS);
#pragma unroll
          for (int i = 0; i < 4; i++) {
            const float4 w = *(const float4*)(postw + lane * 4 + i * 256);
            xv[k][i * 4] += yv[k][i * 4] * r * w.x; xv[k][i * 4 + 1] += yv[k][i * 4 + 1] * r * w.y;
            xv[k][i * 4 + 2] += yv[k][i * 4 + 2] * r * w.z; xv[k][i * 4 + 3] += yv[k][i * 4 + 3] * r * w.w;
          }
        }
        if (Y || from_input) {
#pragma unroll
          for (int i = 0; i < 4; i++)
            *(float4*)(p.out + (size_t)row * D + lane * 4 + i * 256) =
                make_float4(xv[k][i * 4], xv[k][i * 4 + 1], xv[k][i * 4 + 2], xv[k][i * 4 + 3]);
        }
        if (prew) {
          float ss = 0.f;
#pragma unroll
          for (int i = 0; i < 16; i++) ss += xv[k][i] * xv[k][i];
          ss = wave_sum(ss);
          const float r = rsqrtf(ss * (1.f / D) + EPS);
#pragma unroll
          for (int i = 0; i < 4; i++) {
            const float4 w = *(const float4*)(prew + lane * 4 + i * 256);
            uint2 o;
            o.x = pack2(xv[k][i * 4] * r * w.x, xv[k][i * 4 + 1] * r * w.y);
            o.y = pack2(xv[k][i * 4 + 2] * r * w.z, xv[k][i * 4 + 3] * r * w.w);
            *(uint2*)(H + (size_t)row * D + lane * 4 + i * 256) = o;
          }
        }
      }
    }
  }
}

__device__ __forceinline__ void hgrn_prep(u16* smem, const Params& p, int l, int c, int hd) {
  u16* z = (u16*)(p.ws + WS_Z);
  u16* sq = smem;
  u16* skt = smem + 64 * 136;
  u16* skh = smem + 2 * 64 * 136;
  float* sd = (float*)(smem + 3 * 64 * 136);
  OPAQUE_TID(tid);
  const int lane = tid & 63, wid = tid >> 6, fr = lane & 15, fq = lane >> 4;
  const int tok0 = c * 64;
  {
    const int hb = tid >> 7, ch = tid & 127, col = hd * 128 + ch;
    float lbv = 0.f;
    if (l > 0) {
      const float r0 = p.lb_raw[col], r1 = p.lb_raw[512 + col], r2 = p.lb_raw[1024 + col], r3 = p.lb_raw[1536 + col];
      const float m = fmaxf(fmaxf(r0, r1), fmaxf(r2, r3));
      const float e0 = __expf(r0 - m), e1 = __expf(r1 - m), e2 = __expf(r2 - m), e3 = __expf(r3 - m);
      const float inv = 1.f / (e0 + e1 + e2 + e3);
      lbv = e1 * inv;
      if (l > 1) lbv += e2 * inv;
      if (l > 2) lbv += e3 * inv;
    }
    {
      u32x4 rq[4], rf[4];
#pragma unroll
      for (int i = 0; i < 4; i++) {
        const int idx = tid + i * 256, row = idx >> 4, c8 = (idx & 15) * 8;
        rq[i] = *(const u32x4*)(z + (size_t)(tok0 + row) * ZS + ZA_Q + hd * 128 + c8);
        rf[i] = *(const u32x4*)(z + (size_t)(tok0 + row) * ZS + ZA_F + hd * 128 + c8);
      }
#pragma unroll
      for (int i = 0; i < 4; i++) {
        const int idx = tid + i * 256, row = idx >> 4, c8 = (idx & 15) * 8;
        *(u32x4*)(sq + row * 136 + c8) = rq[i];
        *(u32x4*)(skt + row * 136 + c8) = rf[i];
      }
    }
    __syncthreads();
    float bb[32];
    float run = 0.f;
#pragma unroll
    for (int t = 0; t < 32; t++) {
      const float zf = bf2f(skt[(hb * 32 + t) * 136 + ch]);
      const float f = lbv + (1.f - lbv) * sigm(zf);
      const float logf = (lbv > 0.f) ? __logf(f) : (fminf(zf, 0.f) - __logf(1.f + __expf(-fabsf(zf))));
      run += logf;
      bb[t] = run;
    }
    const float blast = run;
#pragma unroll
    for (int t = 0; t < 32; t++) {
      const int o = (hb * 32 + t) * 136 + ch;
      const float zq = bf2f(sq[o]), zf = bf2f(skt[o]);
      const float qv = silu(zq), kv = (1.f - lbv) * sigm(-zf);
      sq[o] = f2bf(qv * __expf(bb[t]));
      skt[o] = f2bf(kv * __expf(fminf(-bb[t], 80.f)));
      skh[o] = f2bf(kv * __expf(blast - bb[t]));
    }
    sd[hb * 128 + ch] = __expf(blast);
  }
  __syncthreads();
  {
    u16* qk = (u16*)(p.ws + WS_HQK);
    const int ti = wid;
    for (int si = 0; si < 4; si++) {
      f32x4 acc = (f32x4){0.f, 0.f, 0.f, 0.f};
      const bool upper = (ti < 2 && si >= 2);
      const bool cross = (ti >= 2 && si < 2);
      if (!upper && !((ti >> 1) == (si >> 1) && si > ti))
        acc = mma_lds_<128>(lane, sq + ti * 16 * 136, 136, (cross ? skh : skt) + si * 16 * 136, 136, acc);
#pragma unroll
      for (int e = 0; e < 4; e++) {
        const int t = ti * 16 + fq * 4 + e, s = si * 16 + fr;
        float v = acc[e];
        if (!cross && s > t) v = 0.f;
        qk[(size_t)(tok0 + t) * 256 + hd * 64 + s] = f2bf(v);
      }
    }
  }
  {
#pragma unroll 4
    for (int i = 0; i < 32; i++) {
      const int e = tid + i * 256, t = e >> 7, ch = e & 127;
      float v = bf2f(sq[t * 136 + ch]);
      if (t >= 32) v *= sd[ch];
      z[(size_t)(tok0 + t) * ZS + ZA_Q + hd * 128 + ch] = f2bf(v);
    }
    u16* kpt = (u16*)(p.ws + WS_HKPT) + (size_t)(c * 4 + hd) * 128 * 64;
#pragma unroll 4
    for (int i = 0; i < 32; i++) {
      const int e = tid + i * 256, dk = e >> 6, t = e & 63;
      float v = bf2f(skh[t * 136 + dk]);
      if (t < 32) v *= sd[128 + dk];
      kpt[dk * 64 + t] = f2bf(v);
    }
    if (tid < 128) ((float*)(p.ws + WS_HDA))[c * 512 + hd * 128 + tid] = sd[tid] * sd[128 + tid];
  }
  __syncthreads();
}

__device__ __forceinline__ void gdn_prep(u16* smem, const Params& p, int l, int c, int hd) {
  const u16* z = (const u16*)(p.ws + WS_Z);
  u16* sq = smem;
  u16* sk = smem + 64 * 136;
  u16* sv = smem + 2 * 64 * 136;
  float* sAm = (float*)(smem + 3 * 64 * 136);
  float* sgc = sAm + 64 * 68;
  float* sbeta = sgc + 64;
  OPAQUE_TID(tid);
  const int lane = tid & 63, wid = tid >> 6, fr = lane & 15, fq = lane >> 4;
  const int tok0 = c * 64;
  const bool first = (c == 0) || (c >= 256);
  const int sb = c - 256;
  u16* sraw = (u16*)sAm;
  u32x4 rraw[3][5];
#pragma unroll
  for (int part = 0; part < 3; part++)
#pragma unroll
    for (int i = 0; i < 5; i++) {
      const int idx = tid + i * 256, row = idx >> 4, c8 = (idx & 15) * 8, rr = row - 3;
      const int colq = part * 512 + hd * 128 + c8;
      u32x4 v = (u32x4){0u, 0u, 0u, 0u};
      if (idx < 67 * 16) {
        if (rr >= 0 || !first) {
          v = *(const u32x4*)(z + (size_t)(tok0 + rr) * ZS + ZC_Q + colq);
        } else if (c >= 256) {
          const float* st = p.st_gdn_conv + ((size_t)(l * 32 + sb) * 3 + row) * 1536 + colq;
          const float4 f0 = *(const float4*)st, f1 = *(const float4*)(st + 4);
          v = (u32x4){pack2(f0.x, f0.y), pack2(f0.z, f0.w), pack2(f1.x, f1.y), pack2(f1.z, f1.w)};
        }
      }
      rraw[part][i] = v;
    }
#pragma unroll
  for (int part = 0; part < 3; part++) {
    if (part > 0) __syncthreads();
#pragma unroll
    for (int i = 0; i < 5; i++) {
      const int idx = tid + i * 256, row = idx >> 4, c8 = (idx & 15) * 8;
      if (idx < 67 * 16) *(u32x4*)(sraw + row * 136 + c8) = rraw[part][i];
    }
    __syncthreads();
    {
      const int cc = tid & 127, half = tid >> 7, colq = part * 512 + hd * 128 + cc;
      const float* cw = p.c_conv_w + (size_t)l * 4 * 1536 + colq;
      const float w0 = cw[0], w1 = cw[1536], w2 = cw[2 * 1536], w3 = cw[3 * 1536];
      const u16* src = sraw + (half * 32) * 136 + cc;
      u16* dst = smem + part * 64 * 136 + (half * 32) * 136 + cc;
      float x0 = bf2f(src[0]), x1 = bf2f(src[136]), x2 = bf2f(src[2 * 136]);
#pragma unroll 8
      for (int t = 0; t < 32; t++) {
        const float x3 = bf2f(src[(t + 3) * 136]);
        const float y = w0 * x0 + w1 * x1 + w2 * x2 + w3 * x3;
        dst[t * 136] = f2bf(silu(y));
        x0 = x1; x1 = x2; x2 = x3;
      }
      if ((c == 255 || c >= 256) && half == 0) {
        float* dsto = (c == 255) ? p.out + O_PGC + (size_t)l * 3 * 1536 : p.out + O_SGC + (size_t)(l * 32 + sb) * 3 * 1536;
#pragma unroll
        for (int j = 0; j < 3; j++) dsto[j * 1536 + colq] = bf2f(sraw[(64 + j) * 136 + cc]);
      }
    }
  }
  __syncthreads();
  {
    const int t = tid >> 2, qd = tid & 3;
#pragma unroll
    for (int part = 0; part < 2; part++) {
      u16* r = smem + part * 64 * 136 + t * 136 + qd * 32;
      float ss = 0.f;
#pragma unroll
      for (int i = 0; i < 32; i++) { const float v = bf2f(r[i]); ss += v * v; }
      ss += __shfl_xor(ss, 1);
      ss += __shfl_xor(ss, 2);
      const float sc = rsqrtf(ss + EPS) * (part == 0 ? 0.08838834764831845f : 1.f);
#pragma unroll
      for (int i = 0; i < 32; i++) r[i] = f2bf(bf2f(r[i]) * sc);
    }
  }
  if (tid < 64) {
    const float beta = sigm(bf2f(z[(size_t)(tok0 + tid) * ZS + ZC_BETA + hd]));
    const float al = bf2f(z[(size_t)(tok0 + tid) * ZS + ZC_ALPHA + hd]);
    float g = -__expf(p.c_a_log[l * 4 + hd]) * softplus(al + p.c_dt_bias[l * 4 + hd]);
#pragma unroll
    for (int o = 1; o < 64; o <<= 1) {
      const float v = __shfl_up(g, o);
      if (lane >= o) g += v;
    }
    sgc[tid] = g;
    sbeta[tid] = beta;
  }
  __syncthreads();
  {
    u16* gqk = (u16*)(p.ws + WS_G) + G_QK;
    const int ti = wid;
    for (int si = 0; si < 4; si++) {
      f32x4 a1 = (f32x4){0.f, 0.f, 0.f, 0.f}, a2 = (f32x4){0.f, 0.f, 0.f, 0.f};
      if (si <= ti) {
        a1 = mma_lds_<128>(lane, sk + ti * 16 * 136, 136, sk + si * 16 * 136, 136, a1);
        a2 = mma_lds_<128>(lane, sq + ti * 16 * 136, 136, sk + si * 16 * 136, 136, a2);
      }
#pragma unroll
      for (int e = 0; e < 4; e++) {
        const int t = ti * 16 + fq * 4 + e, s = si * 16 + fr;
        const float dec = (s <= t) ? __expf(sgc[t] - sgc[s]) : 0.f;
        sAm[s * 68 + t] = (s < t) ? sbeta[t] * a1[e] * dec : 0.f;
        gqk[(size_t)(tok0 + t) * 256 + hd * 64 + s] = f2bf((s <= t) ? a2[e] * dec : 0.f);
      }
    }
  }
  __syncthreads();
  {
    const int col = tid & 127, isw = tid >> 7;
    const u16* src = isw ? sk : sv;
    u16* dst = (u16*)(p.ws + WS_G) + (isw ? G_W : G_U) + (size_t)tok0 * 512 + hd * 128 + col;
    float r[64];
#pragma unroll
    for (int t = 0; t < 64; t++) {
      float a = bf2f(src[t * 136 + col]) * sbeta[t];
      if (isw) a *= __expf(sgc[t]);
      r[t] = a;
    }
#pragma unroll
    for (int j = 0; j < 64; j++) {
      const float xj = r[j];
      *dst = f2bf(xj);
      dst += 512;
#pragma unroll
      for (int g = (j + 1) / 4; g < 16; g++) {
        const float4 a4 = *(const float4*)(sAm + j * 68 + g * 4);
        if (g * 4 > j) r[g * 4] -= a4.x * xj;
        if (g * 4 + 1 > j) r[g * 4 + 1] -= a4.y * xj;
        if (g * 4 + 2 > j) r[g * 4 + 2] -= a4.z * xj;
        if (g * 4 + 3 > j) r[g * 4 + 3] -= a4.w * xj;
      }
    }
  }
  {
    u16* gqp = (u16*)(p.ws + WS_G) + G_QP;
    const float gl = sgc[63];
#pragma unroll 4
    for (int i = 0; i < 32; i++) {
      const int e = tid + i * 256, t = e >> 7, cc = e & 127;
      gqp[(size_t)(tok0 + t) * 512 + hd * 128 + cc] = f2bf(bf2f(sq[t * 136 + cc]) * __expf(sgc[t]));
    }
    u16* kpt = (u16*)(p.ws + WS_G) + G_KPT + (size_t)(c * 4 + hd) * 128 * 64;
#pragma unroll 4
    for (int i = 0; i < 32; i++) {
      const int e = tid + i * 256, dk = e >> 6, t = e & 63;
      kpt[dk * 64 + t] = f2bf(bf2f(sk[t * 136 + dk]) * __expf(gl - sgc[t]));
    }
    if (tid == 0) ((float*)(p.ws + WS_GGL))[c * 4 + hd] = __expf(gl);
  }
  __syncthreads();
}

__device__ __forceinline__ void rglru_prep(u16* smem, const Params& p, int l, int c, int n) {
  const u16* z = (const u16*)(p.ws + WS_Z);
  float* sx = (float*)smem;
  float* su = sx + 64 * 65;
  u16* sxb = (u16*)(su + 64 * 65);
  u16* swa = sxb + 64 * 72;
  u16* swx = swa + 64 * 72;
  OPAQUE_TID(tid);
  const int lane = tid & 63, wid = tid >> 6, fr = lane & 15, fq = lane >> 4;
  const int tok0 = c * 64;
  const bool first = (c == 0) || (c >= 256);
  const int sb = c - 256;
  {
    const int ch = tid & 63, tq = tid >> 6, col = n * 64 + ch;
    const float* cw = p.b_conv_w + (size_t)l * 4 * 512 + col;
    const float w0 = cw[0], w1 = cw[512], w2 = cw[1024], w3 = cw[1536], bias = p.b_conv_b[l * 512 + col];
    u16* sraw = swx + 64 * 72;
    {
      u32x4 rr4[3];
#pragma unroll
      for (int i = 0; i < 3; i++) {
        const int idx = tid + i * 256, row = idx >> 3, c8 = (idx & 7) * 8, rr = row - 3;
        u32x4 v = (u32x4){0u, 0u, 0u, 0u};
        if (idx < 67 * 8) {
          if (rr >= 0 || !first) {
            v = *(const u32x4*)(z + (size_t)(tok0 + rr) * ZS + ZB_X + n * 64 + c8);
          } else if (c >= 256) {
            const float* st = p.st_rglru_conv + ((size_t)(l * 32 + sb) * 3 + row) * 512 + n * 64 + c8;
            const float4 f0 = *(const float4*)st, f1 = *(const float4*)(st + 4);
            v = (u32x4){pack2(f0.x, f0.y), pack2(f0.z, f0.w), pack2(f1.x, f1.y), pack2(f1.z, f1.w)};
          }
        }
        rr4[i] = v;
      }
#pragma unroll
      for (int i = 0; i < 3; i++) {
        const int idx = tid + i * 256, row = idx >> 3, c8 = (idx & 7) * 8;
        if (idx < 67 * 8) *(u32x4*)(sraw + row * 72 + c8) = rr4[i];
      }
    }
    __syncthreads();
    {
      const u16* src = sraw + (tq * 16) * 72 + ch;
      float x0 = bf2f(src[0]), x1 = bf2f(src[72]), x2 = bf2f(src[2 * 72]);
#pragma unroll 8
      for (int i = 0; i < 16; i++) {
        const int t = tq * 16 + i;
        const float x3 = bf2f(src[(i + 3) * 72]);
        const float y = w0 * x0 + w1 * x1 + w2 * x2 + w3 * x3 + bias;
        sx[t * 65 + ch] = y;
        sxb[t * 72 + ch] = f2bf(y);
        x0 = x1; x1 = x2; x2 = x3;
      }
    }
    const float* wa = p.b_ga_w + ((size_t)l * 8 + n) * 4096;
    const float* wx = p.b_gx_w + ((size_t)l * 8 + n) * 4096;
#pragma unroll
    for (int i = 0; i < 16; i++) {
      const int e = tid + i * 256, cin = e >> 6, d = e & 63;
      swa[d * 72 + cin] = f2bf(wa[e]);
      swx[d * 72 + cin] = f2bf(wx[e]);
    }
    if (c == 255 || c >= 256) {
      float* dst = (c == 255) ? p.out + O_PRC + (size_t)l * 3 * 512 : p.out + O_SRC + (size_t)(l * 32 + sb) * 3 * 512;
      if (tid < 192) {
        const int j = tid >> 6;
        dst[j * 512 + col] = bf2f(sraw[(64 + j) * 72 + ch]);
      }
    }
  }
  __syncthreads();
  f32x4 ra[4], rx[4];
  {
    const int ti = wid;
#pragma unroll
    for (int si = 0; si < 4; si++) {
      ra[si] = mma_lds_<64>(lane, sxb + ti * 16 * 72, 72, swa + si * 16 * 72, 72, (f32x4){0.f, 0.f, 0.f, 0.f});
      rx[si] = mma_lds_<64>(lane, sxb + ti * 16 * 72, 72, swx + si * 16 * 72, 72, (f32x4){0.f, 0.f, 0.f, 0.f});
    }
  }
  float lav[4][4], uv[4][4];
  {
    const int ti = wid;
#pragma unroll
    for (int si = 0; si < 4; si++) {
      const int d = si * 16 + fr, col = n * 64 + d;
      const float ba = p.b_ga_b[l * 512 + col], bx = p.b_gx_b[l * 512 + col];
      const float sp = softplus(-p.b_lambda[l * 512 + col]);
#pragma unroll
      for (int e = 0; e < 4; e++) {
        const int t = ti * 16 + fq * 4 + e;
        const float r = sigm(ra[si][e] + ba), ig = sigm(rx[si][e] + bx);
        const float la = -8.f * r * sp;
        float mult = sqrtf(fmaxf(1.f - __expf(2.f * la), 0.f));
        if (c == 0 && t == 0) mult = 1.f;
        const float u = mult * ig * sx[t * 65 + d];
        lav[si][e] = bf2f(f2bf(la));
        uv[si][e] = bf2f(f2bf(u));
      }
    }
  }
  __syncthreads();
  {
    const int ti = wid;
    u16* rla = (u16*)(p.ws + WS_RLA);
    u16* ru = (u16*)(p.ws + WS_RU);
#pragma unroll
    for (int si = 0; si < 4; si++) {
      const int d = si * 16 + fr, col = n * 64 + d;
#pragma unroll
      for (int e = 0; e < 4; e++) {
        const int t = ti * 16 + fq * 4 + e;
        sx[t * 65 + d] = lav[si][e];
        su[t * 65 + d] = uv[si][e];
        rla[(size_t)(tok0 + t) * 512 + col] = f2bf(lav[si][e]);
        ru[(size_t)(tok0 + t) * 512 + col] = f2bf(uv[si][e]);
      }
    }
  }
  __syncthreads();
  if (tid < 64) {
    float h = 0.f, sl = 0.f;
    for (int t = 0; t < 64; t++) {
      const float la = sx[t * 65 + tid];
      h = __expf(la) * h + su[t * 65 + tid];
      sl += la;
    }
    float* agg = (float*)(p.ws + WS_RAGG) + ((size_t)c * 512 + n * 64 + tid) * 2;
    agg[0] = sl;
    agg[1] = h;
  }
  __syncthreads();
}

__device__ __forceinline__ void rglru_scan(const Params& p, int l, int c, int hf) {
  OPAQUE_TID(tid);
  const int col = hf * 256 + tid;
  const int tok0 = c * 64;
  float h = 0.f;
  if (c >= 256) {
    h = p.st_rglru[(size_t)(l * 32 + (c - 256)) * 512 + col];
  } else {
    const float* agg = (const float*)(p.ws + WS_RAGG) + (size_t)col * 2;
    for (int cc = 0; cc < c; cc += 16) {
      float2 ab[16];
#pragma unroll
      for (int i = 0; i < 16; i++) ab[i] = *(const float2*)(agg + (size_t)min(cc + i, c - 1) * 1024);
#pragma unroll
      for (int i = 0; i < 16; i++) if (cc + i < c) h = __expf(ab[i].x) * h + ab[i].y;
    }
  }
  const u16* rla = (const u16*)(p.ws + WS_RLA) + (size_t)tok0 * 512 + col;
  u16* ru = (u16*)(p.ws + WS_RU) + (size_t)tok0 * 512 + col;
  for (int t0 = 0; t0 < 64; t0 += 32) {
    float la[32], u[32];
#pragma unroll
    for (int i = 0; i < 32; i++) { la[i] = bf2f(rla[(size_t)(t0 + i) * 512]); u[i] = bf2f(ru[(size_t)(t0 + i) * 512]); }
#pragma unroll
    for (int i = 0; i < 32; i++) {
      h = __expf(la[i]) * h + u[i];
      ru[(size_t)(t0 + i) * 512] = f2bf(h);
    }
  }
  if (c == 255) p.out[O_PR + (size_t)l * 512 + col] = h;
  else if (c >= 256) p.out[O_SR + (size_t)(l * 32 + (c - 256)) * 512 + col] = h;
}

template <bool GDN>
__device__ __forceinline__ void mat_scan(u16* smem, const Params& p, int l, int kind, int seg, int seq, int hd, int sl) {
  u16* z = (u16*)(p.ws + WS_Z);
  u16* sW = smem;
  u16* sQP = smem + 64 * 136;
  u16* sKT = smem + 2 * 64 * 136;
  u16* sQK = sKT + 128 * 72;
  u16* sSt = sQK + 64 * 72;
  u16* sVt = sSt + 32 * 136;
  OPAQUE_TID(tid);
  const int lane = tid & 63, wid = tid >> 6, fr = lane & 15, fq = lane >> 4;
  const int nchunk = (kind == 0) ? 1 : 16;
  const int c0 = (kind == 0) ? 255 + seq : seg * 16;
  const int cg = sl & 3;
  const int dvc = cg * 32 + fr;
  const bool full = (kind != 1);
  const bool uzero = (kind == 1 && sl >= 4);
  const int r16 = tid >> 4, c16 = (tid & 15) * 8;
  const int r8 = tid >> 3, c8 = (tid & 7) * 8;
  f32x4 S[2][2];
  f32x4 Dacc[2];
  { float one_ = 1.f; asm volatile("" : "+v"(one_)); Dacc[0] = (f32x4){one_, one_, one_, one_}; Dacc[1] = Dacc[0]; }
  if (kind == 0) {
    const float* st = (GDN ? p.st_gdn : p.st_hgrn) + ((size_t)(l * 32 + (seq - 1)) * 4 + hd) * 16384;
#pragma unroll
    for (int i = 0; i < 2; i++)
#pragma unroll
      for (int n = 0; n < 2; n++)
#pragma unroll
        for (int e = 0; e < 4; e++) S[i][n][e] = st[((wid * 2 + i) * 16 + fq * 4 + e) * 128 + dvc + n * 16];
  } else if (kind == 1) {
#pragma unroll
    for (int i = 0; i < 2; i++)
#pragma unroll
      for (int n = 0; n < 2; n++)
#pragma unroll
        for (int e = 0; e < 4; e++)
          S[i][n][e] = (sl >= 4 && ((wid * 2 + i) * 16 + fq * 4 + e) == (sl - 4) * 32 + n * 16 + fr) ? 1.f : 0.f;
  } else {
#pragma unroll
    for (int i = 0; i < 2; i++)
#pragma unroll
      for (int n = 0; n < 2; n++) S[i][n] = (f32x4){0.f, 0.f, 0.f, 0.f};
    if (!GDN) {
      const float* hs = (const float*)(p.ws + WS_HS);
      const float* hdp = (const float*)(p.ws + WS_HD);
#pragma unroll 4
      for (int j = 0; j < seg; j++) {
        f32x4 dj[2], sj[2][2];
#pragma unroll
        for (int i = 0; i < 2; i++) {
          dj[i] = *(const f32x4*)(hdp + (size_t)(j * 4 + hd) * 128 + (wid * 2 + i) * 16 + fq * 4);
#pragma unroll
          for (int n = 0; n < 2; n++)
#pragma unroll
            for (int e = 0; e < 4; e++)
              sj[i][n][e] = hs[((size_t)(j * 4 + hd) * 128 + (wid * 2 + i) * 16 + fq * 4 + e) * 128 + dvc + n * 16];
        }
#pragma unroll
        for (int i = 0; i < 2; i++)
#pragma unroll
          for (int n = 0; n < 2; n++) S[i][n] = S[i][n] * dj[i] + sj[i][n];
      }
    } else {
      const float* gb = (const float*)(p.ws + WS_GB);
      const u16* gp = (const u16*)(p.ws + WS_GP);
      u16* sP = smem;
      u32x4 rP[8];
      if (seg > 1) {
#pragma unroll
        for (int i = 0; i < 8; i++) rP[i] = *(const u32x4*)(gp + ((size_t)(1 * 4 + hd) * 128 + r16 + i * 16) * 128 + c16);
      }
      f32x4 bn[2][2];
#pragma unroll
      for (int i = 0; i < 2; i++)
#pragma unroll
        for (int n = 0; n < 2; n++)
#pragma unroll
          for (int e = 0; e < 4; e++)
            bn[i][n][e] = gb[((size_t)(0 * 4 + hd) * 128 + (wid * 2 + i) * 16 + fq * 4 + e) * 128 + dvc + n * 16];
      for (int j = 0; j < seg; j++) {
        f32x4 bj[2][2];
#pragma unroll
        for (int i = 0; i < 2; i++)
#pragma unroll
          for (int n = 0; n < 2; n++) bj[i][n] = bn[i][n];
        if (j == 0) {
#pragma unroll
          for (int i = 0; i < 2; i++)
#pragma unroll
            for (int n = 0; n < 2; n++) S[i][n] = bj[i][n];
          if (seg > 1) {
#pragma unroll
            for (int i = 0; i < 2; i++)
#pragma unroll
              for (int n = 0; n < 2; n++)
#pragma unroll
                for (int e = 0; e < 4; e++)
                  bn[i][n][e] = gb[((size_t)(1 * 4 + hd) * 128 + (wid * 2 + i) * 16 + fq * 4 + e) * 128 + dvc + n * 16];
          }
        } else {
          __syncthreads();
#pragma unroll
          for (int i = 0; i < 8; i++) *(u32x4*)(sP + (r16 + i * 16) * 136 + c16) = rP[i];
#pragma unroll
          for (int i = 0; i < 2; i++)
#pragma unroll
            for (int n = 0; n < 2; n++) {
              uint2 o2;
              o2.x = pack2(S[i][n][0], S[i][n][1]);
              o2.y = pack2(S[i][n][2], S[i][n][3]);
              *(uint2*)(sSt + (n * 16 + fr) * 136 + (wid * 2 + i) * 16 + fq * 4) = o2;
            }
          __syncthreads();
          if (j + 1 < seg) {
#pragma unroll
            for (int i = 0; i < 8; i++) rP[i] = *(const u32x4*)(gp + ((size_t)((j + 1) * 4 + hd) * 128 + r16 + i * 16) * 128 + c16);
#pragma unroll
            for (int i = 0; i < 2; i++)
#pragma unroll
              for (int n = 0; n < 2; n++)
#pragma unroll
                for (int e = 0; e < 4; e++)
                  bn[i][n][e] = gb[((size_t)((j + 1) * 4 + hd) * 128 + (wid * 2 + i) * 16 + fq * 4 + e) * 128 + dvc + n * 16];
          }
#pragma unroll
          for (int i = 0; i < 2; i++)
#pragma unroll
            for (int n = 0; n < 2; n++)
              S[i][n] = mma_lds_<128>(lane, sP + (wid * 2 + i) * 16 * 136, 136, sSt + n * 16 * 136, 136, bj[i][n]);
        }
      }
    }
  }
  const u16* gQP = GDN ? (const u16*)(p.ws + WS_G) + G_QP + hd * 128 : z + ZA_Q + hd * 128;
  const int ldqp = GDN ? 512 : ZS;
  const u16* gKT = GDN ? (const u16*)(p.ws + WS_G) + G_KPT : (const u16*)(p.ws + WS_HKPT);
  const u16* gQK = (GDN ? (const u16*)(p.ws + WS_G) + G_QK : (const u16*)(p.ws + WS_HQK)) + hd * 64;
  const u16* gW = (const u16*)(p.ws + WS_G) + G_W + hd * 128;
  const u16* gU = (const u16*)(p.ws + WS_G) + G_U + hd * 128 + dvc;
  u16* gO = z + (GDN ? ZC_V : ZA_I) + hd * 128 + dvc;

  u32x4 rQP[2][4], rW[2][4], rKT[2][4], rQK[2][2];
  unsigned rV[2][8];
  f32x4 rDv[2][2];
  float rG[2];
#define LOAD_REGS(ST, cx) do { \
    const int c_ = (cx); \
    const size_t tk0_ = (size_t)c_ * 64; \
    _Pragma("unroll") \
    for (int i = 0; i < 4; i++) { \
      if (full) rQP[ST][i] = *(const u32x4*)(gQP + (tk0_ + r16 + i * 16) * ldqp + c16); \
      if (GDN) rW[ST][i] = *(const u32x4*)(gW + (tk0_ + r16 + i * 16) * 512 + c16); \
      rKT[ST][i] = *(const u32x4*)(gKT + ((size_t)(c_ * 4 + hd) * 128 + r8 + i * 32) * 64 + c8); \
    } \
    if (full) { \
    _Pragma("unroll") \
      for (int i = 0; i < 2; i++) rQK[ST][i] = *(const u32x4*)(gQK + (tk0_ + r8 + i * 32) * 256 + c8); \
    } \
    if (GDN) { \
    _Pragma("unroll") \
      for (int n = 0; n < 2; n++) \
    _Pragma("unroll") \
        for (int e = 0; e < 4; e++) rV[ST][n * 4 + e] = uzero ? 0u : (unsigned)gU[(tk0_ + wid * 16 + fq * 4 + e) * 512 + n * 16]; \
      rG[ST] = ((const float*)(p.ws + WS_GGL))[c_ * 4 + hd]; \
    } else { \
    _Pragma("unroll") \
      for (int i = 0; i < 8; i++) { \
        const int e = tid + i * 256; \
        rV[ST][i] = z[(tk0_ + (e >> 5)) * ZS + ZA_I + hd * 128 + cg * 32 + (e & 31)]; \
      } \
      const float* da = (const float*)(p.ws + WS_HDA) + (size_t)c_ * 512 + hd * 128; \
    _Pragma("unroll") \
      for (int i = 0; i < 2; i++) rDv[ST][i] = *(const f32x4*)(da + (wid * 2 + i) * 16 + fq * 4); \
    } \
  } while (0)
#define SCAN_STEP(ST, cix) do { \
    const int ci_ = (cix); \
    const int c = c0 + ci_; \
    const size_t tok0 = (size_t)c * 64; \
    __syncthreads(); \
    _Pragma("unroll") \
    for (int i = 0; i < 4; i++) { \
      if (full) *(u32x4*)(sQP + (r16 + i * 16) * 136 + c16) = rQP[ST][i]; \
      if (GDN) *(u32x4*)(sW + (r16 + i * 16) * 136 + c16) = rW[ST][i]; \
      *(u32x4*)(sKT + (r8 + i * 32) * 72 + c8) = rKT[ST][i]; \
    } \
    if (full) { \
    _Pragma("unroll") \
      for (int i = 0; i < 2; i++) *(u32x4*)(sQK + (r8 + i * 32) * 72 + c8) = rQK[ST][i]; \
    } \
    _Pragma("unroll") \
    for (int i = 0; i < 2; i++) \
    _Pragma("unroll") \
      for (int n = 0; n < 2; n++) { \
        uint2 o2; \
        o2.x = pack2(S[i][n][0], S[i][n][1]); \
        o2.y = pack2(S[i][n][2], S[i][n][3]); \
        *(uint2*)(sSt + (n * 16 + fr) * 136 + (wid * 2 + i) * 16 + fq * 4) = o2; \
      } \
    float uu[8]; \
    if (GDN) { \
    _Pragma("unroll") \
      for (int e = 0; e < 8; e++) uu[e] = bf2f((u16)rV[ST][e]); \
    } else { \
    _Pragma("unroll") \
      for (int i = 0; i < 8; i++) { \
        const int e = tid + i * 256; \
        sVt[(e & 31) * 72 + (e >> 5)] = (u16)rV[ST][i]; \
      } \
    } \
    __syncthreads(); \
    float g_ = 0.f; f32x4 dv0_, dv1_; \
    if (GDN) { g_ = rG[ST]; asm volatile("" : "+v"(g_), "+v"(uu[0]), "+v"(uu[1]), "+v"(uu[2]), "+v"(uu[3]), "+v"(uu[4]), "+v"(uu[5]), "+v"(uu[6]), "+v"(uu[7]) :: "memory"); } \
    else { dv0_ = rDv[ST][0]; dv1_ = rDv[ST][1]; asm volatile("" : "+v"(dv0_), "+v"(dv1_) :: "memory"); } \
    if (ci_ + 2 < nchunk) LOAD_REGS(ST, c + 2); \
    f32x4 o[2]; \
    o[0] = (f32x4){0.f, 0.f, 0.f, 0.f}; o[1] = o[0]; \
    if (full) { \
    _Pragma("unroll") \
      for (int n = 0; n < 2; n++) o[n] = mma_lds_<128>(lane, sQP + wid * 16 * 136, 136, sSt + n * 16 * 136, 136, o[n]); \
    } \
    if (GDN) { \
    _Pragma("unroll") \
      for (int n = 0; n < 2; n++) { \
        f32x4 a = mma_lds_<128>(lane, sW + wid * 16 * 136, 136, sSt + n * 16 * 136, 136, (f32x4){0.f, 0.f, 0.f, 0.f}); \
        uint2 ov; \
        ov.x = pack2(uu[n * 4 + 0] - a[0], uu[n * 4 + 1] - a[1]); \
        ov.y = pack2(uu[n * 4 + 2] - a[2], uu[n * 4 + 3] - a[3]); \
        *(uint2*)(sVt + (n * 16 + fr) * 72 + wid * 16 + fq * 4) = ov; \
      } \
      __syncthreads(); \
    } \
    if (full) { \
    _Pragma("unroll") \
      for (int n = 0; n < 2; n++) { \
        o[n] = mma_lds_<64>(lane, sQK + wid * 16 * 72, 72, sVt + n * 16 * 72, 72, o[n]); \
    _Pragma("unroll") \
        for (int e = 0; e < 4; e++) gO[(tok0 + wid * 16 + fq * 4 + e) * ZS + n * 16] = f2bf(o[n][e]); \
      } \
    } \
    if (GDN) { \
      const float gs_ = __int_as_float(__builtin_amdgcn_readfirstlane(__float_as_int(g_))); \
    _Pragma("unroll") \
      for (int i = 0; i < 2; i++) { S[i][0] *= gs_; S[i][1] *= gs_; } \
    } else { \
      S[0][0] *= dv0_; S[0][1] *= dv0_; S[1][0] *= dv1_; S[1][1] *= dv1_; \
      Dacc[0] *= dv0_; Dacc[1] *= dv1_; \
    } \
    _Pragma("unroll") \
    for (int i = 0; i < 2; i++) \
    _Pragma("unroll") \
      for (int n = 0; n < 2; n++) \
        S[i][n] = mma_lds_<64>(lane, sKT + (wid * 2 + i) * 16 * 72, 72, sVt + n * 16 * 72, 72, S[i][n]); \
  } while (0)
  __syncthreads();
  LOAD_REGS(0, c0);
  if (nchunk > 1) LOAD_REGS(1, c0 + 1);
  for (int ci = 0; ci < nchunk; ci += 2) {
    SCAN_STEP(0, ci);
    if (ci + 1 < nchunk) SCAN_STEP(1, ci + 1);
  }
  if (kind == 1) {
    if (GDN && sl >= 4) {
      u16* gp = (u16*)(p.ws + WS_GP) + (size_t)(seg * 4 + hd) * 16384;
#pragma unroll
      for (int i = 0; i < 2; i++)
#pragma unroll
        for (int n = 0; n < 2; n++)
#pragma unroll
          for (int e = 0; e < 4; e++) gp[((wid * 2 + i) * 16 + fq * 4 + e) * 128 + (sl - 4) * 32 + n * 16 + fr] = f2bf(S[i][n][e]);
    } else {
      float* dst = (float*)(p.ws + (GDN ? WS_GB : WS_HS)) + (size_t)(seg * 4 + hd) * 16384;
#pragma unroll
      for (int i = 0; i < 2; i++)
#pragma unroll
        for (int n = 0; n < 2; n++)
#pragma unroll
          for (int e = 0; e < 4; e++) dst[((wid * 2 + i) * 16 + fq * 4 + e) * 128 + dvc + n * 16] = S[i][n][e];
      if (!GDN && sl == 0 && fr == 0) {
        float* dd = (float*)(p.ws + WS_HD) + (size_t)(seg * 4 + hd) * 128;
#pragma unroll
        for (int i = 0; i < 2; i++) *(f32x4*)(dd + (wid * 2 + i) * 16 + fq * 4) = Dacc[i];
      }
    }
  } else if (kind == 0 || seg == 15) {
    float* dst;
    if (kind == 2) dst = p.out + (GDN ? O_PG : O_PH) + ((size_t)l * 4 + hd) * 16384;
    else dst = p.out + (GDN ? O_SG : O_SH) + ((size_t)(l * 32 + (seq - 1)) * 4 + hd) * 16384;
#pragma unroll
    for (int i = 0; i < 2; i++)
#pragma unroll
      for (int n = 0; n < 2; n++)
#pragma unroll
        for (int e = 0; e < 4; e++) dst[((wid * 2 + i) * 16 + fq * 4 + e) * 128 + dvc + n * 16] = S[i][n][e];
  }
  __syncthreads();
}

__device__ __forceinline__ void onorm_phase(const Params& p, int l) {
  u16* z = (u16*)(p.ws + WS_Z);
  u16* ru = (u16*)(p.ws + WS_RU);
  OPAQUE_TID(tid);
  const int lane = tid & 63, wid = tid >> 6;
  for (int row = blockIdx.x * 4 + wid; row < NTOK; row += gridDim.x * 4) {
    u16* zr = z + (size_t)row * ZS;
#pragma unroll
    for (int br = 0; br < 2; br++) {
      u16* po = zr + (br == 0 ? ZA_I : ZC_V) + lane * 8;
      const u16* pg = zr + (br == 0 ? ZA_G : ZC_G) + lane * 8;
      const float* nw = (br == 0 ? p.a_norm : p.c_norm) + l * 128 + (lane & 15) * 8;
      const uint4 vo = *(const uint4*)po, vg = *(const uint4*)pg;
      const unsigned uo[4] = {vo.x, vo.y, vo.z, vo.w}, ug[4] = {vg.x, vg.y, vg.z, vg.w};
      float o[8], g[8];
#pragma unroll
      for (int i = 0; i < 4; i++) {
        o[2 * i] = bf2f((u16)(uo[i] & 0xffff)); o[2 * i + 1] = bf2f((u16)(uo[i] >> 16));
        g[2 * i] = bf2f((u16)(ug[i] & 0xffff)); g[2 * i + 1] = bf2f((u16)(ug[i] >> 16));
      }
      float ss = 0.f;
#pragma unroll
      for (int i = 0; i < 8; i++) ss += o[i] * o[i];
      ss += __shfl_xor(ss, 1); ss += __shfl_xor(ss, 2); ss += __shfl_xor(ss, 4); ss += __shfl_xor(ss, 8);
      const float r = rsqrtf(ss * (1.f / 128.f) + EPS);
      unsigned res[4];
#pragma unroll
      for (int i = 0; i < 4; i++)
        res[i] = pack2(o[2 * i] * r * nw[2 * i] * silu(g[2 * i]), o[2 * i + 1] * r * nw[2 * i + 1] * silu(g[2 * i + 1]));
      *(uint4*)po = make_uint4(res[0], res[1], res[2], res[3]);
    }
    {
      u16* ph = ru + (size_t)row * 512 + lane * 8;
      const u16* pg = zr + ZB_G + lane * 8;
      const uint4 vo = *(const uint4*)ph, vg = *(const uint4*)pg;
      const unsigned uo[4] = {vo.x, vo.y, vo.z, vo.w}, ug[4] = {vg.x, vg.y, vg.z, vg.w};
      unsigned res[4];
#pragma unroll
      for (int i = 0; i < 4; i++) {
        const float h0 = bf2f((u16)(uo[i] & 0xffff)), h1 = bf2f((u16)(uo[i] >> 16));
        const float g0 = bf2f((u16)(ug[i] & 0xffff)), g1 = bf2f((u16)(ug[i] >> 16));
        res[i] = pack2(gelu_t(g0) * h0, gelu_t(g1) * h1);
      }
      *(uint4*)ph = make_uint4(res[0], res[1], res[2], res[3]);
    }
  }
}

__device__ __forceinline__ void prep_phase(u16* smem, const Params& p, int l, bool dup) {
  for (int t = blockIdx.x; t < 4608; t += gridDim.x) {
    if (t < 1152) gdn_prep(smem, p, l, t >> 2, t & 3);
    else if (t < 2304) { if (!dup) hgrn_prep(smem, p, l, (t - 1152) >> 2, (t - 1152) & 3); }
    else rglru_prep(smem, p, l, (t - 2304) >> 3, (t - 2304) & 7);
  }
}

__device__ __forceinline__ void scan_phase(u16* smem, const Params& p, int l, int pass) {
  const int ntask = pass ? 512 : (720 + 576 + 1024);
  for (int t = blockIdx.x; t < ntask; t += gridDim.x) {
    bool isg; int kind, seg = 0, seq = 0, hd, sl;
    if (pass) {
      kind = 2;
      if (t < 256) { isg = true; seg = 15 - (t >> 4); hd = (t >> 2) & 3; sl = t & 3; }
      else { const int u = t - 256; isg = false; seg = u >> 4; hd = (u >> 2) & 3; sl = u & 3; }
    } else {
      if (t >= 720 && t < 1296) { rglru_scan(p, l, (t - 720) >> 1, (t - 720) & 1); continue; }
      if (t < 480) { kind = 1; isg = true; seg = t >> 5; hd = (t >> 3) & 3; sl = t & 7; }
      else if (t < 720) { const int u = t - 480; kind = 1; isg = false; seg = u >> 4; hd = (u >> 2) & 3; sl = u & 3; }
      else if (t < 1296 + 512) { const int u = t - 1296; kind = 0; isg = true; seq = 1 + (u >> 4); hd = (u >> 2) & 3; sl = u & 3; }
      else { const int u = t - 1808; kind = 0; isg = false; seq = 1 + (u >> 4); hd = (u >> 2) & 3; sl = u & 3; }
    }
    if (isg) mat_scan<true>(smem, p, l, kind, seg, seq, hd, sl);
    else mat_scan<false>(smem, p, l, kind, seg, seq, hd, sl);
  }
}

__device__ __forceinline__ void run_phase(u16* smem, const Params& p, int l, int ph, bool dup = false) {
#ifdef ONLY_PH
  if (ph != ONLY_PH) return;
  ph = ONLY_PH;
#endif
  u16* Z = (u16*)(p.ws + WS_Z);
  u16* WB = (u16*)(p.ws + WS_WB);
  u16* H = (u16*)(p.ws + WS_H);
  u16* Y = (u16*)(p.ws + WS_Y);
  if (ph == 0 || ph == 7 || ph == 10) {
    const bool fi = (ph == 0);
    const u16* y = fi ? nullptr : Y;
    const float* postw = ((ph == 7) ? opq(p.n_post_mix) : opq(p.n_post_mlp)) + l * D;
    const float* npm = opq(p.n_pre_mix);
    const float* prew = (ph == 0) ? npm : (ph == 7) ? opq(p.n_pre_mlp) + l * D : ((l + 1 < DEPTH) ? npm + (l + 1) * D : nullptr);
    rowpass_phase(p, fi, y, postw, prew, H);
    const int wl = (ph == 0) ? 0 : l + 1;
    if (ph != 7 && wl < DEPTH) wconv_phase(smem, p, wl);
  } else if (ph == 1 || ph == 6 || ph == 8 || ph == 9) {
    const u16* A = (ph == 9) ? Z : H;
    const int lda = (ph == 9) ? 4096 : 1024;
    const u16* Bt = WB + ((ph == 1) ? WB_IN : (ph == 6) ? WB_OUT : (ph == 8) ? WB_UP : WB_DN);
    const int K = (ph == 9) ? 4096 : 1024;
    const int N = (ph == 1) ? ZS : (ph == 8) ? 4096 : 1024;
    u16* C = (ph == 1 || ph == 8) ? Z : Y;
    const int ldc = (ph == 1) ? ZS : (ph == 8) ? 4096 : 1024;
    gemm_big_phase(smem, A, lda, Bt, K, N, K, C, ldc, ph == 8 ? 1 : 0);
  } else if (ph == 2) prep_phase(smem, p, l, dup);
  else if (ph == 3 || ph == 11) scan_phase(smem, p, l, ph == 11 ? 1 : 0);
  else if (ph == 4) onorm_phase(p, l);
  else if (ph == 5) merge_big_phase(smem, p);
}

#if MULTI_LAUNCH
__global__ void __launch_bounds__(256, 2) phase_kernel(Params p, int l, int ph) {
  __shared__ __attribute__((aligned(16))) u16 smem[SMEM_BYTES / 2];
  run_phase(smem, p, l, ph);
}
#endif

#if !MULTI_LAUNCH
#define XB_TMO      128
#define XB_XCNT(j)  (256  + 64 * (j))
#define XB_XSUB(j)  (1280 + 64 * (j))
#define XB_XGEN(j)  (2304 + 64 * (j))
#define XB_TOP      3328
#define XB_TOPGEN   3392
#define XCD_BAR_WORDS 3456
#define XB_SPIN_CAP (1u << 18)
#define LAS __attribute__((address_space(3)))

__device__ __forceinline__ unsigned xb_ld(unsigned* p)              { return __hip_atomic_load(p, __ATOMIC_RELAXED, __HIP_MEMORY_SCOPE_AGENT); }
__device__ __forceinline__ unsigned xb_add(unsigned* p, unsigned v) { return __hip_atomic_fetch_add(p, v, __ATOMIC_RELAXED, __HIP_MEMORY_SCOPE_AGENT); }
__device__ __forceinline__ unsigned xb_xcc_id() { return (unsigned)__builtin_amdgcn_s_getreg((3 << 11) | 20) & 0xFu; }
#define XB_SPIN(cond, bar) do { unsigned _sp = 0; while (cond) { __builtin_amdgcn_s_sleep(1); \
    if ((++_sp & 255u) == 0u) { if (xb_ld(&(bar)[XB_TMO])) break; if (_sp > XB_SPIN_CAP) { atomicAdd(&(bar)[XB_TMO], 1u); break; } } } } while (0)

struct XcdBarrier {
    unsigned* bar; unsigned x;
    volatile LAS unsigned* st;
};

__device__ __forceinline__ XcdBarrier xcd_barrier_post(unsigned* bar, volatile LAS unsigned* st) {
    XcdBarrier b; b.bar = bar; b.x = xb_xcc_id(); b.st = st;
    if (threadIdx.x == 0) (void)xb_add(&bar[XB_XCNT(b.x)], 1u);
    return b;
}
__device__ __forceinline__ void xcd_barrier_complete(unsigned* bar, unsigned x, unsigned& nloc, unsigned& nx) {
    const unsigned G = gridDim.x * gridDim.y * gridDim.z;
    unsigned sum, cnt, mine, sp = 0u;
    for (;;) {
        sum = 0u; cnt = 0u; mine = 0u;
#pragma unroll
        for (unsigned j = 0; j < 16; ++j) { const unsigned c = xb_ld(&bar[XB_XCNT(j)]); sum += c; cnt += (c > 0u) ? 1u : 0u; mine = (j == x) ? c : mine; }
        if (sum == G) break;
        __builtin_amdgcn_s_sleep(1);
        if ((++sp & 255u) == 0u) { if (xb_ld(&bar[XB_TMO])) break; if (sp > XB_SPIN_CAP) { atomicAdd(&bar[XB_TMO], 1u); break; } }
    }
    nloc = mine > 0u ? mine : 1u; nx = cnt > 0u ? cnt : 1u;
}

__device__ __forceinline__ void xcd_barrier(const XcdBarrier& b) {
    asm volatile("s_waitcnt vmcnt(0)" ::: "memory");
    __syncthreads();
    if (threadIdx.x == 0) {
        unsigned* bar = b.bar;
        __builtin_amdgcn_s_waitcnt(0);
        unsigned nloc = b.st[0], nx = b.st[1];
        if (nloc == 0u) { xcd_barrier_complete(bar, b.x, nloc, nx); b.st[0] = nloc; b.st[1] = nx; }
        const unsigned old = xb_add(&bar[XB_XSUB(b.x)], 1u);
        const unsigned gen = old / nloc;
        if (old + 1u == (gen + 1u) * nloc) {
            __builtin_amdgcn_fence(__ATOMIC_RELEASE, "agent");
            asm volatile("s_waitcnt vmcnt(0)" ::: "memory");
            const unsigned og = xb_add(&bar[XB_TOP], 1u);
            const unsigned tg = og / nx;
            if (og + 1u == (tg + 1u) * nx) xb_add(&bar[XB_TOPGEN], 1u);
            else XB_SPIN(xb_ld(&bar[XB_TOPGEN]) == tg, bar);
            __builtin_amdgcn_fence(__ATOMIC_ACQUIRE, "agent");
            xb_add(&bar[XB_XGEN(b.x)], 1u);
            asm volatile("s_waitcnt vmcnt(0)" ::: "memory");
        } else {
            XB_SPIN(xb_ld(&bar[XB_XGEN(b.x)]) == gen, bar);
            __builtin_amdgcn_fence(__ATOMIC_ACQUIRE, "agent");
            asm volatile("s_waitcnt vmcnt(0)" ::: "memory");
        }
    }
    __syncthreads();
}


__global__ void __launch_bounds__(256, 2) mega_kernel(Params p) {
  __shared__ __attribute__((aligned(16))) u16 smem[SMEM_BYTES / 2 + 8];
  cg::grid_group grid = cg::this_grid();
  unsigned* xbw = (unsigned*)(smem + SMEM_BYTES / 2);
  if (threadIdx.x == 0) { xbw[0] = 0u; xbw[1] = 0u; xbw[2] = 0u; xbw[3] = 0u; }
  __syncthreads();
  XcdBarrier xb = xcd_barrier_post((unsigned*)(p.ws + WS_BAR), (volatile LAS unsigned*)xbw);
  if (p.ws == nullptr) grid.sync();
  for (int s = 0; s < 1 + DEPTH * 11; s++) {
    int l = 0, ph = 0;
    if (s > 0) {
      l = (s - 1) / 11;
      const int pi = (s - 1) % 11 + 1;
      ph = (pi <= 3) ? pi : (pi == 4) ? 11 : pi - 1;
    }
    run_phase(smem, p, l, ph);
    xcd_barrier(xb);
#ifdef DUP_MASK
    if (s > 0 && ((DUP_MASK >> ph) & 1)) { run_phase(smem, p, l, ph, true); xcd_barrier(xb); }
#endif
#ifdef EXTRA_SYNCS
    for (int i = 0; i < EXTRA_SYNCS; i++) xcd_barrier(xb);
#endif
  }
}
#endif

extern "C" void kernel_launch(void* const* d_in, const int* in_sizes, int n_in, void* d_out, int out_size, void* d_ws,
                              size_t ws_size, hipStream_t stream) {
  if (ws_size < WS_END) { fprintf(stderr, "workspace too small: %zu < %zu\n", ws_size, (size_t)WS_END); return; }
  Params p{};
  const float** pp = (const float**)&p;
  for (int i = 0; i < 31; i++) pp[i] = (const float*)d_in[i];
  p.out = (float*)d_out;
  p.ws = (char*)d_ws;
  static int grid_blocks = 0;
  if (!grid_blocks) {
    int dev = 0, cus = 0, per_cu = 0;
    hipGetDevice(&dev);
    hipDeviceGetAttribute(&cus, hipDeviceAttributeMultiprocessorCount, dev);
#if MULTI_LAUNCH
    hipOccupancyMaxActiveBlocksPerMultiprocessor(&per_cu, phase_kernel, 256, 0);
#else
    hipOccupancyMaxActiveBlocksPerMultiprocessor(&per_cu, mega_kernel, 256, 0);
#endif
    if (per_cu > 2) per_cu = 2;
    if (per_cu < 1) per_cu = 1;
    grid_blocks = cus * per_cu;
  }
#if MULTI_LAUNCH
  phase_kernel<<<grid_blocks, 256, 0, stream>>>(p, 0, 0);
  for (int l = 0; l < DEPTH; l++)
    for (int pi = 1; pi <= 11; pi++) phase_kernel<<<grid_blocks, 256, 0, stream>>>(p, l, (pi <= 3) ? pi : (pi == 4) ? 11 : pi - 1);
#else
  hipMemsetAsync((char*)d_ws + WS_BAR, 0, 16384, stream);
  void* args[] = {&p};
  hipError_t e = hipLaunchCooperativeKernel((void*)mega_kernel, dim3(grid_blocks), dim3(256), args, 0, stream);
  if (e != hipSuccess) fprintf(stderr, "cooperative launch failed: %s (grid %d)\n", hipGetErrorString(e), grid_blocks);
#endif
}
```

```cpp
#include <hip/hip_runtime.h>
#include <hip/hip_cooperative_groups.h>
#include <cstdio>
namespace cg = cooperative_groups;

#ifndef MULTI_LAUNCH
#define MULTI_LAUNCH 0
#endif

typedef unsigned short u16;
typedef __attribute__((ext_vector_type(8))) short bf16x8;
typedef __attribute__((ext_vector_type(4))) float f32x4;
typedef __attribute__((ext_vector_type(4))) unsigned int u32x4;

constexpr int D = 1024, NTOK = 18432, TP = 16384, NCHUNK = 288, DEPTH = 4, DFF = 4096;
constexpr int DIN = 8200, ZS = 8320;
constexpr int ZA_Q = 0, ZA_F = 512, ZA_I = 1024, ZA_G = 1536, ZB_X = 2048, ZB_G = 2560, ZC_Q = 3072, ZC_V = 4096,
              ZC_G = 4608, ZC_BETA = 5120, ZC_ALPHA = 5124, Z_MERGE = 5128;
constexpr float EPS = 1e-6f;

constexpr size_t O_YP = 0, O_YS = 16777216, O_PH = 18874368, O_PR = 19136512, O_PRC = 19138560, O_PG = 19144704,
                 O_PGC = 19406848, O_SH = 19425280, O_SR = 27813888, O_SRC = 27879424, O_SG = 28076032, O_SGC = 36464640;

constexpr size_t WS_Z = 0;
constexpr size_t WS_WB = WS_Z + (size_t)NTOK * ZS * 2;
constexpr size_t WB_IN = 0, WB_BR = (size_t)ZS * 1024, WB_OUT = WB_BR + 3 * 1024 * 512, WB_UP = WB_OUT + 1024 * 1024,
                 WB_DN = WB_UP + 4096 * 1024, WB_END = WB_DN + 4096 * 1024;
constexpr size_t WS_G = WS_WB + WB_END * 2;
constexpr size_t G_U = 0, G_W = (size_t)NTOK * 512, G_QP = 2 * G_W, G_KPT = 3 * G_W, G_QK = 4 * G_W, G_END = 4 * G_W + (size_t)NTOK * 256;
constexpr size_t WS_H = WS_G, WS_Y = WS_G + (size_t)NTOK * 1024 * 2;
constexpr size_t WS_HKPT = WS_G + G_END * 2;
constexpr size_t WS_HQK = WS_HKPT + (size_t)NTOK * 512 * 2;
constexpr size_t WS_HDA = WS_HQK + (size_t)NTOK * 256 * 2;
constexpr size_t WS_GGL = WS_HDA + (size_t)NCHUNK * 512 * 4;
constexpr size_t WS_RLA = WS_GGL + 8192;
constexpr size_t WS_RU = WS_RLA + (size_t)NTOK * 512 * 2;
constexpr size_t WS_RAGG = WS_RU + (size_t)NTOK * 512 * 2;
constexpr size_t WS_BAR = WS_RAGG + (size_t)NCHUNK * 512 * 8;
constexpr size_t WS_HS = WS_BAR + 16384;
constexpr size_t WS_HD = WS_HS + (size_t)15 * 4 * 16384 * 4;
constexpr size_t WS_GB = WS_HD + (size_t)15 * 4 * 128 * 4;
constexpr size_t WS_GP = WS_GB + (size_t)15 * 4 * 16384 * 4;
constexpr size_t WS_END = WS_GP + (size_t)15 * 4 * 16384 * 2;

struct Params {
  const float *x_prompt, *x_sample, *st_hgrn, *st_rglru, *st_rglru_conv, *st_gdn, *st_gdn_conv, *lb_raw, *n_pre_mix,
      *n_post_mix, *n_pre_mlp, *n_post_mlp, *w_in, *a_norm, *b_conv_w, *b_conv_b, *b_ga_w, *b_ga_b, *b_gx_w, *b_gx_b,
      *b_lambda, *c_conv_w, *c_a_log, *c_dt_bias, *c_norm, *w_br_a, *w_br_b, *w_br_c, *w_out, *w_up, *w_down;
  float* out;
  char* ws;
};

__device__ __forceinline__ u16 f2bf(float f) {
  unsigned u = __float_as_uint(f);
  u += 0x7fffu + ((u >> 16) & 1u);
  return (u16)(u >> 16);
}
__device__ __forceinline__ float bf2f(u16 h) { return __uint_as_float(((unsigned)h) << 16); }
__device__ __forceinline__ float sigm(float x) { return 1.f / (1.f + __expf(-x)); }
__device__ __forceinline__ float silu(float x) { return x * sigm(x); }
__device__ __forceinline__ float softplus(float x) { return fmaxf(x, 0.f) + __logf(1.f + __expf(-fabsf(x))); }
__device__ __forceinline__ float gelu_t(float x) {
  const float u = 1.5957691216f * (x + 0.044715f * x * x * x);
  return x * sigm(u);
}
__device__ __forceinline__ unsigned pack2(float a, float b) { return (unsigned)f2bf(a) | ((unsigned)f2bf(b) << 16); }

template <class T> __device__ __forceinline__ T* opq(T* x) { asm volatile("" : "+s"(x)); return x; }
#define OPAQUE_TID(t) int t = threadIdx.x; asm volatile("" : "+v"(t))

template <int K>
__device__ __forceinline__ f32x4 mma_lds_(int lane, const u16* a, int lda, const u16* b, int ldb, f32x4 acc) {
  const int r = lane & 15, q = lane >> 4;
  const u16* pa = a + r * lda + q * 8;
  const u16* pb = b + r * ldb + q * 8;
#pragma unroll
  for (int k = 0; k < K; k += 32) {
    bf16x8 af = *(const bf16x8*)(pa + k);
    bf16x8 bf = *(const bf16x8*)(pb + k);
    acc = __builtin_amdgcn_mfma_f32_16x16x32_bf16(af, bf, acc, 0, 0, 0);
  }
  return acc;
}

constexpr int BM = 128, BK = 64, LDT = 72;
constexpr int SMEM_BYTES = 75776;

template <int NJ>
__device__ __forceinline__ void gemm_tile(u16* smem, const u16* __restrict__ A, int lda, const u16* __restrict__ Bt,
                                          int ldb, int K, int m0, int n0, f32x4 (&acc)[4][NJ]) {
  OPAQUE_TID(tid);
  const int lane = tid & 63, wid = tid >> 6, wr = wid >> 1, wc = wid & 1, fr = lane & 15, fq = lane >> 4;
#pragma unroll
  for (int i = 0; i < 4; i++)
#pragma unroll
    for (int j = 0; j < NJ; j++) acc[i][j] = (f32x4){0.f, 0.f, 0.f, 0.f};
  const int lrow = tid >> 3, lc8 = (tid & 7) * 8;
  const u16* ga = A + (size_t)(m0 + lrow) * lda + lc8;
  const u16* gb = Bt + (size_t)(n0 + lrow) * ldb + lc8;
  u32x4 ra[4], rb[NJ];
#pragma unroll
  for (int i = 0; i < 4; i++) {
    ra[i] = *(const u32x4*)(ga + (size_t)i * 32 * lda);
    if (i < NJ) rb[i] = *(const u32x4*)(gb + (size_t)i * 32 * ldb);
  }
#pragma unroll
  for (int i = 0; i < 4; i++) {
    *(u32x4*)(smem + (lrow + i * 32) * LDT + lc8) = ra[i];
    if (i < NJ) *(u32x4*)(smem + BM * LDT + (lrow + i * 32) * LDT + lc8) = rb[i];
  }
  __syncthreads();
  const int nk = K / BK;
  for (int kt = 0; kt < nk; kt++) {
    const int cur = kt & 1;
    const bool more = (kt + 1 < nk);
    if (more) {
      ga += BK; gb += BK;
#pragma unroll
      for (int i = 0; i < 4; i++) {
        ra[i] = *(const u32x4*)(ga + (size_t)i * 32 * lda);
        if (i < NJ) rb[i] = *(const u32x4*)(gb + (size_t)i * 32 * ldb);
      }
    }
    const u16* a = smem + cur * 2 * BM * LDT + (wr * 64 + fr) * LDT + fq * 8;
    const u16* b = smem + cur * 2 * BM * LDT + BM * LDT + (wc * 16 * NJ + fr) * LDT + fq * 8;
#pragma unroll
    for (int ks = 0; ks < 2; ks++) {
      bf16x8 af[4], bf[NJ];
#pragma unroll
      for (int i = 0; i < 4; i++) {
        af[i] = *(const bf16x8*)(a + i * 16 * LDT + ks * 32);
        if (i < NJ) bf[i] = *(const bf16x8*)(b + i * 16 * LDT + ks * 32);
      }
#pragma unroll
      for (int i = 0; i < 4; i++)
#pragma unroll
        for (int j = 0; j < NJ; j++) acc[i][j] = __builtin_amdgcn_mfma_f32_16x16x32_bf16(af[i], bf[j], acc[i][j], 0, 0, 0);
    }
    if (more) {
      u16* sa = smem + (cur ^ 1) * 2 * BM * LDT;
#pragma unroll
      for (int i = 0; i < 4; i++) {
        *(u32x4*)(sa + (lrow + i * 32) * LDT + lc8) = ra[i];
        if (i < NJ) *(u32x4*)(sa + BM * LDT + (lrow + i * 32) * LDT + lc8) = rb[i];
      }
    }
    __syncthreads();
  }
}

__device__ __forceinline__ void tile_coords(int tile, int NT, int& mt, int& nt) {
  const int band = tile / (8 * NT), within = tile % (8 * NT);
  mt = band * 8 + (within & 7);
  nt = within >> 3;
}

__device__ __forceinline__ void gemm_phase(u16* smem, const u16* A, int lda, const u16* Bt, int ldb, int N, int K, u16* C, int ldc, int EPI) {
  const int NT = N / 128, MT = NTOK / 128;
  OPAQUE_TID(tid);
  const int lane = tid & 63, wid = tid >> 6, wr = wid >> 1, wc = wid & 1, fr = lane & 15, fq = lane >> 4;
  for (int tile = blockIdx.x; tile < MT * NT; tile += gridDim.x) {
    int mt, nt;
    tile_coords(tile, NT, mt, nt);
    f32x4 acc[4][4];
    gemm_tile<4>(smem, A, lda, Bt, ldb, K, mt * 128, nt * 128, acc);
#pragma unroll
    for (int i = 0; i < 4; i++)
#pragma unroll
      for (int j = 0; j < 4; j++)
#pragma unroll
        for (int e = 0; e < 4; e++) {
          const int row = mt * 128 + wr * 64 + i * 16 + fq * 4 + e, col = nt * 128 + wc * 64 + j * 16 + fr;
          float v = acc[i][j][e];
          if (EPI == 1) { v = fmaxf(v, 0.f); v = v * v; }
          C[(size_t)row * ldc + col] = f2bf(v);
        }
  }
}

__device__ __forceinline__ void glds16(const void* gsrc, unsigned lds_dst) {
  unsigned keep;
  asm volatile("s_mov_b32 %0, m0\n\ts_mov_b32 m0, %2\n\ts_nop 0\n\tglobal_load_lds_dwordx4 %1, off\n\ts_mov_b32 m0, %0"
               : "=&s"(keep) : "v"(gsrc), "s"(lds_dst) : "memory");
}

constexpr int BMB = 288, LDB_ = 40, STG = (BMB + 128) * LDB_;
constexpr int STGG = (BMB + 128) * 32;
__device__ __forceinline__ void gemm_big_phase(u16* smem, const u16* __restrict__ A, int lda, const u16* __restrict__ Bt, int ldb,
                                               int N, int K, u16* C, int ldc, int EPI) {
  const int NT = N / 128, MT = NTOK / BMB;
  OPAQUE_TID(tid);
  const int lane = tid & 63, wid = tid >> 6, wr = wid >> 1, wc = wid & 1, fr = lane & 15, fq = lane >> 4;
  const int nmc = (NT + 7) >> 3;
  const bool xcd_order = (gridDim.x == 512);
  const int nwork = xcd_order ? 8 * nmc * 64 : MT * NT;
  for (int w = blockIdx.x; w < nwork; w += gridDim.x) {
    int mt, nt;
    if (xcd_order) {
      const int q = (w >> 9) * 8 + (w & 7), slot = (w >> 3) & 63;
      mt = (q & 7) * 8 + (slot & 7); nt = (q >> 3) * 8 + (slot >> 3);
      if (nt >= NT) continue;
    } else {
      tile_coords(w, NT, mt, nt);
    }
    const int m0 = mt * BMB, n0 = nt * 128;
    f32x4 acc[9][4];
#pragma unroll
    for (int i = 0; i < 9; i++)
#pragma unroll
      for (int j = 0; j < 4; j++) acc[i][j] = (f32x4){0.f, 0.f, 0.f, 0.f};
    const int gl_row = lane >> 2, gl_c = (lane & 3) ^ ((lane >> 4) & 3);
    const unsigned oA = ((unsigned)(m0 + gl_row) * (unsigned)lda + gl_c * 8) * 2u;
    const unsigned oB = ((unsigned)(n0 + gl_row) * (unsigned)ldb + gl_c * 8) * 2u;
    const char* Ab = (const char*)A; const char* Bb = (const char*)Bt;
    const int pc = fq ^ (fr >> 2);
    const int nk = K / 32;
    const int uw = __builtin_amdgcn_readfirstlane(wid);
    const unsigned lds0 = (unsigned)__builtin_amdgcn_readfirstlane((int)(unsigned)(size_t)smem);
#define GG_STAGE(st_, kt_) do { \
      _Pragma("unroll") \
      for (int k_ = 0; k_ < 5; k_++) { \
        const int a_ = uw + 4 * k_; \
        if (a_ < 18) glds16(Ab + (oA + (unsigned)((16 * a_) * lda + (kt_) * 32) * 2u), lds0 + (unsigned)(((st_) * STGG + a_ * 512) * 2)); \
      } \
      _Pragma("unroll") \
      for (int k_ = 0; k_ < 2; k_++) { \
        const int b_ = uw + 4 * k_; \
        glds16(Bb + (oB + (unsigned)((16 * b_) * ldb + (kt_) * 32) * 2u), lds0 + (unsigned)(((st_) * STGG + 9216 + b_ * 512) * 2)); \
      } \
    } while (0)
    GG_STAGE(0, 0);
    asm volatile("s_waitcnt vmcnt(0)" ::: "memory");
    __syncthreads();
    for (int kt = 0; kt < nk; kt++) {
      const int cur = kt & 1;
      if (kt + 1 < nk) GG_STAGE(cur ^ 1, kt + 1);
      const u16* a = smem + cur * STGG + (wr * 144 + fr) * 32 + pc * 8;
      const u16* b = smem + cur * STGG + 9216 + (wc * 64 + fr) * 32 + pc * 8;
      bf16x8 bf[4], af[9];
#pragma unroll
      for (int j = 0; j < 4; j++) bf[j] = *(const bf16x8*)(b + j * 512);
#pragma unroll
      for (int i = 0; i < 9; i++) af[i] = *(const bf16x8*)(a + i * 512);
      __builtin_amdgcn_sched_barrier(0);
#pragma unroll
      for (int i = 0; i < 9; i++)
#pragma unroll
        for (int j = 0; j < 4; j++) acc[i][j] = __builtin_amdgcn_mfma_f32_16x16x32_bf16(af[i], bf[j], acc[i][j], 0, 0, 0);
      __builtin_amdgcn_sched_barrier(0);
      asm volatile("s_waitcnt vmcnt(0)" ::: "memory");
      __syncthreads();
    }
    {
      u16* scr = smem + STGG + wid * 16 * 72;
#pragma unroll
      for (int i = 0; i < 9; i++) {
#pragma unroll
        for (int j = 0; j < 4; j++)
#pragma unroll
          for (int e = 0; e < 4; e++) {
            float v = acc[i][j][e];
            if (EPI == 1) { v = fmaxf(v, 0.f); v = v * v; }
            scr[(fq * 4 + e) * 72 + j * 16 + fr] = f2bf(v);
          }
#pragma unroll
        for (int h = 0; h < 2; h++) {
          const int rr = h * 8 + (lane >> 3), cc = (lane & 7) * 8;
          const u32x4 v = *(const u32x4*)(scr + rr * 72 + cc);
          *(u32x4*)(C + (size_t)(m0 + wr * 144 + i * 16 + rr) * ldc + n0 + wc * 64 + cc) = v;
        }
      }
    }
  }
}

__device__ __forceinline__ void merge_phase(u16* smem, const Params& p) {
  const u16* z = (const u16*)(p.ws + WS_Z);
  const u16* wb = (const u16*)(p.ws + WS_WB) + WB_BR;
  const u16* ru = (const u16*)(p.ws + WS_RU);
  u16* H = (u16*)(p.ws + WS_H);
  const int NT = 8, MT = NTOK / 128;
  OPAQUE_TID(tid);
  const int lane = tid & 63, wid = tid >> 6, wr = wid >> 1, wc = wid & 1, fr = lane & 15, fq = lane >> 4;
  const int lrow = tid >> 3, lc8 = (tid & 7) * 8;
  for (int tile = blockIdx.x; tile < MT * NT; tile += gridDim.x) {
    int mt, nt;
    tile_coords(tile, NT, mt, nt);
    const int m0 = mt * 128, n0 = nt * 128;
    f32x4 tot[4][4], acc[4][4];
#pragma unroll
    for (int i = 0; i < 4; i++)
#pragma unroll
      for (int j = 0; j < 4; j++) { tot[i][j] = (f32x4){0.f, 0.f, 0.f, 0.f}; acc[i][j] = tot[i][j]; }
    u32x4 ra[4], rb[4];
    unsigned gv[4][4][2];
#define MG_LOAD(it_) do { \
      const int sg_ = (it_) >> 3, kk_ = (it_) & 7; \
      const u16* A_ = (sg_ == 0) ? z + ZA_I : (sg_ == 1) ? ru : z + ZC_V; \
      const int lda_ = (sg_ == 1) ? 512 : ZS; \
      const u16* ga_ = A_ + (size_t)(m0 + lrow) * lda_ + kk_ * 64 + lc8; \
      const u16* gb_ = wb + (size_t)sg_ * 1024 * 512 + (size_t)(n0 + lrow) * 512 + kk_ * 64 + lc8; \
      _Pragma("unroll") \
      for (int i = 0; i < 4; i++) ra[i] = *(const u32x4*)(ga_ + (size_t)i * 32 * lda_); \
      _Pragma("unroll") \
      for (int i = 0; i < 4; i++) rb[i] = *(const u32x4*)(gb_ + (size_t)i * 32 * 512); \
    } while (0)
#define MG_STORE(st_) do { \
      u16* sa_ = smem + (st_) * 2 * BM * LDT; \
      _Pragma("unroll") \
      for (int i = 0; i < 4; i++) *(u32x4*)(sa_ + (lrow + i * 32) * LDT + lc8) = ra[i]; \
      _Pragma("unroll") \
      for (int i = 0; i < 4; i++) *(u32x4*)(sa_ + BM * LDT + (lrow + i * 32) * LDT + lc8) = rb[i]; \
    } while (0)
    MG_LOAD(0);
    MG_STORE(0);
    __syncthreads();
    for (int it = 0; it < 24; it++) {
      const int cur = it & 1, sg = it >> 3, kk = it & 7;
      if (kk == 0) {
#pragma unroll
        for (int i = 0; i < 4; i++)
#pragma unroll
          for (int j = 0; j < 4; j++) {
            const u16* gp = z + (size_t)(m0 + wr * 64 + i * 16 + fq * 4) * ZS + Z_MERGE + sg * 1024 + n0 + wc * 64 + j * 16 + fr;
            gv[i][j][0] = (unsigned)gp[0] | ((unsigned)gp[ZS] << 16);
            gv[i][j][1] = (unsigned)gp[2 * ZS] | ((unsigned)gp[3 * ZS] << 16);
          }
      }
      if (it + 1 < 24) MG_LOAD(it + 1);
      const u16* a = smem + cur * 2 * BM * LDT + (wr * 64 + fr) * LDT + fq * 8;
      const u16* b = smem + cur * 2 * BM * LDT + BM * LDT + (wc * 64 + fr) * LDT + fq * 8;
#pragma unroll
      for (int ks = 0; ks < 2; ks++) {
        bf16x8 af[4], bf[4];
#pragma unroll
        for (int i = 0; i < 4; i++) af[i] = *(const bf16x8*)(a + i * 16 * LDT + ks * 32);
#pragma unroll
        for (int j = 0; j < 4; j++) bf[j] = *(const bf16x8*)(b + j * 16 * LDT + ks * 32);
#pragma unroll
        for (int i = 0; i < 4; i++)
#pragma unroll
          for (int j = 0; j < 4; j++) acc[i][j] = __builtin_amdgcn_mfma_f32_16x16x32_bf16(af[i], bf[j], acc[i][j], 0, 0, 0);
      }
      if (it + 1 < 24) MG_STORE(cur ^ 1);
      if (kk == 7) {
#pragma unroll
        for (int i = 0; i < 4; i++)
#pragma unroll
          for (int j = 0; j < 4; j++) {
            tot[i][j][0] += sigm(bf2f((u16)(gv[i][j][0] & 0xffff))) * acc[i][j][0];
            tot[i][j][1] += sigm(bf2f((u16)(gv[i][j][0] >> 16))) * acc[i][j][1];
            tot[i][j][2] += sigm(bf2f((u16)(gv[i][j][1] & 0xffff))) * acc[i][j][2];
            tot[i][j][3] += sigm(bf2f((u16)(gv[i][j][1] >> 16))) * acc[i][j][3];
            acc[i][j] = (f32x4){0.f, 0.f, 0.f, 0.f};
          }
      }
      __syncthreads();
    }
#pragma unroll
    for (int i = 0; i < 4; i++)
#pragma unroll
      for (int j = 0; j < 4; j++)
#pragma unroll
        for (int e = 0; e < 4; e++) {
          const int row = m0 + wr * 64 + i * 16 + fq * 4 + e, col = n0 + wc * 64 + j * 16 + fr;
          H[(size_t)row * 1024 + col] = f2bf(tot[i][j][e]);
        }
  }
}

__device__ __forceinline__ void merge_big_phase(u16* smem, const Params& p) {
  const u16* z = (const u16*)(p.ws + WS_Z);
  const u16* wb = (const u16*)(p.ws + WS_WB) + WB_BR;
  const u16* ru = (const u16*)(p.ws + WS_RU);
  u16* H = (u16*)(p.ws + WS_H);
  const int NT = 8, MT = NTOK / BMB;
  OPAQUE_TID(tid);
  const int lane = tid & 63, wid = tid >> 6, wr = wid >> 1, wc = wid & 1, fr = lane & 15, fq = lane >> 4;
  for (int tile = blockIdx.x; tile < MT * NT; tile += gridDim.x) {
    int mt, nt;
    tile_coords(tile, NT, mt, nt);
    const int m0 = mt * BMB, n0 = nt * 128;
    f32x4 acc[9][4];
#pragma unroll
    for (int i = 0; i < 9; i++)
#pragma unroll
      for (int j = 0; j < 4; j++) acc[i][j] = (f32x4){0.f, 0.f, 0.f, 0.f};
    const int gl_row = lane >> 2, gl_c = (lane & 3) ^ ((lane >> 4) & 3);
    const int pc = fq ^ (fr >> 2);
    const int uw = __builtin_amdgcn_readfirstlane(wid);
    const unsigned lds0 = (unsigned)__builtin_amdgcn_readfirstlane((int)(unsigned)(size_t)smem);
#define MB_STAGE(st_, it_) do { \
      const int sg_ = (it_) >> 4, kk_ = (it_) & 15; \
      const char* A_ = (const char*)((sg_ == 0) ? z + ZA_I : (sg_ == 1) ? ru : z + ZC_V); \
      const int lda_ = (sg_ == 1) ? 512 : ZS; \
      const char* B_ = (const char*)(wb + (size_t)sg_ * 1024 * 512); \
      const unsigned oA_ = ((unsigned)(m0 + gl_row) * (unsigned)lda_ + gl_c * 8 + kk_ * 32) * 2u; \
      const unsigned oB_ = ((unsigned)(n0 + gl_row) * 512u + gl_c * 8 + kk_ * 32) * 2u; \
      _Pragma("unroll") \
      for (int k_ = 0; k_ < 5; k_++) { \
        const int a_ = uw + 4 * k_; \
        if (a_ < 18) glds16(A_ + (oA_ + (unsigned)(16 * a_ * lda_) * 2u), lds0 + (unsigned)(((st_) * STGG + a_ * 512) * 2)); \
      } \
      _Pragma("unroll") \
      for (int k_ = 0; k_ < 2; k_++) { \
        const int b_ = uw + 4 * k_; \
        glds16(B_ + (oB_ + (unsigned)(16 * b_ * 512) * 2u), lds0 + (unsigned)(((st_) * STGG + 9216 + b_ * 512) * 2)); \
      } \
    } while (0)
#define MB_GSTRIP_LOAD(G_, i_) do { \
        int t_ = tid; asm volatile("" : "+v"(t_)); \
        const int ln_ = t_ & 63, wd_ = t_ >> 6; \
        _Pragma("unroll") \
        for (int h = 0; h < 2; h++) { \
          const int rr = h * 8 + (ln_ >> 3), cc = (ln_ & 7) * 8; \
          nv[h] = *(const u32x4*)(z + (size_t)(m0 + (wd_ >> 1) * 144 + (i_) * 16 + rr) * ZS + Z_MERGE + (G_) * 1024 + n0 + (wd_ & 1) * 64 + cc); \
        } \
      } while (0)
#define MB_GATE(G_, INV) do { \
      u32x4 nv[2]; \
      MB_GSTRIP_LOAD(G_, 0); \
      _Pragma("unroll") \
      for (int i = 0; i < 9; i++) { \
        int t_ = tid; asm volatile("" : "+v"(t_));     \
        const int ln_ = t_ & 63, wd_ = t_ >> 6, fr_ = ln_ & 15, fq_ = ln_ >> 4; \
        u16* scr_ = smem + 2 * STGG + wd_ * 16 * 72; \
        _Pragma("unroll") \
        for (int h = 0; h < 2; h++) { \
          const int rr = h * 8 + (ln_ >> 3), cc = (ln_ & 7) * 8; \
          *(u32x4*)(scr_ + rr * 72 + cc) = nv[h]; \
        } \
        if (i + 1 < 9) MB_GSTRIP_LOAD(G_, i + 1);     \
        _Pragma("unroll") \
        for (int j = 0; j < 4; j++) \
        _Pragma("unroll") \
          for (int e = 0; e < 4; e++) { \
            const float x_ = 1.f + __expf(-bf2f(scr_[(fq_ * 4 + e) * 72 + j * 16 + fr_])); \
            acc[i][j][e] *= (INV) ? x_ : __frcp_rn(x_); \
          } \
      } \
    } while (0)
    MB_STAGE(0, 0);
    asm volatile("s_waitcnt vmcnt(0)" ::: "memory");
    __syncthreads();
#pragma unroll 1
    for (int it = 0; it < 48; it++) {
      const int cur = it & 1;
      if (it + 1 < 48) MB_STAGE(cur ^ 1, it + 1);
      const u16* a = smem + cur * STGG + (wr * 144 + fr) * 32 + pc * 8;
      const u16* b = smem + cur * STGG + 9216 + (wc * 64 + fr) * 32 + pc * 8;
      bf16x8 bf[4], af[9];
#pragma unroll
      for (int j = 0; j < 4; j++) bf[j] = *(const bf16x8*)(b + j * 512);
#pragma unroll
      for (int i = 0; i < 9; i++) af[i] = *(const bf16x8*)(a + i * 512);
      __builtin_amdgcn_sched_barrier(0);
#pragma unroll
      for (int i = 0; i < 9; i++)
#pragma unroll
        for (int j = 0; j < 4; j++) acc[i][j] = __builtin_amdgcn_mfma_f32_16x16x32_bf16(af[i], bf[j], acc[i][j], 0, 0, 0);
      __builtin_amdgcn_sched_barrier(0);
      if ((it & 15) == 15) {
        const int sg = it >> 4, napply = (sg < 2) ? 2 : 1;
#pragma unroll 1
        for (int q = 0; q < napply; q++) { MB_GATE(sg + q, q); }
      }
      asm volatile("s_waitcnt vmcnt(0)" ::: "memory");
      __syncthreads();
    }
    {
#pragma unroll
      for (int i = 0; i < 9; i++) {
        int t_ = tid; asm volatile("" : "+v"(t_));
        const int ln_ = t_ & 63, wd_ = t_ >> 6, fr_ = ln_ & 15, fq_ = ln_ >> 4;
        u16* scr_ = smem + 2 * STGG + wd_ * 16 * 72;
#pragma unroll
        for (int j = 0; j < 4; j++)
#pragma unroll
          for (int e = 0; e < 4; e++) scr_[(fq_ * 4 + e) * 72 + j * 16 + fr_] = f2bf(acc[i][j][e]);
#pragma unroll
        for (int h = 0; h < 2; h++) {
          const int rr = h * 8 + (ln_ >> 3), cc = (ln_ & 7) * 8;
          const u32x4 v = *(const u32x4*)(scr_ + rr * 72 + cc);
          *(u32x4*)(H + (size_t)(m0 + (wd_ >> 1) * 144 + i * 16 + rr) * 1024 + n0 + (wd_ & 1) * 64 + cc) = v;
        }
      }
    }
  }
}

__device__ __forceinline__ void conv_w_tile(float* sm, const float* __restrict__ W, int K, int N, u16* Wt, int kt, int nt) {
  OPAQUE_TID(tid);
  const int lane = tid & 63, wid = tid >> 6;
  const int n = nt * 64 + lane;
#pragma unroll
  for (int i = 0; i < 16; i++) {
    const int k = wid * 16 + i;
    sm[lane * 65 + k] = (n < N) ? W[(size_t)(kt * 64 + k) * N + n] : 0.f;
  }
  __syncthreads();
  const int nn = tid >> 2, ks = (tid & 3) * 16;
  const float* s = sm + nn * 65 + ks;
  uint4 o0, o1;
  o0.x = pack2(s[0], s[1]); o0.y = pack2(s[2], s[3]); o0.z = pack2(s[4], s[5]); o0.w = pack2(s[6], s[7]);
  o1.x = pack2(s[8], s[9]); o1.y = pack2(s[10], s[11]); o1.z = pack2(s[12], s[13]); o1.w = pack2(s[14], s[15]);
  u16* dst = Wt + (size_t)(nt * 64 + nn) * K + kt * 64 + ks;
  *(uint4*)dst = o0;
  *(uint4*)(dst + 8) = o1;
  __syncthreads();
}

__device__ __forceinline__ void wconv_phase(u16* smem, const Params& p, int l) {
  float* sm = (float*)smem;
  u16* wb = (u16*)(p.ws + WS_WB);
  const int total = 2080 + 384 + 256 + 1024 + 1024;
  for (int t = blockIdx.x; t < total; t += gridDim.x) {
    const float* src; u16* dst; int K, N, kt, nt;
    if (t < 2080) {
      src = opq(p.w_in) + (size_t)l * 1024 * DIN; K = 1024; N = DIN; dst = wb + WB_IN; kt = t / 130; nt = t % 130;
    } else if (t < 2080 + 384) {
      const int u = t - 2080, br = u / 128, v = u % 128;
      src = (br == 0 ? opq(p.w_br_a) : br == 1 ? opq(p.w_br_b) : opq(p.w_br_c)) + (size_t)l * 512 * 1024;
      K = 512; N = 1024; dst = wb + WB_BR + (size_t)br * 1024 * 512; kt = v / 16; nt = v % 16;
    } else if (t < 2080 + 384 + 256) {
      const int u = t - 2464;
      src = opq(p.w_out) + (size_t)l * 1024 * 1024; K = 1024; N = 1024; dst = wb + WB_OUT; kt = u / 16; nt = u % 16;
    } else if (t < 2080 + 384 + 256 + 1024) {
      const int u = t - 2720;
      src = opq(p.w_up) + (size_t)l * 1024 * 4096; K = 1024; N = 4096; dst = wb + WB_UP; kt = u / 64; nt = u % 64;
    } else {
      const int u = t - 3744;
      src = opq(p.w_down) + (size_t)l * 4096 * 1024; K = 4096; N = 1024; dst = wb + WB_DN; kt = u / 16; nt = u % 16;
    }
    conv_w_tile(sm, src, K, N, dst, kt, nt);
  }
}

__device__ __forceinline__ float wave_sum(float v) {
#pragma unroll
  for (int o = 32; o >= 1; o >>= 1) v += __shfl_xor(v, o);
  return v;
}

__device__ __forceinline__ void rowpass_phase(const Params& p, bool from_input, const u16* Y, const float* postw, const float* prew, u16* H) {
  OPAQUE_TID(tid);
  const int lane = tid & 63, wid = tid >> 6;
  const float* xpr = opq(p.x_prompt); const float* xsa = opq(p.x_sample); const float* xo = opq((const float*)p.out);
  const int stride = gridDim.x * 4;
  for (int row0 = blockIdx.x * 4 + wid; row0 < NTOK; row0 += 3 * stride) {
    float xv[3][16], yv[3][16];
#pragma unroll
    for (int k = 0; k < 3; k++) {
      const int row = min(row0 + k * stride, NTOK - 1);
      const float* xin = from_input ? (row < TP ? xpr + (size_t)row * D : xsa + (size_t)(row - TP) * D) : xo + (size_t)row * D;
#pragma unroll
      for (int i = 0; i < 4; i++) {
        const float4 v = *(const float4*)(xin + lane * 4 + i * 256);
        xv[k][i * 4] = v.x; xv[k][i * 4 + 1] = v.y; xv[k][i * 4 + 2] = v.z; xv[k][i * 4 + 3] = v.w;
      }
      if (Y) {
#pragma unroll
        for (int i = 0; i < 4; i++) {
          const uint2 v = *(const uint2*)(Y + (size_t)row * D + lane * 4 + i * 256);
          yv[k][i * 4] = bf2f((u16)(v.x & 0xffff)); yv[k][i * 4 + 1] = bf2f((u16)(v.x >> 16));
          yv[k][i * 4 + 2] = bf2f((u16)(v.y & 0xffff)); yv[k][i * 4 + 3] = bf2f((u16)(v.y >> 16));
        }
      }
    }
#pragma unroll
    for (int k = 0; k < 3; k++) {
      const int row = row0 + k * stride;
      if (row < NTOK) {
        if (Y) {
          float ss = 0.f;
#pragma unroll
          for (int i = 0; i < 16; i++) ss += yv[k][i] * yv[k][i];
          ss = wave_sum(ss);
          const float r = rsqrtf(ss * (1.f / D) + EPS);
#pragma unroll
          for (int i = 0; i < 4; i++) {
            const float4 w = *(const float4*)(postw + lane * 4 + i * 256);
            xv[k][i * 4] += yv[k][i * 4] * r * w.x; xv[k][i * 4 + 1] += yv[k][i * 4 + 1] * r * w.y;
            xv[k][i * 4 + 2] += yv[k][i * 4 + 2] * r * w.z; xv[k][i * 4 + 3] += yv[k][i * 4 + 3] * r * w.w;
          }
        }
        if (Y || from_input) {
#pragma unroll
          for (int i = 0; i < 4; i++)
            *(float4*)(p.out + (size_t)row * D + lane * 4 + i * 256) =
                make_float4(xv[k][i * 4], xv[k][i * 4 + 1], xv[k][i * 4 + 2], xv[k][i * 4 + 3]);
        }
        if (prew) {
          float ss = 0.f;
#pragma unroll
          for (int i = 0; i < 16; i++) ss += xv[k][i] * xv[k][i];
          ss = wave_sum(ss);
          const float r = rsqrtf(ss * (1.f / D) + EPS);
#pragma unroll
          for (int i = 0; i < 4; i++) {
            const float4 w = *(const float4*)(prew + lane * 4 + i * 256);
            uint2 o;
            o.x = pack2(xv[k][i * 4] * r * w.x, xv[k][i * 4 + 1] * r * w.y);
            o.y = pack2(xv[k][i * 4 + 2] * r * w.z, xv[k][i * 4 + 3] * r * w.w);
            *(uint2*)(H + (size_t)row * D + lane * 4 + i * 256) = o;
          }
        }
      }
    }
  }
}

__device__ __forceinline__ void hgrn_prep(u16* smem, const Params& p, int l, int c, int hd) {
  u16* z = (u16*)(p.ws + WS_Z);
  u16* sq = smem;
  u16* skt = smem + 64 * 136;
  u16* skh = smem + 2 * 64 * 136;
  float* sd = (float*)(smem + 3 * 64 * 136);
  OPAQUE_TID(tid);
  const int lane = tid & 63, wid = tid >> 6, fr = lane & 15, fq = lane >> 4;
  const int tok0 = c * 64;
  {
    const int hb = tid >> 7, ch = tid & 127, col = hd * 128 + ch;
    float lbv = 0.f;
    if (l > 0) {
      const float r0 = p.lb_raw[col], r1 = p.lb_raw[512 + col], r2 = p.lb_raw[1024 + col], r3 = p.lb_raw[1536 + col];
      const float m = fmaxf(fmaxf(r0, r1), fmaxf(r2, r3));
      const float e0 = __expf(r0 - m), e1 = __expf(r1 - m), e2 = __expf(r2 - m), e3 = __expf(r3 - m);
      const float inv = 1.f / (e0 + e1 + e2 + e3);
      lbv = e1 * inv;
      if (l > 1) lbv += e2 * inv;
      if (l > 2) lbv += e3 * inv;
    }
    {
      u32x4 rq[4], rf[4];
#pragma unroll
      for (int i = 0; i < 4; i++) {
        const int idx = tid + i * 256, row = idx >> 4, c8 = (idx & 15) * 8;
        rq[i] = *(const u32x4*)(z + (size_t)(tok0 + row) * ZS + ZA_Q + hd * 128 + c8);
        rf[i] = *(const u32x4*)(z + (size_t)(tok0 + row) * ZS + ZA_F + hd * 128 + c8);
      }
#pragma unroll
      for (int i = 0; i < 4; i++) {
        const int idx = tid + i * 256, row = idx >> 4, c8 = (idx & 15) * 8;
        *(u32x4*)(sq + row * 136 + c8) = rq[i];
        *(u32x4*)(skt + row * 136 + c8) = rf[i];
      }
    }
    __syncthreads();
    float bb[32];
    float run = 0.f;
#pragma unroll
    for (int t = 0; t < 32; t++) {
      const float zf = bf2f(skt[(hb * 32 + t) * 136 + ch]);
      const float f = lbv + (1.f - lbv) * sigm(zf);
      const float logf = (lbv > 0.f) ? __logf(f) : (fminf(zf, 0.f) - __logf(1.f + __expf(-fabsf(zf))));
      run += logf;
      bb[t] = run;
    }
    const float blast = run;
#pragma unroll
    for (int t = 0; t < 32; t++) {
      const int o = (hb * 32 + t) * 136 + ch;
      const float zq = bf2f(sq[o]), zf = bf2f(skt[o]);
      const float qv = silu(zq), kv = (1.f - lbv) * sigm(-zf);
      sq[o] = f2bf(qv * __expf(bb[t]));
      skt[o] = f2bf(kv * __expf(fminf(-bb[t], 80.f)));
      skh[o] = f2bf(kv * __expf(blast - bb[t]));
    }
    sd[hb * 128 + ch] = __expf(blast);
  }
  __syncthreads();
  {
    u16* qk = (u16*)(p.ws + WS_HQK);
    const int ti = wid;
    for (int si = 0; si < 4; si++) {
      f32x4 acc = (f32x4){0.f, 0.f, 0.f, 0.f};
      const bool upper = (ti < 2 && si >= 2);
      const bool cross = (ti >= 2 && si < 2);
      if (!upper && !((ti >> 1) == (si >> 1) && si > ti))
        acc = mma_lds_<128>(lane, sq + ti * 16 * 136, 136, (cross ? skh : skt) + si * 16 * 136, 136, acc);
#pragma unroll
      for (int e = 0; e < 4; e++) {
        const int t = ti * 16 + fq * 4 + e, s = si * 16 + fr;
        float v = acc[e];
        if (!cross && s > t) v = 0.f;
        qk[(size_t)(tok0 + t) * 256 + hd * 64 + s] = f2bf(v);
      }
    }
  }
  {
#pragma unroll 4
    for (int i = 0; i < 32; i++) {
      const int e = tid + i * 256, t = e >> 7, ch = e & 127;
      float v = bf2f(sq[t * 136 + ch]);
      if (t >= 32) v *= sd[ch];
      z[(size_t)(tok0 + t) * ZS + ZA_Q + hd * 128 + ch] = f2bf(v);
    }
    u16* kpt = (u16*)(p.ws + WS_HKPT) + (size_t)(c * 4 + hd) * 128 * 64;
#pragma unroll 4
    for (int i = 0; i < 32; i++) {
      const int e = tid + i * 256, dk = e >> 6, t = e & 63;
      float v = bf2f(skh[t * 136 + dk]);
      if (t < 32) v *= sd[128 + dk];
      kpt[dk * 64 + t] = f2bf(v);
    }
    if (tid < 128) ((float*)(p.ws + WS_HDA))[c * 512 + hd * 128 + tid] = sd[tid] * sd[128 + tid];
  }
  __syncthreads();
}

__device__ __forceinline__ void gdn_prep(u16* smem, const Params& p, int l, int c, int hd) {
  const u16* z = (const u16*)(p.ws + WS_Z);
  u16* sq = smem;
  u16* sk = smem + 64 * 136;
  u16* sv = smem + 2 * 64 * 136;
  float* sAm = (float*)(smem + 3 * 64 * 136);
  float* sgc = sAm + 64 * 68;
  float* sbeta = sgc + 64;
  OPAQUE_TID(tid);
  const int lane = tid & 63, wid = tid >> 6, fr = lane & 15, fq = lane >> 4;
  const int tok0 = c * 64;
  const bool first = (c == 0) || (c >= 256);
  const int sb = c - 256;
  u16* sraw = (u16*)sAm;
  u32x4 rraw[3][5];
#pragma unroll
  for (int part = 0; part < 3; part++)
#pragma unroll
    for (int i = 0; i < 5; i++) {
      const int idx = tid + i * 256, row = idx >> 4, c8 = (idx & 15) * 8, rr = row - 3;
      const int colq = part * 512 + hd * 128 + c8;
      u32x4 v = (u32x4){0u, 0u, 0u, 0u};
      if (idx < 67 * 16) {
        if (rr >= 0 || !first) {
          v = *(const u32x4*)(z + (size_t)(tok0 + rr) * ZS + ZC_Q + colq);
        } else if (c >= 256) {
          const float* st = p.st_gdn_conv + ((size_t)(l * 32 + sb) * 3 + row) * 1536 + colq;
          const float4 f0 = *(const float4*)st, f1 = *(const float4*)(st + 4);
          v = (u32x4){pack2(f0.x, f0.y), pack2(f0.z, f0.w), pack2(f1.x, f1.y), pack2(f1.z, f1.w)};
        }
      }
      rraw[part][i] = v;
    }
#pragma unroll
  for (int part = 0; part < 3; part++) {
    if (part > 0) __syncthreads();
#pragma unroll
    for (int i = 0; i < 5; i++) {
      const int idx = tid + i * 256, row = idx >> 4, c8 = (idx & 15) * 8;
      if (idx < 67 * 16) *(u32x4*)(sraw + row * 136 + c8) = rraw[part][i];
    }
    __syncthreads();
    {
      const int cc = tid & 127, half = tid >> 7, colq = part * 512 + hd * 128 + cc;
      const float* cw = p.c_conv_w + (size_t)l * 4 * 1536 + colq;
      const float w0 = cw[0], w1 = cw[1536], w2 = cw[2 * 1536], w3 = cw[3 * 1536];
      const u16* src = sraw + (half * 32) * 136 + cc;
      u16* dst = smem + part * 64 * 136 + (half * 32) * 136 + cc;
      float x0 = bf2f(src[0]), x1 = bf2f(src[136]), x2 = bf2f(src[2 * 136]);
#pragma unroll 8
      for (int t = 0; t < 32; t++) {
        const float x3 = bf2f(src[(t + 3) * 136]);
        const float y = w0 * x0 + w1 * x1 + w2 * x2 + w3 * x3;
        dst[t * 136] = f2bf(silu(y));
        x0 = x1; x1 = x2; x2 = x3;
      }
      if ((c == 255 || c >= 256) && half == 0) {
        float* dsto = (c == 255) ? p.out + O_PGC + (size_t)l * 3 * 1536 : p.out + O_SGC + (size_t)(l * 32 + sb) * 3 * 1536;
#pragma unroll
        for (int j = 0; j < 3; j++) dsto[j * 1536 + colq] = bf2f(sraw[(64 + j) * 136 + cc]);
      }
    }
  }
  __syncthreads();
  {
    const int t = tid >> 2, qd = tid & 3;
#pragma unroll
    for (int part = 0; part < 2; part++) {
      u16* r = smem + part * 64 * 136 + t * 136 + qd * 32;
      float ss = 0.f;
#pragma unroll
      for (int i = 0; i < 32; i++) { const float v = bf2f(r[i]); ss += v * v; }
      ss += __shfl_xor(ss, 1);
      ss += __shfl_xor(ss, 2);
      const float sc = rsqrtf(ss + EPS) * (part == 0 ? 0.08838834764831845f : 1.f);
#pragma unroll
      for (int i = 0; i < 32; i++) r[i] = f2bf(bf2f(r[i]) * sc);
    }
  }
  if (tid < 64) {
    const float beta = sigm(bf2f(z[(size_t)(tok0 + tid) * ZS + ZC_BETA + hd]));
    const float al = bf2f(z[(size_t)(tok0 + tid) * ZS + ZC_ALPHA + hd]);
    float g = -__expf(p.c_a_log[l * 4 + hd]) * softplus(al + p.c_dt_bias[l * 4 + hd]);
#pragma unroll
    for (int o = 1; o < 64; o <<= 1) {
      const float v = __shfl_up(g, o);
      if (lane >= o) g += v;
    }
    sgc[tid] = g;
    sbeta[tid] = beta;
  }
  __syncthreads();
  {
    u16* gqk = (u16*)(p.ws + WS_G) + G_QK;
    const int ti = wid;
    for (int si = 0; si < 4; si++) {
      f32x4 a1 = (f32x4){0.f, 0.f, 0.f, 0.f}, a2 = (f32x4){0.f, 0.f, 0.f, 0.f};
      if (si <= ti) {
        a1 = mma_lds_<128>(lane, sk + ti * 16 * 136, 136, sk + si * 16 * 136, 136, a1);
        a2 = mma_lds_<128>(lane, sq + ti * 16 * 136, 136, sk + si * 16 * 136, 136, a2);
      }
#pragma unroll
      for (int e = 0; e < 4; e++) {
        const int t = ti * 16 + fq * 4 + e, s = si * 16 + fr;
        const float dec = (s <= t) ? __expf(sgc[t] - sgc[s]) : 0.f;
        sAm[s * 68 + t] = (s < t) ? sbeta[t] * a1[e] * dec : 0.f;
        gqk[(size_t)(tok0 + t) * 256 + hd * 64 + s] = f2bf((s <= t) ? a2[e] * dec : 0.f);
      }
    }
  }
  __syncthreads();
  {
    const int col = tid & 127, isw = tid >> 7;
    const u16* src = isw ? sk : sv;
    u16* dst = (u16*)(p.ws + WS_G) + (isw ? G_W : G_U) + (size_t)tok0 * 512 + hd * 128 + col;
    float r[64];
#pragma unroll
    for (int t = 0; t < 64; t++) {
      float a = bf2f(src[t * 136 + col]) * sbeta[t];
      if (isw) a *= __expf(sgc[t]);
      r[t] = a;
    }
#pragma unroll
    for (int j = 0; j < 64; j++) {
      const float xj = r[j];
      *dst = f2bf(xj);
      dst += 512;
#pragma unroll
      for (int g = (j + 1) / 4; g < 16; g++) {
        const float4 a4 = *(const float4*)(sAm + j * 68 + g * 4);
        if (g * 4 > j) r[g * 4] -= a4.x * xj;
        if (g * 4 + 1 > j) r[g * 4 + 1] -= a4.y * xj;
        if (g * 4 + 2 > j) r[g * 4 + 2] -= a4.z * xj;
        if (g * 4 + 3 > j) r[g * 4 + 3] -= a4.w * xj;
      }
    }
  }
  {
    u16* gqp = (u16*)(p.ws + WS_G) + G_QP;
    const float gl = sgc[63];
#pragma unroll 4
    for (int i = 0; i < 32; i++) {
      const int e = tid + i * 256, t = e >> 7, cc = e & 127;
      gqp[(size_t)(tok0 + t) * 512 + hd * 128 + cc] = f2bf(bf2f(sq[t * 136 + cc]) * __expf(sgc[t]));
    }
    u16* kpt = (u16*)(p.ws + WS_G) + G_KPT + (size_t)(c * 4 + hd) * 128 * 64;
#pragma unroll 4
    for (int i = 0; i < 32; i++) {
      const int e = tid + i * 256, dk = e >> 6, t = e & 63;
      kpt[dk * 64 + t] = f2bf(bf2f(sk[t * 136 + dk]) * __expf(gl - sgc[t]));
    }
    if (tid == 0) ((float*)(p.ws + WS_GGL))[c * 4 + hd] = __expf(gl);
  }
  __syncthreads();
}

__device__ __forceinline__ void rglru_prep(u16* smem, const Params& p, int l, int c, int n) {
  const u16* z = (const u16*)(p.ws + WS_Z);
  float* sx = (float*)smem;
  float* su = sx + 64 * 65;
  u16* sxb = (u16*)(su + 64 * 65);
  u16* swa = sxb + 64 * 72;
  u16* swx = swa + 64 * 72;
  OPAQUE_TID(tid);
  const int lane = tid & 63, wid = tid >> 6, fr = lane & 15, fq = lane >> 4;
  const int tok0 = c * 64;
  const bool first = (c == 0) || (c >= 256);
  const int sb = c - 256;
  {
    const int ch = tid & 63, tq = tid >> 6, col = n * 64 + ch;
    const float* cw = p.b_conv_w + (size_t)l * 4 * 512 + col;
    const float w0 = cw[0], w1 = cw[512], w2 = cw[1024], w3 = cw[1536], bias = p.b_conv_b[l * 512 + col];
    u16* sraw = swx + 64 * 72;
    {
      u32x4 rr4[3];
#pragma unroll
      for (int i = 0; i < 3; i++) {
        const int idx = tid + i * 256, row = idx >> 3, c8 = (idx & 7) * 8, rr = row - 3;
        u32x4 v = (u32x4){0u, 0u, 0u, 0u};
        if (idx < 67 * 8) {
          if (rr >= 0 || !first) {
            v = *(const u32x4*)(z + (size_t)(tok0 + rr) * ZS + ZB_X + n * 64 + c8);
          } else if (c >= 256) {
            const float* st = p.st_rglru_conv + ((size_t)(l * 32 + sb) * 3 + row) * 512 + n * 64 + c8;
            const float4 f0 = *(const float4*)st, f1 = *(const float4*)(st + 4);
            v = (u32x4){pack2(f0.x, f0.y), pack2(f0.z, f0.w), pack2(f1.x, f1.y), pack2(f1.z, f1.w)};
          }
        }
        rr4[i] = v;
      }
#pragma unroll
      for (int i = 0; i < 3; i++) {
        const int idx = tid + i * 256, row = idx >> 3, c8 = (idx & 7) * 8;
        if (idx < 67 * 8) *(u32x4*)(sraw + row * 72 + c8) = rr4[i];
      }
    }
    __syncthreads();
    {
      const u16* src = sraw + (tq * 16) * 72 + ch;
      float x0 = bf2f(src[0]), x1 = bf2f(src[72]), x2 = bf2f(src[2 * 72]);
#pragma unroll 8
      for (int i = 0; i < 16; i++) {
        const int t = tq * 16 + i;
        const float x3 = bf2f(src[(i + 3) * 72]);
        const float y = w0 * x0 + w1 * x1 + w2 * x2 + w3 * x3 + bias;
        sx[t * 65 + ch] = y;
        sxb[t * 72 + ch] = f2bf(y);
        x0 = x1; x1 = x2; x2 = x3;
      }
    }
    const float* wa = p.b_ga_w + ((size_t)l * 8 + n) * 4096;
    const float* wx = p.b_gx_w + ((size_t)l * 8 + n) * 4096;
#pragma unroll
    for (int i = 0; i < 16; i++) {
      const int e = tid + i * 256, cin = e >> 6, d = e & 63;
      swa[d * 72 + cin] = f2bf(wa[e]);
      swx[d * 72 + cin] = f2bf(wx[e]);
    }
    if (c == 255 || c >= 256) {
      float* dst = (c == 255) ? p.out + O_PRC + (size_t)l * 3 * 512 : p.out + O_SRC + (size_t)(l * 32 + sb) * 3 * 512;
      if (tid < 192) {
        const int j = tid >> 6;
        dst[j * 512 + col] = bf2f(sraw[(64 + j) * 72 + ch]);
      }
    }
  }
  __syncthreads();
  f32x4 ra[4], rx[4];
  {
    const int ti = wid;
#pragma unroll
    for (int si = 0; si < 4; si++) {
      ra[si] = mma_lds_<64>(lane, sxb + ti * 16 * 72, 72, swa + si * 16 * 72, 72, (f32x4){0.f, 0.f, 0.f, 0.f});
      rx[si] = mma_lds_<64>(lane, sxb + ti * 16 * 72, 72, swx + si * 16 * 72, 72, (f32x4){0.f, 0.f, 0.f, 0.f});
    }
  }
  float lav[4][4], uv[4][4];
  {
    const int ti = wid;
#pragma unroll
    for (int si = 0; si < 4; si++) {
      const int d = si * 16 + fr, col = n * 64 + d;
      const float ba = p.b_ga_b[l * 512 + col], bx = p.b_gx_b[l * 512 + col];
      const float sp = softplus(-p.b_lambda[l * 512 + col]);
#pragma unroll
      for (int e = 0; e < 4; e++) {
        const int t = ti * 16 + fq * 4 + e;
        const float r = sigm(ra[si][e] + ba), ig = sigm(rx[si][e] + bx);
        const float la = -8.f * r * sp;
        float mult = sqrtf(fmaxf(1.f - __expf(2.f * la), 0.f));
        if (c == 0 && t == 0) mult = 1.f;
        const float u = mult * ig * sx[t * 65 + d];
        lav[si][e] = bf2f(f2bf(la));
        uv[si][e] = bf2f(f2bf(u));
      }
    }
  }
  __syncthreads();
  {
    const int ti = wid;
    u16* rla = (u16*)(p.ws + WS_RLA);
    u16* ru = (u16*)(p.ws + WS_RU);
#pragma unroll
    for (int si = 0; si < 4; si++) {
      const int d = si * 16 + fr, col = n * 64 + d;
#pragma unroll
      for (int e = 0; e < 4; e++) {
        const int t = ti * 16 + fq * 4 + e;
        sx[t * 65 + d] = lav[si][e];
        su[t * 65 + d] = uv[si][e];
        rla[(size_t)(tok0 + t) * 512 + col] = f2bf(lav[si][e]);
        ru[(size_t)(tok0 + t) * 512 + col] = f2bf(uv[si][e]);
      }
    }
  }
  __syncthreads();
  if (tid < 64) {
    float h = 0.f, sl = 0.f;
    for (int t = 0; t < 64; t++) {
      const float la = sx[t * 65 + tid];
      h = __expf(la) * h + su[t * 65 + tid];
      sl += la;
    }
    float* agg = (float*)(p.ws + WS_RAGG) + ((size_t)c * 512 + n * 64 + tid) * 2;
    agg[0] = sl;
    agg[1] = h;
  }
  __syncthreads();
}

__device__ __forceinline__ void rglru_scan(const Params& p, int l, int c, int hf) {
  OPAQUE_TID(tid);
  const int col = hf * 256 + tid;
  const int tok0 = c * 64;
  float h = 0.f;
  if (c >= 256) {
    h = p.st_rglru[(size_t)(l * 32 + (c - 256)) * 512 + col];
  } else {
    const float* agg = (const float*)(p.ws + WS_RAGG) + (size_t)col * 2;
    for (int cc = 0; cc < c; cc += 16) {
      float2 ab[16];
#pragma unroll
      for (int i = 0; i < 16; i++) ab[i] = *(const float2*)(agg + (size_t)min(cc + i, c - 1) * 1024);
#pragma unroll
      for (int i = 0; i < 16; i++) if (cc + i < c) h = __expf(ab[i].x) * h + ab[i].y;
    }
  }
  const u16* rla = (const u16*)(p.ws + WS_RLA) + (size_t)tok0 * 512 + col;
  u16* ru = (u16*)(p.ws + WS_RU) + (size_t)tok0 * 512 + col;
  for (int t0 = 0; t0 < 64; t0 += 32) {
    float la[32], u[32];
#pragma unroll
    for (int i = 0; i < 32; i++) { la[i] = bf2f(rla[(size_t)(t0 + i) * 512]); u[i] = bf2f(ru[(size_t)(t0 + i) * 512]); }
#pragma unroll
    for (int i = 0; i < 32; i++) {
      h = __expf(la[i]) * h + u[i];
      ru[(size_t)(t0 + i) * 512] = f2bf(h);
    }
  }
  if (c == 255) p.out[O_PR + (size_t)l * 512 + col] = h;
  else if (c >= 256) p.out[O_SR + (size_t)(l * 32 + (c - 256)) * 512 + col] = h;
}

template <bool GDN>
__device__ __forceinline__ void mat_scan(u16* smem, const Params& p, int l, int kind, int seg, int seq, int hd, int sl) {
  u16* z = (u16*)(p.ws + WS_Z);
  u16* sW = smem;
  u16* sQP = smem + 64 * 136;
  u16* sKT = smem + 2 * 64 * 136;
  u16* sQK = sKT + 128 * 72;
  u16* sSt = sQK + 64 * 72;
  u16* sVt = sSt + 32 * 136;
  OPAQUE_TID(tid);
  const int lane = tid & 63, wid = tid >> 6, fr = lane & 15, fq = lane >> 4;
  const int nchunk = (kind == 0) ? 1 : 16;
  const int c0 = (kind == 0) ? 255 + seq : seg * 16;
  const int cg = sl & 3;
  const int dvc = cg * 32 + fr;
  const bool full = (kind != 1);
  const bool uzero = (kind == 1 && sl >= 4);
  const int r16 = tid >> 4, c16 = (tid & 15) * 8;
  const int r8 = tid >> 3, c8 = (tid & 7) * 8;
  f32x4 S[2][2];
  f32x4 Dacc[2];
  { float one_ = 1.f; asm volatile("" : "+v"(one_)); Dacc[0] = (f32x4){one_, one_, one_, one_}; Dacc[1] = Dacc[0]; }
  if (kind == 0) {
    const float* st = (GDN ? p.st_gdn : p.st_hgrn) + ((size_t)(l * 32 + (seq - 1)) * 4 + hd) * 16384;
#pragma unroll
    for (int i = 0; i < 2; i++)
#pragma unroll
      for (int n = 0; n < 2; n++)
#pragma unroll
        for (int e = 0; e < 4; e++) S[i][n][e] = st[((wid * 2 + i) * 16 + fq * 4 + e) * 128 + dvc + n * 16];
  } else if (kind == 1) {
#pragma unroll
    for (int i = 0; i < 2; i++)
#pragma unroll
      for (int n = 0; n < 2; n++)
#pragma unroll
        for (int e = 0; e < 4; e++)
          S[i][n][e] = (sl >= 4 && ((wid * 2 + i) * 16 + fq * 4 + e) == (sl - 4) * 32 + n * 16 + fr) ? 1.f : 0.f;
  } else {
#pragma unroll
    for (int i = 0; i < 2; i++)
#pragma unroll
      for (int n = 0; n < 2; n++) S[i][n] = (f32x4){0.f, 0.f, 0.f, 0.f};
    if (!GDN) {
      const float* hs = (const float*)(p.ws + WS_HS);
      const float* hdp = (const float*)(p.ws + WS_HD);
#pragma unroll 4
      for (int j = 0; j < seg; j++) {
        f32x4 dj[2], sj[2][2];
#pragma unroll
        for (int i = 0; i < 2; i++) {
          dj[i] = *(const f32x4*)(hdp + (size_t)(j * 4 + hd) * 128 + (wid * 2 + i) * 16 + fq * 4);
#pragma unroll
          for (int n = 0; n < 2; n++)
#pragma unroll
            for (int e = 0; e < 4; e++)
              sj[i][n][e] = hs[((size_t)(j * 4 + hd) * 128 + (wid * 2 + i) * 16 + fq * 4 + e) * 128 + dvc + n * 16];
        }
#pragma unroll
        for (int i = 0; i < 2; i++)
#pragma unroll
          for (int n = 0; n < 2; n++) S[i][n] = S[i][n] * dj[i] + sj[i][n];
      }
    } else {
      const float* gb = (const float*)(p.ws + WS_GB);
      const u16* gp = (const u16*)(p.ws + WS_GP);
      u16* sP = smem;
      u32x4 rP[8];
      if (seg > 1) {
#pragma unroll
        for (int i = 0; i < 8; i++) rP[i] = *(const u32x4*)(gp + ((size_t)(1 * 4 + hd) * 128 + r16 + i * 16) * 128 + c16);
      }
      f32x4 bn[2][2];
#pragma unroll
      for (int i = 0; i < 2; i++)
#pragma unroll
        for (int n = 0; n < 2; n++)
#pragma unroll
          for (int e = 0; e < 4; e++)
            bn[i][n][e] = gb[((size_t)(0 * 4 + hd) * 128 + (wid * 2 + i) * 16 + fq * 4 + e) * 128 + dvc + n * 16];
      for (int j = 0; j < seg; j++) {
        f32x4 bj[2][2];
#pragma unroll
        for (int i = 0; i < 2; i++)
#pragma unroll
          for (int n = 0; n < 2; n++) bj[i][n] = bn[i][n];
        if (j == 0) {
#pragma unroll
          for (int i = 0; i < 2; i++)
#pragma unroll
            for (int n = 0; n < 2; n++) S[i][n] = bj[i][n];
          if (seg > 1) {
#pragma unroll
            for (int i = 0; i < 2; i++)
#pragma unroll
              for (int n = 0; n < 2; n++)
#pragma unroll
                for (int e = 0; e < 4; e++)
                  bn[i][n][e] = gb[((size_t)(1 * 4 + hd) * 128 + (wid * 2 + i) * 16 + fq * 4 + e) * 128 + dvc + n * 16];
          }
        } else {
          __syncthreads();
#pragma unroll
          for (int i = 0; i < 8; i++) *(u32x4*)(sP + (r16 + i * 16) * 136 + c16) = rP[i];
#pragma unroll
          for (int i = 0; i < 2; i++)
#pragma unroll
            for (int n = 0; n < 2; n++) {
              uint2 o2;
              o2.x = pack2(S[i][n][0], S[i][n][1]);
              o2.y = pack2(S[i][n][2], S[i][n][3]);
              *(uint2*)(sSt + (n * 16 + fr) * 136 + (wid * 2 + i) * 16 + fq * 4) = o2;
            }
          __syncthreads();
          if (j + 1 < seg) {
#pragma unroll
            for (int i = 0; i < 8; i++) rP[i] = *(const u32x4*)(gp + ((size_t)((j + 1) * 4 + hd) * 128 + r16 + i * 16) * 128 + c16);
#pragma unroll
            for (int i = 0; i < 2; i++)
#pragma unroll
              for (int n = 0; n < 2; n++)
#pragma unroll
                for (int e = 0; e < 4; e++)
                  bn[i][n][e] = gb[((size_t)((j + 1) * 4 + hd) * 128 + (wid * 2 + i) * 16 + fq * 4 + e) * 128 + dvc + n * 16];
          }
#pragma unroll
          for (int i = 0; i < 2; i++)
#pragma unroll
            for (int n = 0; n < 2; n++)
              S[i][n] = mma_lds_<128>(lane, sP + (wid * 2 + i) * 16 * 136, 136, sSt + n * 16 * 136, 136, bj[i][n]);
        }
      }
    }
  }
  const u16* gQP = GDN ? (const u16*)(p.ws + WS_G) + G_QP + hd * 128 : z + ZA_Q + hd * 128;
  const int ldqp = GDN ? 512 : ZS;
  const u16* gKT = GDN ? (const u16*)(p.ws + WS_G) + G_KPT : (const u16*)(p.ws + WS_HKPT);
  const u16* gQK = (GDN ? (const u16*)(p.ws + WS_G) + G_QK : (const u16*)(p.ws + WS_HQK)) + hd * 64;
  const u16* gW = (const u16*)(p.ws + WS_G) + G_W + hd * 128;
  const u16* gU = (const u16*)(p.ws + WS_G) + G_U + hd * 128 + dvc;
  u16* gO = z + (GDN ? ZC_V : ZA_I) + hd * 128 + dvc;

  u32x4 rQP[2][4], rW[2][4], rKT[2][4], rQK[2][2];
  unsigned rV[2][8];
  f32x4 rDv[2][2];
  float rG[2];
#define LOAD_REGS(ST, cx) do { \
    const int c_ = (cx); \
    const size_t tk0_ = (size_t)c_ * 64; \
    _Pragma("unroll") \
    for (int i = 0; i < 4; i++) { \
      if (full) rQP[ST][i] = *(const u32x4*)(gQP + (tk0_ + r16 + i * 16) * ldqp + c16); \
      if (GDN) rW[ST][i] = *(const u32x4*)(gW + (tk0_ + r16 + i * 16) * 512 + c16); \
      rKT[ST][i] = *(const u32x4*)(gKT + ((size_t)(c_ * 4 + hd) * 128 + r8 + i * 32) * 64 + c8); \
    } \
    if (full) { \
    _Pragma("unroll") \
      for (int i = 0; i < 2; i++) rQK[ST][i] = *(const u32x4*)(gQK + (tk0_ + r8 + i * 32) * 256 + c8); \
    } \
    if (GDN) { \
    _Pragma("unroll") \
      for (int n = 0; n < 2; n++) \
    _Pragma("unroll") \
        for (int e = 0; e < 4; e++) rV[ST][n * 4 + e] = uzero ? 0u : (unsigned)gU[(tk0_ + wid * 16 + fq * 4 + e) * 512 + n * 16]; \
      rG[ST] = ((const float*)(p.ws + WS_GGL))[c_ * 4 + hd]; \
    } else { \
    _Pragma("unroll") \
      for (int i = 0; i < 8; i++) { \
        const int e = tid + i * 256; \
        rV[ST][i] = z[(tk0_ + (e >> 5)) * ZS + ZA_I + hd * 128 + cg * 32 + (e & 31)]; \
      } \
      const float* da = (const float*)(p.ws + WS_HDA) + (size_t)c_ * 512 + hd * 128; \
    _Pragma("unroll") \
      for (int i = 0; i < 2; i++) rDv[ST][i] = *(const f32x4*)(da + (wid * 2 + i) * 16 + fq * 4); \
    } \
  } while (0)
#define SCAN_STEP(ST, cix) do { \
    const int ci_ = (cix); \
    const int c = c0 + ci_; \
    const size_t tok0 = (size_t)c * 64; \
    __syncthreads(); \
    _Pragma("unroll") \
    for (int i = 0; i < 4; i++) { \
      if (full) *(u32x4*)(sQP + (r16 + i * 16) * 136 + c16) = rQP[ST][i]; \
      if (GDN) *(u32x4*)(sW + (r16 + i * 16) * 136 + c16) = rW[ST][i]; \
      *(u32x4*)(sKT + (r8 + i * 32) * 72 + c8) = rKT[ST][i]; \
    } \
    if (full) { \
    _Pragma("unroll") \
      for (int i = 0; i < 2; i++) *(u32x4*)(sQK + (r8 + i * 32) * 72 + c8) = rQK[ST][i]; \
    } \
    _Pragma("unroll") \
    for (int i = 0; i < 2; i++) \
    _Pragma("unroll") \
      for (int n = 0; n < 2; n++) { \
        uint2 o2; \
        o2.x = pack2(S[i][n][0], S[i][n][1]); \
        o2.y = pack2(S[i][n][2], S[i][n][3]); \
        *(uint2*)(sSt + (n * 16 + fr) * 136 + (wid * 2 + i) * 16 + fq * 4) = o2; \
      } \
    float uu[8]; \
    if (GDN) { \
    _Pragma("unroll") \
      for (int e = 0; e < 8; e++) uu[e] = bf2f((u16)rV[ST][e]); \
    } else { \
    _Pragma("unroll") \
      for (int i = 0; i < 8; i++) { \
        const int e = tid + i * 256; \
        sVt[(e & 31) * 72 + (e >> 5)] = (u16)rV[ST][i]; \
      } \
    } \
    __syncthreads(); \
    float g_ = 0.f; f32x4 dv0_, dv1_; \
    if (GDN) { g_ = rG[ST]; asm volatile("" : "+v"(g_), "+v"(uu[0]), "+v"(uu[1]), "+v"(uu[2]), "+v"(uu[3]), "+v"(uu[4]), "+v"(uu[5]), "+v"(uu[6]), "+v"(uu[7]) :: "memory"); } \
    else { dv0_ = rDv[ST][0]; dv1_ = rDv[ST][1]; asm volatile("" : "+v"(dv0_), "+v"(dv1_) :: "memory"); } \
    if (ci_ + 2 < nchunk) LOAD_REGS(ST, c + 2); \
    f32x4 o[2]; \
    o[0] = (f32x4){0.f, 0.f, 0.f, 0.f}; o[1] = o[0]; \
    if (full) { \
    _Pragma("unroll") \
      for (int n = 0; n < 2; n++) o[n] = mma_lds_<128>(lane, sQP + wid * 16 * 136, 136, sSt + n * 16 * 136, 136, o[n]); \
    } \
    if (GDN) { \
    _Pragma("unroll") \
      for (int n = 0; n < 2; n++) { \
        f32x4 a = mma_lds_<128>(lane, sW + wid * 16 * 136, 136, sSt + n * 16 * 136, 136, (f32x4){0.f, 0.f, 0.f, 0.f}); \
        uint2 ov; \
        ov.x = pack2(uu[n * 4 + 0] - a[0], uu[n * 4 + 1] - a[1]); \
        ov.y = pack2(uu[n * 4 + 2] - a[2], uu[n * 4 + 3] - a[3]); \
        *(uint2*)(sVt + (n * 16 + fr) * 72 + wid * 16 + fq * 4) = ov; \
      } \
      __syncthreads(); \
    } \
    if (full) { \
    _Pragma("unroll") \
      for (int n = 0; n < 2; n++) { \
        o[n] = mma_lds_<64>(lane, sQK + wid * 16 * 72, 72, sVt + n * 16 * 72, 72, o[n]); \
    _Pragma("unroll") \
        for (int e = 0; e < 4; e++) gO[(tok0 + wid * 16 + fq * 4 + e) * ZS + n * 16] = f2bf(o[n][e]); \
      } \
    } \
    if (GDN) { \
      const float gs_ = __int_as_float(__builtin_amdgcn_readfirstlane(__float_as_int(g_))); \
    _Pragma("unroll") \
      for (int i = 0; i < 2; i++) { S[i][0] *= gs_; S[i][1] *= gs_; } \
    } else { \
      S[0][0] *= dv0_; S[0][1] *= dv0_; S[1][0] *= dv1_; S[1][1] *= dv1_; \
      Dacc[0] *= dv0_; Dacc[1] *= dv1_; \
    } \
    _Pragma("unroll") \
    for (int i = 0; i < 2; i++) \
    _Pragma("unroll") \
      for (int n = 0; n < 2; n++) \
        S[i][n] = mma_lds_<64>(lane, sKT + (wid * 2 + i) * 16 * 72, 72, sVt + n * 16 * 72, 72, S[i][n]); \
  } while (0)
  __syncthreads();
  LOAD_REGS(0, c0);
  if (nchunk > 1) LOAD_REGS(1, c0 + 1);
  for (int ci = 0; ci < nchunk; ci += 2) {
    SCAN_STEP(0, ci);
    if (ci + 1 < nchunk) SCAN_STEP(1, ci + 1);
  }
  if (kind == 1) {
    if (GDN && sl >= 4) {
      u16* gp = (u16*)(p.ws + WS_GP) + (size_t)(seg * 4 + hd) * 16384;
#pragma unroll
      for (int i = 0; i < 2; i++)
#pragma unroll
        for (int n = 0; n < 2; n++)
#pragma unroll
          for (int e = 0; e < 4; e++) gp[((wid * 2 + i) * 16 + fq * 4 + e) * 128 + (sl - 4) * 32 + n * 16 + fr] = f2bf(S[i][n][e]);
    } else {
      float* dst = (float*)(p.ws + (GDN ? WS_GB : WS_HS)) + (size_t)(seg * 4 + hd) * 16384;
#pragma unroll
      for (int i = 0; i < 2; i++)
#pragma unroll
        for (int n = 0; n < 2; n++)
#pragma unroll
          for (int e = 0; e < 4; e++) dst[((wid * 2 + i) * 16 + fq * 4 + e) * 128 + dvc + n * 16] = S[i][n][e];
      if (!GDN && sl == 0 && fr == 0) {
        float* dd = (float*)(p.ws + WS_HD) + (size_t)(seg * 4 + hd) * 128;
#pragma unroll
        for (int i = 0; i < 2; i++) *(f32x4*)(dd + (wid * 2 + i) * 16 + fq * 4) = Dacc[i];
      }
    }
  } else if (kind == 0 || seg == 15) {
    float* dst;
    if (kind == 2) dst = p.out + (GDN ? O_PG : O_PH) + ((size_t)l * 4 + hd) * 16384;
    else dst = p.out + (GDN ? O_SG : O_SH) + ((size_t)(l * 32 + (seq - 1)) * 4 + hd) * 16384;
#pragma unroll
    for (int i = 0; i < 2; i++)
#pragma unroll
      for (int n = 0; n < 2; n++)
#pragma unroll
        for (int e = 0; e < 4; e++) dst[((wid * 2 + i) * 16 + fq * 4 + e) * 128 + dvc + n * 16] = S[i][n][e];
  }
  __syncthreads();
}

__device__ __forceinline__ void onorm_phase(const Params& p, int l) {
  u16* z = (u16*)(p.ws + WS_Z);
  u16* ru = (u16*)(p.ws + WS_RU);
  OPAQUE_TID(tid);
  const int lane = tid & 63, wid = tid >> 6;
  for (int row = blockIdx.x * 4 + wid; row < NTOK; row += gridDim.x * 4) {
    u16* zr = z + (size_t)row * ZS;
#pragma unroll
    for (int br = 0; br < 2; br++) {
      u16* po = zr + (br == 0 ? ZA_I : ZC_V) + lane * 8;
      const u16* pg = zr + (br == 0 ? ZA_G : ZC_G) + lane * 8;
      const float* nw = (br == 0 ? p.a_norm : p.c_norm) + l * 128 + (lane & 15) * 8;
      const uint4 vo = *(const uint4*)po, vg = *(const uint4*)pg;
      const unsigned uo[4] = {vo.x, vo.y, vo.z, vo.w}, ug[4] = {vg.x, vg.y, vg.z, vg.w};
      float o[8], g[8];
#pragma unroll
      for (int i = 0; i < 4; i++) {
        o[2 * i] = bf2f((u16)(uo[i] & 0xffff)); o[2 * i + 1] = bf2f((u16)(uo[i] >> 16));
        g[2 * i] = bf2f((u16)(ug[i] & 0xffff)); g[2 * i + 1] = bf2f((u16)(ug[i] >> 16));
      }
      float ss = 0.f;
#pragma unroll
      for (int i = 0; i < 8; i++) ss += o[i] * o[i];
      ss += __shfl_xor(ss, 1); ss += __shfl_xor(ss, 2); ss += __shfl_xor(ss, 4); ss += __shfl_xor(ss, 8);
      const float r = rsqrtf(ss * (1.f / 128.f) + EPS);
      unsigned res[4];
#pragma unroll
      for (int i = 0; i < 4; i++)
        res[i] = pack2(o[2 * i] * r * nw[2 * i] * silu(g[2 * i]), o[2 * i + 1] * r * nw[2 * i + 1] * silu(g[2 * i + 1]));
      *(uint4*)po = make_uint4(res[0], res[1], res[2], res[3]);
    }
    {
      u16* ph = ru + (size_t)row * 512 + lane * 8;
      const u16* pg = zr + ZB_G + lane * 8;
      const uint4 vo = *(const uint4*)ph, vg = *(const uint4*)pg;
      const unsigned uo[4] = {vo.x, vo.y, vo.z, vo.w}, ug[4] = {vg.x, vg.y, vg.z, vg.w};
      unsigned res[4];
#pragma unroll
      for (int i = 0; i < 4; i++) {
        const float h0 = bf2f((u16)(uo[i] & 0xffff)), h1 = bf2f((u16)(uo[i] >> 16));
        const float g0 = bf2f((u16)(ug[i] & 0xffff)), g1 = bf2f((u16)(ug[i] >> 16));
        res[i] = pack2(gelu_t(g0) * h0, gelu_t(g1) * h1);
      }
      *(uint4*)ph = make_uint4(res[0], res[1], res[2], res[3]);
    }
  }
}

__device__ __forceinline__ void prep_phase(u16* smem, const Params& p, int l, bool dup) {
  for (int t = blockIdx.x; t < 4608; t += gridDim.x) {
    if (t < 1152) gdn_prep(smem, p, l, t >> 2, t & 3);
    else if (t < 2304) { if (!dup) hgrn_prep(smem, p, l, (t - 1152) >> 2, (t - 1152) & 3); }
    else rglru_prep(smem, p, l, (t - 2304) >> 3, (t - 2304) & 7);
  }
}

__device__ __forceinline__ void scan_phase(u16* smem, const Params& p, int l, int pass) {
  const int ntask = pass ? 512 : (720 + 576 + 1024);
  for (int t = blockIdx.x; t < ntask; t += gridDim.x) {
    bool isg; int kind, seg = 0, seq = 0, hd, sl;
    if (pass) {
      kind = 2;
      if (t < 256) { isg = true; seg = 15 - (t >> 4); hd = (t >> 2) & 3; sl = t & 3; }
      else { const int u = t - 256; isg = false; seg = u >> 4; hd = (u >> 2) & 3; sl = u & 3; }
    } else {
      if (t >= 720 && t < 1296) { rglru_scan(p, l, (t - 720) >> 1, (t - 720) & 1); continue; }
      if (t < 480) { kind = 1; isg = true; seg = t >> 5; hd = (t >> 3) & 3; sl = t & 7; }
      else if (t < 720) { const int u = t - 480; kind = 1; isg = false; seg = u >> 4; hd = (u >> 2) & 3; sl = u & 3; }
      else if (t < 1296 + 512) { const int u = t - 1296; kind = 0; isg = true; seq = 1 + (u >> 4); hd = (u >> 2) & 3; sl = u & 3; }
      else { const int u = t - 1808; kind = 0; isg = false; seq = 1 + (u >> 4); hd = (u >> 2) & 3; sl = u & 3; }
    }
    if (isg) mat_scan<true>(smem, p, l, kind, seg, seq, hd, sl);
    else mat_scan<false>(smem, p, l, kind, seg, seq, hd, sl);
  }
}

__device__ __forceinline__ void run_phase(u16* smem, const Params& p, int l, int ph, bool dup = false) {
#ifdef ONLY_PH
  if (ph != ONLY_PH) return;
  ph = ONLY_PH;
#endif
  u16* Z = (u16*)(p.ws + WS_Z);
  u16* WB = (u16*)(p.ws + WS_WB);
  u16* H = (u16*)(p.ws + WS_H);
  u16* Y = (u16*)(p.ws + WS_Y);
  if (ph == 0 || ph == 7 || ph == 10) {
    const bool fi = (ph == 0);
    const u16* y = fi ? nullptr : Y;
    const float* postw = ((ph == 7) ? opq(p.n_post_mix) : opq(p.n_post_mlp)) + l * D;
    const float* npm = opq(p.n_pre_mix);
    const float* prew = (ph == 0) ? npm : (ph == 7) ? opq(p.n_pre_mlp) + l * D : ((l + 1 < DEPTH) ? npm + (l + 1) * D : nullptr);
    rowpass_phase(p, fi, y, postw, prew, H);
    const int wl = (ph == 0) ? 0 : l + 1;
    if (ph != 7 && wl < DEPTH) wconv_phase(smem, p, wl);
  } else if (ph == 1 || ph == 6 || ph == 8 || ph == 9) {
    const u16* A = (ph == 9) ? Z : H;
    const int lda = (ph == 9) ? 4096 : 1024;
    const u16* Bt = WB + ((ph == 1) ? WB_IN : (ph == 6) ? WB_OUT : (ph == 8) ? WB_UP : WB_DN);
    const int K = (ph == 9) ? 4096 : 1024;
    const int N = (ph == 1) ? ZS : (ph == 8) ? 4096 : 1024;
    u16* C = (ph == 1 || ph == 8) ? Z : Y;
    const int ldc = (ph == 1) ? ZS : (ph == 8) ? 4096 : 1024;
    gemm_big_phase(smem, A, lda, Bt, K, N, K, C, ldc, ph == 8 ? 1 : 0);
  } else if (ph == 2) prep_phase(smem, p, l, dup);
  else if (ph == 3 || ph == 11) scan_phase(smem, p, l, ph == 11 ? 1 : 0);
  else if (ph == 4) onorm_phase(p, l);
  else if (ph == 5) merge_big_phase(smem, p);
}

#if MULTI_LAUNCH
__global__ void __launch_bounds__(256, 2) phase_kernel(Params p, int l, int ph) {
  __shared__ __attribute__((aligned(16))) u16 smem[SMEM_BYTES / 2];
  run_phase(smem, p, l, ph);
}
#endif

#if !MULTI_LAUNCH
#define XB_TMO      128
#define XB_XCNT(j)  (256  + 64 * (j))
#define XB_XSUB(j)  (1280 + 64 * (j))
#define XB_XGEN(j)  (2304 + 64 * (j))
#define XB_TOP      3328
#define XB_TOPGEN   3392
#define XCD_BAR_WORDS 3456
#define XB_SPIN_CAP (1u << 18)
#define LAS __attribute__((address_space(3)))

__device__ __forceinline__ unsigned xb_ld(unsigned* p)              { return __hip_atomic_load(p, __ATOMIC_RELAXED, __HIP_MEMORY_SCOPE_AGENT); }
__device__ __forceinline__ unsigned xb_add(unsigned* p, unsigned v) { return __hip_atomic_fetch_add(p, v, __ATOMIC_RELAXED, __HIP_MEMORY_SCOPE_AGENT); }
__device__ __forceinline__ unsigned xb_xcc_id() { return (unsigned)__builtin_amdgcn_s_getreg((3 << 11) | 20) & 0xFu; }
#define XB_SPIN(cond, bar) do { unsigned _sp = 0; while (cond) { __builtin_amdgcn_s_sleep(1); \
    if ((++_sp & 255u) == 0u) { if (xb_ld(&(bar)[XB_TMO])) break; if (_sp > XB_SPIN_CAP) { atomicAdd(&(bar)[XB_TMO], 1u); break; } } } } while (0)

struct XcdBarrier {
    unsigned* bar; unsigned x;
    volatile LAS unsigned* st;
};

__device__ __forceinline__ XcdBarrier xcd_barrier_post(unsigned* bar, volatile LAS unsigned* st) {
    XcdBarrier b; b.bar = bar; b.x = xb_xcc_id(); b.st = st;
    if (threadIdx.x == 0) (void)xb_add(&bar[XB_XCNT(b.x)], 1u);
    return b;
}
__device__ __forceinline__ void xcd_barrier_complete(unsigned* bar, unsigned x, unsigned& nloc, unsigned& nx) {
    const unsigned G = gridDim.x * gridDim.y * gridDim.z;
    unsigned sum, cnt, mine, sp = 0u;
    for (;;) {
        sum = 0u; cnt = 0u; mine = 0u;
#pragma unroll
        for (unsigned j = 0; j < 16; ++j) { const unsigned c = xb_ld(&bar[XB_XCNT(j)]); sum += c; cnt += (c > 0u) ? 1u : 0u; mine = (j == x) ? c : mine; }
        if (sum == G) break;
        __builtin_amdgcn_s_sleep(1);
        if ((++sp & 255u) == 0u) { if (xb_ld(&bar[XB_TMO])) break; if (sp > XB_SPIN_CAP) { atomicAdd(&bar[XB_TMO], 1u); break; } }
    }
    nloc = mine > 0u ? mine : 1u; nx = cnt > 0u ? cnt : 1u;
}

__device__ __forceinline__ void xcd_barrier(const XcdBarrier& b) {
    asm volatile("s_waitcnt vmcnt(0)" ::: "memory");
    __syncthreads();
    if (threadIdx.x == 0) {
        unsigned* bar = b.bar;
        __builtin_amdgcn_s_waitcnt(0);
        unsigned nloc = b.st[0], nx = b.st[1];
        if (nloc == 0u) { xcd_barrier_complete(bar, b.x, nloc, nx); b.st[0] = nloc; b.st[1] = nx; }
        const unsigned old = xb_add(&bar[XB_XSUB(b.x)], 1u);
        const unsigned gen = old / nloc;
        if (old + 1u == (gen + 1u) * nloc) {
            __builtin_amdgcn_fence(__ATOMIC_RELEASE, "agent");
            asm volatile("s_waitcnt vmcnt(0)" ::: "memory");
            const unsigned og = xb_add(&bar[XB_TOP], 1u);
            const unsigned tg = og / nx;
            if (og + 1u == (tg + 1u) * nx) xb_add(&bar[XB_TOPGEN], 1u);
            else XB_SPIN(xb_ld(&bar[XB_TOPGEN]) == tg, bar);
            __builtin_amdgcn_fence(__ATOMIC_ACQUIRE, "agent");
            xb_add(&bar[XB_XGEN(b.x)], 1u);
            asm volatile("s_waitcnt vmcnt(0)" ::: "memory");
        } else {
            XB_SPIN(xb_ld(&bar[XB_XGEN(b.x)]) == gen, bar);
            __builtin_amdgcn_fence(__ATOMIC_ACQUIRE, "agent");
            asm volatile("s_waitcnt vmcnt(0)" ::: "memory");
        }
    }
    __syncthreads();
}


__global__ void __launch_bounds__(256, 2) mega_kernel(Params p) {
  __shared__ __attribute__((aligned(16))) u16 smem[SMEM_BYTES / 2 + 8];
  cg::grid_group grid = cg::this_grid();
  unsigned* xbw = (unsigned*)(smem + SMEM_BYTES / 2);
  if (threadIdx.x == 0) { xbw[0] = 0u; xbw[1] = 0u; xbw[2] = 0u; xbw[3] = 0u; }
  __syncthreads();
  XcdBarrier xb = xcd_barrier_post((unsigned*)(p.ws + WS_BAR), (volatile LAS unsigned*)xbw);
  if (p.ws == nullptr) grid.sync();
  for (int s = 0; s < 1 + DEPTH * 11; s++) {
    int l = 0, ph = 0;
    if (s > 0) {
      l = (s - 1) / 11;
      const int pi = (s - 1) % 11 + 1;
      ph = (pi <= 3) ? pi : (pi == 4) ? 11 : pi - 1;
    }
    run_phase(smem, p, l, ph);
    xcd_barrier(xb);
#ifdef DUP_MASK
    if (s > 0 && ((DUP_MASK >> ph) & 1)) { run_phase(smem, p, l, ph, true); xcd_barrier(xb); }
#endif
#ifdef EXTRA_SYNCS
    for (int i = 0; i < EXTRA_SYNCS; i++) xcd_barrier(xb);
#endif
  }
}
#endif

extern "C" void kernel_launch(void* const* d_in, const int* in_sizes, int n_in, void* d_out, int out_size, void* d_ws,
                              size_t ws_size, hipStream_t stream) {
  if (ws_size < WS_END) { fprintf(stderr, "workspace too small: %zu < %zu\n", ws_size, (size_t)WS_END); return; }
  Params p{};
  const float** pp = (const float**)&p;
  for (int i = 0; i < 31; i++) pp[i] = (const float*)d_in[i];
  p.out = (float*)d_out;
  p.ws = (char*)d_ws;
  static int grid_blocks = 0;
  if (!grid_blocks) {
    int dev = 0, cus = 0, per_cu = 0;
    hipGetDevice(&dev);
    hipDeviceGetAttribute(&cus, hipDeviceAttributeMultiprocessorCount, dev);
#if MULTI_LAUNCH
    hipOccupancyMaxActiveBlocksPerMultiprocessor(&per_cu, phase_kernel, 256, 0);
#else
    hipOccupancyMaxActiveBlocksPerMultiprocessor(&per_cu, mega_kernel, 256, 0);
#endif
    if (per_cu > 2) per_cu = 2;
    if (per_cu < 1) per_cu = 1;
    grid_blocks = cus * per_cu;
  }
#if MULTI_LAUNCH
  phase_kernel<<<grid_blocks, 256, 0, stream>>>(p, 0, 0);
  for (int l = 0; l < DEPTH; l++)
    for (int pi = 1; pi <= 11; pi++) phase_kernel<<<grid_blocks, 256, 0, stream>>>(p, l, (pi <= 3) ? pi : (pi == 4) ? 11 : pi - 1);
#else
  hipMemsetAsync((char*)d_ws + WS_BAR, 0, 16384, stream);
  void* args[] = {&p};
  hipError_t e = hipLaunchCooperativeKernel((void*)mega_kernel, dim3(grid_blocks), dim3(256), args, 0, stream);
  if (e != hipSuccess) fprintf(stderr, "cooperative launch failed: %s (grid %d)\n", hipGetErrorString(e), grid_blocks);
#endif
}
```

```cpp
#include <hip/hip_runtime.h>
#include <hip/hip_cooperative_groups.h>
#include <cstdio>
namespace cg = cooperative_groups;

#ifndef MULTI_LAUNCH
#define MULTI_LAUNCH 0
#endif

typedef unsigned short u16;
typedef __attribute__((ext_vector_type(8))) short bf16x8;
typedef __attribute__((ext_vector_type(4))) float f32x4;
typedef __attribute__((ext_vector_type(4))) unsigned int u32x4;

constexpr int D = 1024, NTOK = 18432, TP = 16384, NCHUNK = 288, DEPTH = 4, DFF = 4096;
constexpr int DIN = 8200, ZS = 8320;
constexpr int ZA_Q = 0, ZA_F = 512, ZA_I = 1024, ZA_G = 1536, ZB_X = 2048, ZB_G = 2560, ZC_Q = 3072, ZC_V = 4096,
              ZC_G = 4608, ZC_BETA = 5120, ZC_ALPHA = 5124, Z_MERGE = 5128;
constexpr float EPS = 1e-6f;

constexpr size_t O_YP = 0, O_YS = 16777216, O_PH = 18874368, O_PR = 19136512, O_PRC = 19138560, O_PG = 19144704,
                 O_PGC = 19406848, O_SH = 19425280, O_SR = 27813888, O_SRC = 27879424, O_SG = 28076032, O_SGC = 36464640;

constexpr size_t WS_Z = 0;
constexpr size_t WS_WB = WS_Z + (size_t)NTOK * ZS * 2;
constexpr size_t WB_IN = 0, WB_BR = (size_t)ZS * 1024, WB_OUT = WB_BR + 3 * 1024 * 512, WB_UP = WB_OUT + 1024 * 1024,
                 WB_DN = WB_UP + 4096 * 1024, WB_END = WB_DN + 4096 * 1024;
constexpr size_t WS_G = WS_WB + WB_END * 2;
constexpr size_t G_U = 0, G_W = (size_t)NTOK * 512, G_QP = 2 * G_W, G_KPT = 3 * G_W, G_QK = 4 * G_W, G_END = 4 * G_W + (size_t)NTOK * 256;
constexpr size_t WS_H = WS_G, WS_Y = WS_G + (size_t)NTOK * 1024 * 2;
constexpr size_t WS_HKPT = WS_G + G_END * 2;
constexpr size_t WS_HQK = WS_HKPT + (size_t)NTOK * 512 * 2;
constexpr size_t WS_HDA = WS_HQK + (size_t)NTOK * 256 * 2;
constexpr size_t WS_GGL = WS_HDA + (size_t)NCHUNK * 512 * 4;
constexpr size_t WS_RLA = WS_GGL + 8192;
constexpr size_t WS_RU = WS_RLA + (size_t)NTOK * 512 * 2;
constexpr size_t WS_RAGG = WS_RU + (size_t)NTOK * 512 * 2;
constexpr size_t WS_BAR = WS_RAGG + (size_t)NCHUNK * 512 * 8;
constexpr size_t WS_HS = WS_BAR + 16384;
constexpr size_t WS_HD = WS_HS + (size_t)15 * 4 * 16384 * 4;
constexpr size_t WS_GB = WS_HD + (size_t)15 * 4 * 128 * 4;
constexpr size_t WS_GP = WS_GB + (size_t)15 * 4 * 16384 * 4;
constexpr size_t WS_END = WS_GP + (size_t)15 * 4 * 16384 * 2;

struct Params {
  const float *x_prompt, *x_sample, *st_hgrn, *st_rglru, *st_rglru_conv, *st_gdn, *st_gdn_conv, *lb_raw, *n_pre_mix,
      *n_post_mix, *n_pre_mlp, *n_post_mlp, *w_in, *a_norm, *b_conv_w, *b_conv_b, *b_ga_w, *b_ga_b, *b_gx_w, *b_gx_b,
      *b_lambda, *c_conv_w, *c_a_log, *c_dt_bias, *c_norm, *w_br_a, *w_br_b, *w_br_c, *w_out, *w_up, *w_down;
  float* out;
  char* ws;
};

__device__ __forceinline__ u16 f2bf(float f) {
  unsigned u = __float_as_uint(f);
  u += 0x7fffu + ((u >> 16) & 1u);
  return (u16)(u >> 16);
}
__device__ __forceinline__ float bf2f(u16 h) { return __uint_as_float(((unsigned)h) << 16); }
__device__ __forceinline__ float sigm(float x) { return 1.f / (1.f + __expf(-x)); }
__device__ __forceinline__ float silu(float x) { return x * sigm(x); }
__device__ __forceinline__ float softplus(float x) { return fmaxf(x, 0.f) + __logf(1.f + __expf(-fabsf(x))); }
__device__ __forceinline__ float gelu_t(float x) {
  const float u = 1.5957691216f * (x + 0.044715f * x * x * x);
  return x * sigm(u);
}
__device__ __forceinline__ unsigned pack2(float a, float b) { return (unsigned)f2bf(a) | ((unsigned)f2bf(b) << 16); }

template <class T> __device__ __forceinline__ T* opq(T* x) { asm volatile("" : "+s"(x)); return x; }
#define OPAQUE_TID(t) int t = threadIdx.x; asm volatile("" : "+v"(t))

template <int K>
__device__ __forceinline__ f32x4 mma_lds_(int lane, const u16* a, int lda, const u16* b, int ldb, f32x4 acc) {
  const int r = lane & 15, q = lane >> 4;
  const u16* pa = a + r * lda + q * 8;
  const u16* pb = b + r * ldb + q * 8;
#pragma unroll
  for (int k = 0; k < K; k += 32) {
    bf16x8 af = *(const bf16x8*)(pa + k);
    bf16x8 bf = *(const bf16x8*)(pb + k);
    acc = __builtin_amdgcn_mfma_f32_16x16x32_bf16(af, bf, acc, 0, 0, 0);
  }
  return acc;
}

constexpr int BM = 128, BK = 64, LDT = 72;
constexpr int SMEM_BYTES = 75776;

template <int NJ>
__device__ __forceinline__ void gemm_tile(u16* smem, const u16* __restrict__ A, int lda, const u16* __restrict__ Bt,
                                          int ldb, int K, int m0, int n0, f32x4 (&acc)[4][NJ]) {
  OPAQUE_TID(tid);
  const int lane = tid & 63, wid = tid >> 6, wr = wid >> 1, wc = wid & 1, fr = lane & 15, fq = lane >> 4;
#pragma unroll
  for (int i = 0; i < 4; i++)
#pragma unroll
    for (int j = 0; j < NJ; j++) acc[i][j] = (f32x4){0.f, 0.f, 0.f, 0.f};
  const int lrow = tid >> 3, lc8 = (tid & 7) * 8;
  const u16* ga = A + (size_t)(m0 + lrow) * lda + lc8;
  const u16* gb = Bt + (size_t)(n0 + lrow) * ldb + lc8;
  u32x4 ra[4], rb[NJ];
#pragma unroll
  for (int i = 0; i < 4; i++) {
    ra[i] = *(const u32x4*)(ga + (size_t)i * 32 * lda);
    if (i < NJ) rb[i] = *(const u32x4*)(gb + (size_t)i * 32 * ldb);
  }
#pragma unroll
  for (int i = 0; i < 4; i++) {
    *(u32x4*)(smem + (lrow + i * 32) * LDT + lc8) = ra[i];
    if (i < NJ) *(u32x4*)(smem + BM * LDT + (lrow + i * 32) * LDT + lc8) = rb[i];
  }
  __syncthreads();
  const int nk = K / BK;
  for (int kt = 0; kt < nk; kt++) {
    const int cur = kt & 1;
    const bool more = (kt + 1 < nk);
    if (more) {
      ga += BK; gb += BK;
#pragma unroll
      for (int i = 0; i < 4; i++) {
        ra[i] = *(const u32x4*)(ga + (size_t)i * 32 * lda);
        if (i < NJ) rb[i] = *(const u32x4*)(gb + (size_t)i * 32 * ldb);
      }
    }
    const u16* a = smem + cur * 2 * BM * LDT + (wr * 64 + fr) * LDT + fq * 8;
    const u16* b = smem + cur * 2 * BM * LDT + BM * LDT + (wc * 16 * NJ + fr) * LDT + fq * 8;
#pragma unroll
    for (int ks = 0; ks < 2; ks++) {
      bf16x8 af[4], bf[NJ];
#pragma unroll
      for (int i = 0; i < 4; i++) {
        af[i] = *(const bf16x8*)(a + i * 16 * LDT + ks * 32);
        if (i < NJ) bf[i] = *(const bf16x8*)(b + i * 16 * LDT + ks * 32);
      }
#pragma unroll
      for (int i = 0; i < 4; i++)
#pragma unroll
        for (int j = 0; j < NJ; j++) acc[i][j] = __builtin_amdgcn_mfma_f32_16x16x32_bf16(af[i], bf[j], acc[i][j], 0, 0, 0);
    }
    if (more) {
      u16* sa = smem + (cur ^ 1) * 2 * BM * LDT;
#pragma unroll
      for (int i = 0; i < 4; i++) {
        *(u32x4*)(sa + (lrow + i * 32) * LDT + lc8) = ra[i];
        if (i < NJ) *(u32x4*)(sa + BM * LDT + (lrow + i * 32) * LDT + lc8) = rb[i];
      }
    }
    __syncthreads();
  }
}

__device__ __forceinline__ void tile_coords(int tile, int NT, int& mt, int& nt) {
  const int band = tile / (8 * NT), within = tile % (8 * NT);
  mt = band * 8 + (within & 7);
  nt = within >> 3;
}

__device__ __forceinline__ void gemm_phase(u16* smem, const u16* A, int lda, const u16* Bt, int ldb, int N, int K, u16* C, int ldc, int EPI) {
  const int NT = N / 128, MT = NTOK / 128;
  OPAQUE_TID(tid);
  const int lane = tid & 63, wid = tid >> 6, wr = wid >> 1, wc = wid & 1, fr = lane & 15, fq = lane >> 4;
  for (int tile = blockIdx.x; tile < MT * NT; tile += gridDim.x) {
    int mt, nt;
    tile_coords(tile, NT, mt, nt);
    f32x4 acc[4][4];
    gemm_tile<4>(smem, A, lda, Bt, ldb, K, mt * 128, nt * 128, acc);
#pragma unroll
    for (int i = 0; i < 4; i++)
#pragma unroll
      for (int j = 0; j < 4; j++)
#pragma unroll
        for (int e = 0; e < 4; e++) {
          const int row = mt * 128 + wr * 64 + i * 16 + fq * 4 + e, col = nt * 128 + wc * 64 + j * 16 + fr;
          float v = acc[i][j][e];
          if (EPI == 1) { v = fmaxf(v, 0.f); v = v * v; }
          C[(size_t)row * ldc + col] = f2bf(v);
        }
  }
}

__device__ __forceinline__ void glds16(const void* gsrc, unsigned lds_dst) {
  unsigned keep;
  asm volatile("s_mov_b32 %0, m0\n\ts_mov_b32 m0, %2\n\ts_nop 0\n\tglobal_load_lds_dwordx4 %1, off\n\ts_mov_b32 m0, %0"
               : "=&s"(keep) : "v"(gsrc), "s"(lds_dst) : "memory");
}

constexpr int BMB = 288, LDB_ = 40, STG = (BMB + 128) * LDB_;
constexpr int STGG = (BMB + 128) * 32;
__device__ __forceinline__ void gemm_big_phase(u16* smem, const u16* __restrict__ A, int lda, const u16* __restrict__ Bt, int ldb,
                                               int N, int K, u16* C, int ldc, int EPI) {
  const int NT = N / 128, MT = NTOK / BMB;
  OPAQUE_TID(tid);
  const int lane = tid & 63, wid = tid >> 6, wr = wid >> 1, wc = wid & 1, fr = lane & 15, fq = lane >> 4;
  const int nmc = (NT + 7) >> 3;
  const bool xcd_order = (gridDim.x == 512);
  const int nwork = xcd_order ? 8 * nmc * 64 : MT * NT;
  for (int w = blockIdx.x; w < nwork; w += gridDim.x) {
    int mt, nt;
    if (xcd_order) {
      const int q = (w >> 9) * 8 + (w & 7), slot = (w >> 3) & 63;
      mt = (q & 7) * 8 + (slot & 7); nt = (q >> 3) * 8 + (slot >> 3);
      if (nt >= NT) continue;
    } else {
      tile_coords(w, NT, mt, nt);
    }
    const int m0 = mt * BMB, n0 = nt * 128;
    f32x4 acc[9][4];
#pragma unroll
    for (int i = 0; i < 9; i++)
#pragma unroll
      for (int j = 0; j < 4; j++) acc[i][j] = (f32x4){0.f, 0.f, 0.f, 0.f};
    const int gl_row = lane >> 2, gl_c = (lane & 3) ^ ((lane >> 4) & 3);
    const unsigned oA = ((unsigned)(m0 + gl_row) * (unsigned)lda + gl_c * 8) * 2u;
    const unsigned oB = ((unsigned)(n0 + gl_row) * (unsigned)ldb + gl_c * 8) * 2u;
    const char* Ab = (const char*)A; const char* Bb = (const char*)Bt;
    const int pc = fq ^ (fr >> 2);
    const int nk = K / 32;
    const int uw = __builtin_amdgcn_readfirstlane(wid);
    const unsigned lds0 = (unsigned)__builtin_amdgcn_readfirstlane((int)(unsigned)(size_t)smem);
#define GG_STAGE(st_, kt_) do { \
      _Pragma("unroll") \
      for (int k_ = 0; k_ < 5; k_++) { \
        const int a_ = uw + 4 * k_; \
        if (a_ < 18) glds16(Ab + (oA + (unsigned)((16 * a_) * lda + (kt_) * 32) * 2u), lds0 + (unsigned)(((st_) * STGG + a_ * 512) * 2)); \
      } \
      _Pragma("unroll") \
      for (int k_ = 0; k_ < 2; k_++) { \
        const int b_ = uw + 4 * k_; \
        glds16(Bb + (oB + (unsigned)((16 * b_) * ldb + (kt_) * 32) * 2u), lds0 + (unsigned)(((st_) * STGG + 9216 + b_ * 512) * 2)); \
      } \
    } while (0)
    GG_STAGE(0, 0);
    asm volatile("s_waitcnt vmcnt(0)" ::: "memory");
    __syncthreads();
    for (int kt = 0; kt < nk; kt++) {
      const int cur = kt & 1;
      if (kt + 1 < nk) GG_STAGE(cur ^ 1, kt + 1);
      const u16* a = smem + cur * STGG + (wr * 144 + fr) * 32 + pc * 8;
      const u16* b = smem + cur * STGG + 9216 + (wc * 64 + fr) * 32 + pc * 8;
      bf16x8 bf[4], af[9];
#pragma unroll
      for (int j = 0; j < 4; j++) bf[j] = *(const bf16x8*)(b + j * 512);
#pragma unroll
      for (int i = 0; i < 9; i++) af[i] = *(const bf16x8*)(a + i * 512);
      __builtin_amdgcn_sched_barrier(0);
#pragma unroll
      for (int i = 0; i < 9; i++)
#pragma unroll
        for (int j = 0; j < 4; j++) acc[i][j] = __builtin_amdgcn_mfma_f32_16x16x32_bf16(af[i], bf[j], acc[i][j], 0, 0, 0);
      __builtin_amdgcn_sched_barrier(0);
      asm volatile("s_waitcnt vmcnt(0)" ::: "memory");
      __syncthreads();
    }
    {
      u16* scr = smem + STGG + wid * 16 * 72;
#pragma unroll
      for (int i = 0; i < 9; i++) {
#pragma unroll
        for (int j = 0; j < 4; j++)
#pragma unroll
          for (int e = 0; e < 4; e++) {
            float v = acc[i][j][e];
            if (EPI == 1) { v = fmaxf(v, 0.f); v = v * v; }
            scr[(fq * 4 + e) * 72 + j * 16 + fr] = f2bf(v);
          }
#pragma unroll
        for (int h = 0; h < 2; h++) {
          const int rr = h * 8 + (lane >> 3), cc = (lane & 7) * 8;
          const u32x4 v = *(const u32x4*)(scr + rr * 72 + cc);
          __builtin_nontemporal_store(v, (u32x4*)(C + (size_t)(m0 + wr * 144 + i * 16 + rr) * ldc + n0 + wc * 64 + cc));
        }
      }
    }
  }
}

__device__ __forceinline__ void merge_phase(u16* smem, const Params& p) {
  const u16* z = (const u16*)(p.ws + WS_Z);
  const u16* wb = (const u16*)(p.ws + WS_WB) + WB_BR;
  const u16* ru = (const u16*)(p.ws + WS_RU);
  u16* H = (u16*)(p.ws + WS_H);
  const int NT = 8, MT = NTOK / 128;
  OPAQUE_TID(tid);
  const int lane = tid & 63, wid = tid >> 6, wr = wid >> 1, wc = wid & 1, fr = lane & 15, fq = lane >> 4;
  const int lrow = tid >> 3, lc8 = (tid & 7) * 8;
  for (int tile = blockIdx.x; tile < MT * NT; tile += gridDim.x) {
    int mt, nt;
    tile_coords(tile, NT, mt, nt);
    const int m0 = mt * 128, n0 = nt * 128;
    f32x4 tot[4][4], acc[4][4];
#pragma unroll
    for (int i = 0; i < 4; i++)
#pragma unroll
      for (int j = 0; j < 4; j++) { tot[i][j] = (f32x4){0.f, 0.f, 0.f, 0.f}; acc[i][j] = tot[i][j]; }
    u32x4 ra[4], rb[4];
    unsigned gv[4][4][2];
#define MG_LOAD(it_) do { \
      const int sg_ = (it_) >> 3, kk_ = (it_) & 7; \
      const u16* A_ = (sg_ == 0) ? z + ZA_I : (sg_ == 1) ? ru : z + ZC_V; \
      const int lda_ = (sg_ == 1) ? 512 : ZS; \
      const u16* ga_ = A_ + (size_t)(m0 + lrow) * lda_ + kk_ * 64 + lc8; \
      const u16* gb_ = wb + (size_t)sg_ * 1024 * 512 + (size_t)(n0 + lrow) * 512 + kk_ * 64 + lc8; \
      _Pragma("unroll") \
      for (int i = 0; i < 4; i++) ra[i] = *(const u32x4*)(ga_ + (size_t)i * 32 * lda_); \
      _Pragma("unroll") \
      for (int i = 0; i < 4; i++) rb[i] = *(const u32x4*)(gb_ + (size_t)i * 32 * 512); \
    } while (0)
#define MG_STORE(st_) do { \
      u16* sa_ = smem + (st_) * 2 * BM * LDT; \
      _Pragma("unroll") \
      for (int i = 0; i < 4; i++) *(u32x4*)(sa_ + (lrow + i * 32) * LDT + lc8) = ra[i]; \
      _Pragma("unroll") \
      for (int i = 0; i < 4; i++) *(u32x4*)(sa_ + BM * LDT + (lrow + i * 32) * LDT + lc8) = rb[i]; \
    } while (0)
    MG_LOAD(0);
    MG_STORE(0);
    __syncthreads();
    for (int it = 0; it < 24; it++) {
      const int cur = it & 1, sg = it >> 3, kk = it & 7;
      if (kk == 0) {
#pragma unroll
        for (int i = 0; i < 4; i++)
#pragma unroll
          for (int j = 0; j < 4; j++) {
            const u16* gp = z + (size_t)(m0 + wr * 64 + i * 16 + fq * 4) * ZS + Z_MERGE + sg * 1024 + n0 + wc * 64 + j * 16 + fr;
            gv[i][j][0] = (unsigned)gp[0] | ((unsigned)gp[ZS] << 16);
            gv[i][j][1] = (unsigned)gp[2 * ZS] | ((unsigned)gp[3 * ZS] << 16);
          }
      }
      if (it + 1 < 24) MG_LOAD(it + 1);
      const u16* a = smem + cur * 2 * BM * LDT + (wr * 64 + fr) * LDT + fq * 8;
      const u16* b = smem + cur * 2 * BM * LDT + BM * LDT + (wc * 64 + fr) * LDT + fq * 8;
#pragma unroll
      for (int ks = 0; ks < 2; ks++) {
        bf16x8 af[4], bf[4];
#pragma unroll
        for (int i = 0; i < 4; i++) af[i] = *(const bf16x8*)(a + i * 16 * LDT + ks * 32);
#pragma unroll
        for (int j = 0; j < 4; j++) bf[j] = *(const bf16x8*)(b + j * 16 * LDT + ks * 32);
#pragma unroll
        for (int i = 0; i < 4; i++)
#pragma unroll
          for (int j = 0; j < 4; j++) acc[i][j] = __builtin_amdgcn_mfma_f32_16x16x32_bf16(af[i], bf[j], acc[i][j], 0, 0, 0);
      }
      if (it + 1 < 24) MG_STORE(cur ^ 1);
      if (kk == 7) {
#pragma unroll
        for (int i = 0; i < 4; i++)
#pragma unroll
          for (int j = 0; j < 4; j++) {
            tot[i][j][0] += sigm(bf2f((u16)(gv[i][j][0] & 0xffff))) * acc[i][j][0];
            tot[i][j][1] += sigm(bf2f((u16)(gv[i][j][0] >> 16))) * acc[i][j][1];
            tot[i][j][2] += sigm(bf2f((u16)(gv[i][j][1] & 0xffff))) * acc[i][j][2];
            tot[i][j][3] += sigm(bf2f((u16)(gv[i][j][1] >> 16))) * acc[i][j][3];
            acc[i][j] = (f32x4){0.f, 0.f, 0.f, 0.f};
          }
      }
      __syncthreads();
    }
#pragma unroll
    for (int i = 0; i < 4; i++)
#pragma unroll
      for (int j = 0; j < 4; j++)
#pragma unroll
        for (int e = 0; e < 4; e++) {
          const int row = m0 + wr * 64 + i * 16 + fq * 4 + e, col = n0 + wc * 64 + j * 16 + fr;
          H[(size_t)row * 1024 + col] = f2bf(tot[i][j][e]);
        }
  }
}

__device__ __forceinline__ void merge_big_phase(u16* smem, const Params& p) {
  const u16* z = (const u16*)(p.ws + WS_Z);
  const u16* wb = (const u16*)(p.ws + WS_WB) + WB_BR;
  const u16* ru = (const u16*)(p.ws + WS_RU);
  u16* H = (u16*)(p.ws + WS_H);
  const int NT = 8, MT = NTOK / BMB;
  OPAQUE_TID(tid);
  const int lane = tid & 63, wid = tid >> 6, wr = wid >> 1, wc = wid & 1, fr = lane & 15, fq = lane >> 4;
  for (int tile = blockIdx.x; tile < MT * NT; tile += gridDim.x) {
    int mt, nt;
    tile_coords(tile, NT, mt, nt);
    const int m0 = mt * BMB, n0 = nt * 128;
    f32x4 acc[9][4];
#pragma unroll
    for (int i = 0; i < 9; i++)
#pragma unroll
      for (int j = 0; j < 4; j++) acc[i][j] = (f32x4){0.f, 0.f, 0.f, 0.f};
    const int gl_row = lane >> 2, gl_c = (lane & 3) ^ ((lane >> 4) & 3);
    const int pc = fq ^ (fr >> 2);
    const int uw = __builtin_amdgcn_readfirstlane(wid);
    const unsigned lds0 = (unsigned)__builtin_amdgcn_readfirstlane((int)(unsigned)(size_t)smem);
#define MB_STAGE(st_, it_) do { \
      const int sg_ = (it_) >> 4, kk_ = (it_) & 15; \
      const char* A_ = (const char*)((sg_ == 0) ? z + ZA_I : (sg_ == 1) ? ru : z + ZC_V); \
      const int lda_ = (sg_ == 1) ? 512 : ZS; \
      const char* B_ = (const char*)(wb + (size_t)sg_ * 1024 * 512); \
      const unsigned oA_ = ((unsigned)(m0 + gl_row) * (unsigned)lda_ + gl_c * 8 + kk_ * 32) * 2u; \
      const unsigned oB_ = ((unsigned)(n0 + gl_row) * 512u + gl_c * 8 + kk_ * 32) * 2u; \
      _Pragma("unroll") \
      for (int k_ = 0; k_ < 5; k_++) { \
        const int a_ = uw + 4 * k_; \
        if (a_ < 18) glds16(A_ + (oA_ + (unsigned)(16 * a_ * lda_) * 2u), lds0 + (unsigned)(((st_) * STGG + a_ * 512) * 2)); \
      } \
      _Pragma("unroll") \
      for (int k_ = 0; k_ < 2; k_++) { \
        const int b_ = uw + 4 * k_; \
        glds16(B_ + (oB_ + (unsigned)(16 * b_ * 512) * 2u), lds0 + (unsigned)(((st_) * STGG + 9216 + b_ * 512) * 2)); \
      } \
    } while (0)
#define MB_GSTRIP_LOAD(G_, i_) do { \
        int t_ = tid; asm volatile("" : "+v"(t_)); \
        const int ln_ = t_ & 63, wd_ = t_ >> 6; \
        _Pragma("unroll") \
        for (int h = 0; h < 2; h++) { \
          const int rr = h * 8 + (ln_ >> 3), cc = (ln_ & 7) * 8; \
          nv[h] = *(const u32x4*)(z + (size_t)(m0 + (wd_ >> 1) * 144 + (i_) * 16 + rr) * ZS + Z_MERGE + (G_) * 1024 + n0 + (wd_ & 1) * 64 + cc); \
        } \
      } while (0)
#define MB_GATE(G_, INV) do { \
      u32x4 nv[2]; \
      MB_GSTRIP_LOAD(G_, 0); \
      _Pragma("unroll") \
      for (int i = 0; i < 9; i++) { \
        int t_ = tid; asm volatile("" : "+v"(t_));     \
        const int ln_ = t_ & 63, wd_ = t_ >> 6, fr_ = ln_ & 15, fq_ = ln_ >> 4; \
        u16* scr_ = smem + 2 * STGG + wd_ * 16 * 72; \
        _Pragma("unroll") \
        for (int h = 0; h < 2; h++) { \
          const int rr = h * 8 + (ln_ >> 3), cc = (ln_ & 7) * 8; \
          *(u32x4*)(scr_ + rr * 72 + cc) = nv[h]; \
        } \
        if (i + 1 < 9) MB_GSTRIP_LOAD(G_, i + 1);     \
        _Pragma("unroll") \
        for (int j = 0; j < 4; j++) \
        _Pragma("unroll") \
          for (int e = 0; e < 4; e++) { \
            const float x_ = 1.f + __expf(-bf2f(scr_[(fq_ * 4 + e) * 72 + j * 16 + fr_])); \
            acc[i][j][e] *= (INV) ? x_ : __frcp_rn(x_); \
          } \
      } \
    } while (0)
    MB_STAGE(0, 0);
    asm volatile("s_waitcnt vmcnt(0)" ::: "memory");
    __syncthreads();
#pragma unroll 1
    for (int it = 0; it < 48; it++) {
      const int cur = it & 1;
      if (it + 1 < 48) MB_STAGE(cur ^ 1, it + 1);
      const u16* a = smem + cur * STGG + (wr * 144 + fr) * 32 + pc * 8;
      const u16* b = smem + cur * STGG + 9216 + (wc * 64 + fr) * 32 + pc * 8;
      bf16x8 bf[4], af[9];
#pragma unroll
      for (int j = 0; j < 4; j++) bf[j] = *(const bf16x8*)(b + j * 512);
#pragma unroll
      for (int i = 0; i < 9; i++) af[i] = *(const bf16x8*)(a + i * 512);
      __builtin_amdgcn_sched_barrier(0);
#pragma unroll
      for (int i = 0; i < 9; i++)
#pragma unroll
        for (int j = 0; j < 4; j++) acc[i][j] = __builtin_amdgcn_mfma_f32_16x16x32_bf16(af[i], bf[j], acc[i][j], 0, 0, 0);
      __builtin_amdgcn_sched_barrier(0);
      if ((it & 15) == 15) {
        const int sg = it >> 4, napply = (sg < 2) ? 2 : 1;
#pragma unroll 1
        for (int q = 0; q < napply; q++) { MB_GATE(sg + q, q); }
      }
      asm volatile("s_waitcnt vmcnt(0)" ::: "memory");
      __syncthreads();
    }
    {
#pragma unroll
      for (int i = 0; i < 9; i++) {
        int t_ = tid; asm volatile("" : "+v"(t_));
        const int ln_ = t_ & 63, wd_ = t_ >> 6, fr_ = ln_ & 15, fq_ = ln_ >> 4;
        u16* scr_ = smem + 2 * STGG + wd_ * 16 * 72;
#pragma unroll
        for (int j = 0; j < 4; j++)
#pragma unroll
          for (int e = 0; e < 4; e++) scr_[(fq_ * 4 + e) * 72 + j * 16 + fr_] = f2bf(acc[i][j][e]);
#pragma unroll
        for (int h = 0; h < 2; h++) {
          const int rr = h * 8 + (ln_ >> 3), cc = (ln_ & 7) * 8;
          const u32x4 v = *(const u32x4*)(scr_ + rr * 72 + cc);
          *(u32x4*)(H + (size_t)(m0 + (wd_ >> 1) * 144 + i * 16 + rr) * 1024 + n0 + (wd_ & 1) * 64 + cc) = v;
        }
      }
    }
  }
}

__device__ __forceinline__ void conv_w_tile(float* sm, const float* __restrict__ W, int K, int N, u16* Wt, int kt, int nt) {
  OPAQUE_TID(tid);
  const int lane = tid & 63, wid = tid >> 6;
  const int n = nt * 64 + lane;
#pragma unroll
  for (int i = 0; i < 16; i++) {
    const int k = wid * 16 + i;
    sm[lane * 65 + k] = (n < N) ? W[(size_t)(kt * 64 + k) * N + n] : 0.f;
  }
  __syncthreads();
  const int nn = tid >> 2, ks = (tid & 3) * 16;
  const float* s = sm + nn * 65 + ks;
  uint4 o0, o1;
  o0.x = pack2(s[0], s[1]); o0.y = pack2(s[2], s[3]); o0.z = pack2(s[4], s[5]); o0.w = pack2(s[6], s[7]);
  o1.x = pack2(s[8], s[9]); o1.y = pack2(s[10], s[11]); o1.z = pack2(s[12], s[13]); o1.w = pack2(s[14], s[15]);
  u16* dst = Wt + (size_t)(nt * 64 + nn) * K + kt * 64 + ks;
  *(uint4*)dst = o0;
  *(uint4*)(dst + 8) = o1;
  __syncthreads();
}

__device__ __forceinline__ void wconv_phase(u16* smem, const Params& p, int l) {
  float* sm = (float*)smem;
  u16* wb = (u16*)(p.ws + WS_WB);
  const int total = 2080 + 384 + 256 + 1024 + 1024;
  for (int t = blockIdx.x; t < total; t += gridDim.x) {
    const float* src; u16* dst; int K, N, kt, nt;
    if (t < 2080) {
      src = opq(p.w_in) + (size_t)l * 1024 * DIN; K = 1024; N = DIN; dst = wb + WB_IN; kt = t / 130; nt = t % 130;
    } else if (t < 2080 + 384) {
      const int u = t - 2080, br = u / 128, v = u % 128;
      src = (br == 0 ? opq(p.w_br_a) : br == 1 ? opq(p.w_br_b) : opq(p.w_br_c)) + (size_t)l * 512 * 1024;
      K = 512; N = 1024; dst = wb + WB_BR + (size_t)br * 1024 * 512; kt = v / 16; nt = v % 16;
    } else if (t < 2080 + 384 + 256) {
      const int u = t - 2464;
      src = opq(p.w_out) + (size_t)l * 1024 * 1024; K = 1024; N = 1024; dst = wb + WB_OUT; kt = u / 16; nt = u % 16;
    } else if (t < 2080 + 384 + 256 + 1024) {
      const int u = t - 2720;
      src = opq(p.w_up) + (size_t)l * 1024 * 4096; K = 1024; N = 4096; dst = wb + WB_UP; kt = u / 64; nt = u % 64;
    } else {
      const int u = t - 3744;
      src = opq(p.w_down) + (size_t)l * 4096 * 1024; K = 4096; N = 1024; dst = wb + WB_DN; kt = u / 16; nt = u % 16;
    }
    conv_w_tile(sm, src, K, N, dst, kt, nt);
  }
}

__device__ __forceinline__ float wave_sum(float v) {
#pragma unroll
  for (int o = 32; o >= 1; o >>= 1) v += __shfl_xor(v, o);
  return v;
}

__device__ __forceinline__ void rowpass_phase(const Params& p, bool from_input, const u16* Y, const float* postw, const float* prew, u16* H) {
  OPAQUE_TID(tid);
  const int lane = tid & 63, wid = tid >> 6;
  const float* xpr = opq(p.x_prompt); const float* xsa = opq(p.x_sample); const float* xo = opq((const float*)p.out);
  const int stride = gridDim.x * 4;
  for (int row0 = blockIdx.x * 4 + wid; row0 < NTOK; row0 += 3 * stride) {
    float xv[3][16], yv[3][16];
#pragma unroll
    for (int k = 0; k < 3; k++) {
      const int row = min(row0 + k * stride, NTOK - 1);
      const float* xin = from_input ? (row < TP ? xpr + (size_t)row * D : xsa + (size_t)(row - TP) * D) : xo + (size_t)row * D;
#pragma unroll
      for (int i = 0; i < 4; i++) {
        const float4 v = *(const float4*)(xin + lane * 4 + i * 256);
        xv[k][i * 4] = v.x; xv[k][i * 4 + 1] = v.y; xv[k][i * 4 + 2] = v.z; xv[k][i * 4 + 3] = v.w;
      }
      if (Y) {
#pragma unroll
        for (int i = 0; i < 4; i++) {
          const uint2 v = *(const uint2*)(Y + (size_t)row * D + lane * 4 + i * 256);
          yv[k][i * 4] = bf2f((u16)(v.x & 0xffff)); yv[k][i * 4 + 1] = bf2f((u16)(v.x >> 16));
          yv[k][i * 4 + 2] = bf2f((u16)(v.y & 0xffff)); yv[k][i * 4 + 3] = bf2f((u16)(v.y >> 16));
        }
      }
    }
#pragma unroll
    for (int k = 0; k < 3; k++) {
      const int row = row0 + k * stride;
      if (row < NTOK) {
        if (Y) {
          float ss = 0.f;
#pragma unroll
          for (int i = 0; i < 16; i++) ss += yv[k][i] * yv[k][i];
          ss = wave_sum(ss);
          const float r = rsqrtf(ss * (1.f / D) + EPS);
#pragma unroll
          for (int i = 0; i < 4; i++) {
            const float4 w = *(const float4*)(postw + lane * 4 + i * 256);
            xv[k][i * 4] += yv[k][i * 4] * r * w.x; xv[k][i * 4 + 1] += yv[k][i * 4 + 1] * r * w.y;
            xv[k][i * 4 + 2] += yv[k][i * 4 + 2] * r * w.z; xv[k][i * 4 + 3] += yv[k][i * 4 + 3] * r * w.w;
          }
        }
        if (Y || from_input) {
#pragma unroll
          for (int i = 0; i < 4; i++)
            *(float4*)(p.out + (size_t)row * D + lane * 4 + i * 256) =
                make_float4(xv[k][i * 4], xv[k][i * 4 + 1], xv[k][i * 4 + 2], xv[k][i * 4 + 3]);
        }
        if (prew) {
          float ss = 0.f;
#pragma unroll
          for (int i = 0; i < 16; i++) ss += xv[k][i] * xv[k][i];
          ss = wave_sum(ss);
          const float r = rsqrtf(ss * (1.f / D) + EPS);
#pragma unroll
          for (int i = 0; i < 4; i++) {
            const float4 w = *(const float4*)(prew + lane * 4 + i * 256);
            uint2 o;
            o.x = pack2(xv[k][i * 4] * r * w.x, xv[k][i * 4 + 1] * r * w.y);
            o.y = pack2(xv[k][i * 4 + 2] * r * w.z, xv[k][i * 4 + 3] * r * w.w);
            *(uint2*)(H + (size_t)row * D + lane * 4 + i * 256) = o;
          }
        }
      }
    }
  }
}

__device__ __forceinline__ void hgrn_prep(u16* smem, const Params& p, int l, int c, int hd) {
  u16* z = (u16*)(p.ws + WS_Z);
  u16* sq = smem;
  u16* skt = smem + 64 * 136;
  u16* skh = smem + 2 * 64 * 136;
  float* sd = (float*)(smem + 3 * 64 * 136);
  OPAQUE_TID(tid);
  const int lane = tid & 63, wid = tid >> 6, fr = lane & 15, fq = lane >> 4;
  const int tok0 = c * 64;
  {
    const int hb = tid >> 7, ch = tid & 127, col = hd * 128 + ch;
    float lbv = 0.f;
    if (l > 0) {
      const float r0 = p.lb_raw[col], r1 = p.lb_raw[512 + col], r2 = p.lb_raw[1024 + col], r3 = p.lb_raw[1536 + col];
      const float m = fmaxf(fmaxf(r0, r1), fmaxf(r2, r3));
      const float e0 = __expf(r0 - m), e1 = __expf(r1 - m), e2 = __expf(r2 - m), e3 = __expf(r3 - m);
      const float inv = 1.f / (e0 + e1 + e2 + e3);
      lbv = e1 * inv;
      if (l > 1) lbv += e2 * inv;
      if (l > 2) lbv += e3 * inv;
    }
    {
      u32x4 rq[4], rf[4];
#pragma unroll
      for (int i = 0; i < 4; i++) {
        const int idx = tid + i * 256, row = idx >> 4, c8 = (idx & 15) * 8;
        rq[i] = *(const u32x4*)(z + (size_t)(tok0 + row) * ZS + ZA_Q + hd * 128 + c8);
        rf[i] = *(const u32x4*)(z + (size_t)(tok0 + row) * ZS + ZA_F + hd * 128 + c8);
      }
#pragma unroll
      for (int i = 0; i < 4; i++) {
        const int idx = tid + i * 256, row = idx >> 4, c8 = (idx & 15) * 8;
        *(u32x4*)(sq + row * 136 + c8) = rq[i];
        *(u32x4*)(skt + row * 136 + c8) = rf[i];
      }
    }
    __syncthreads();
    float bb[32];
    float run = 0.f;
#pragma unroll
    for (int t = 0; t < 32; t++) {
      const float zf = bf2f(skt[(hb * 32 + t) * 136 + ch]);
      const float f = lbv + (1.f - lbv) * sigm(zf);
      const float logf = (lbv > 0.f) ? __logf(f) : (fminf(zf, 0.f) - __logf(1.f + __expf(-fabsf(zf))));
      run += logf;
      bb[t] = run;
    }
    const float blast = run;
#pragma unroll
    for (int t = 0; t < 32; t++) {
      const int o = (hb * 32 + t) * 136 + ch;
      const float zq = bf2f(sq[o]), zf = bf2f(skt[o]);
      const float qv = silu(zq), kv = (1.f - lbv) * sigm(-zf);
      sq[o] = f2bf(qv * __expf(bb[t]));
      skt[o] = f2bf(kv * __expf(fminf(-bb[t], 80.f)));
      skh[o] = f2bf(kv * __expf(blast - bb[t]));
    }
    sd[hb * 128 + ch] = __expf(blast);
  }
  __syncthreads();
  {
    u16* qk = (u16*)(p.ws + WS_HQK);
    const int ti = wid;
    for (int si = 0; si < 4; si++) {
      f32x4 acc = (f32x4){0.f, 0.f, 0.f, 0.f};
      const bool upper = (ti < 2 && si >= 2);
      const bool cross = (ti >= 2 && si < 2);
      if (!upper && !((ti >> 1) == (si >> 1) && si > ti))
        acc = mma_lds_<128>(lane, sq + ti * 16 * 136, 136, (cross ? skh : skt) + si * 16 * 136, 136, acc);
#pragma unroll
      for (int e = 0; e < 4; e++) {
        const int t = ti * 16 + fq * 4 + e, s = si * 16 + fr;
        float v = acc[e];
        if (!cross && s > t) v = 0.f;
        qk[(size_t)(tok0 + t) * 256 + hd * 64 + s] = f2bf(v);
      }
    }
  }
  {
#pragma unroll 4
    for (int i = 0; i < 32; i++) {
      const int e = tid + i * 256, t = e >> 7, ch = e & 127;
      float v = bf2f(sq[t * 136 + ch]);
      if (t >= 32) v *= sd[ch];
      z[(size_t)(tok0 + t) * ZS + ZA_Q + hd * 128 + ch] = f2bf(v);
    }
    u16* kpt = (u16*)(p.ws + WS_HKPT) + (size_t)(c * 4 + hd) * 128 * 64;
#pragma unroll 4
    for (int i = 0; i < 32; i++) {
      const int e = tid + i * 256, dk = e >> 6, t = e & 63;
      float v = bf2f(skh[t * 136 + dk]);
      if (t < 32) v *= sd[128 + dk];
      kpt[dk * 64 + t] = f2bf(v);
    }
    if (tid < 128) ((float*)(p.ws + WS_HDA))[c * 512 + hd * 128 + tid] = sd[tid] * sd[128 + tid];
  }
  __syncthreads();
}

__device__ __forceinline__ void gdn_prep(u16* smem, const Params& p, int l, int c, int hd) {
  const u16* z = (const u16*)(p.ws + WS_Z);
  u16* sq = smem;
  u16* sk = smem + 64 * 136;
  u16* sv = smem + 2 * 64 * 136;
  float* sAm = (float*)(smem + 3 * 64 * 136);
  float* sgc = sAm + 64 * 68;
  float* sbeta = sgc + 64;
  OPAQUE_TID(tid);
  const int lane = tid & 63, wid = tid >> 6, fr = lane & 15, fq = lane >> 4;
  const int tok0 = c * 64;
  const bool first = (c == 0) || (c >= 256);
  const int sb = c - 256;
  u16* sraw = (u16*)sAm;
  u32x4 rraw[3][5];
#pragma unroll
  for (int part = 0; part < 3; part++)
#pragma unroll
    for (int i = 0; i < 5; i++) {
      const int idx = tid + i * 256, row = idx >> 4, c8 = (idx & 15) * 8, rr = row - 3;
      const int colq = part * 512 + hd * 128 + c8;
      u32x4 v = (u32x4){0u, 0u, 0u, 0u};
      if (idx < 67 * 16) {
        if (rr >= 0 || !first) {
          v = *(const u32x4*)(z + (size_t)(tok0 + rr) * ZS + ZC_Q + colq);
        } else if (c >= 256) {
          const float* st = p.st_gdn_conv + ((size_t)(l * 32 + sb) * 3 + row) * 1536 + colq;
          const float4 f0 = *(const float4*)st, f1 = *(const float4*)(st + 4);
          v = (u32x4){pack2(f0.x, f0.y), pack2(f0.z, f0.w), pack2(f1.x, f1.y), pack2(f1.z, f1.w)};
        }
      }
      rraw[part][i] = v;
    }
#pragma unroll
  for (int part = 0; part < 3; part++) {
    if (part > 0) __syncthreads();
#pragma unroll
    for (int i = 0; i < 5; i++) {
      const int idx = tid + i * 256, row = idx >> 4, c8 = (idx & 15) * 8;
      if (idx < 67 * 16) *(u32x4*)(sraw + row * 136 + c8) = rraw[part][i];
    }
    __syncthreads();
    {
      const int cc = tid & 127, half = tid >> 7, colq = part * 512 + hd * 128 + cc;
      const float* cw = p.c_conv_w + (size_t)l * 4 * 1536 + colq;
      const float w0 = cw[0], w1 = cw[1536], w2 = cw[2 * 1536], w3 = cw[3 * 1536];
      const u16* src = sraw + (half * 32) * 136 + cc;
      u16* dst = smem + part * 64 * 136 + (half * 32) * 136 + cc;
      float x0 = bf2f(src[0]), x1 = bf2f(src[136]), x2 = bf2f(src[2 * 136]);
#pragma unroll 8
      for (int t = 0; t < 32; t++) {
        const float x3 = bf2f(src[(t + 3) * 136]);
        const float y = w0 * x0 + w1 * x1 + w2 * x2 + w3 * x3;
        dst[t * 136] = f2bf(silu(y));
        x0 = x1; x1 = x2; x2 = x3;
      }
      if ((c == 255 || c >= 256) && half == 0) {
        float* dsto = (c == 255) ? p.out + O_PGC + (size_t)l * 3 * 1536 : p.out + O_SGC + (size_t)(l * 32 + sb) * 3 * 1536;
#pragma unroll
        for (int j = 0; j < 3; j++) dsto[j * 1536 + colq] = bf2f(sraw[(64 + j) * 136 + cc]);
      }
    }
  }
  __syncthreads();
  {
    const int t = tid >> 2, qd = tid & 3;
#pragma unroll
    for (int part = 0; part < 2; part++) {
      u16* r = smem + part * 64 * 136 + t * 136 + qd * 32;
      float ss = 0.f;
#pragma unroll
      for (int i = 0; i < 32; i++) { const float v = bf2f(r[i]); ss += v * v; }
      ss += __shfl_xor(ss, 1);
      ss += __shfl_xor(ss, 2);
      const float sc = rsqrtf(ss + EPS) * (part == 0 ? 0.08838834764831845f : 1.f);
#pragma unroll
      for (int i = 0; i < 32; i++) r[i] = f2bf(bf2f(r[i]) * sc);
    }
  }
  if (tid < 64) {
    const float beta = sigm(bf2f(z[(size_t)(tok0 + tid) * ZS + ZC_BETA + hd]));
    const float al = bf2f(z[(size_t)(tok0 + tid) * ZS + ZC_ALPHA + hd]);
    float g = -__expf(p.c_a_log[l * 4 + hd]) * softplus(al + p.c_dt_bias[l * 4 + hd]);
#pragma unroll
    for (int o = 1; o < 64; o <<= 1) {
      const float v = __shfl_up(g, o);
      if (lane >= o) g += v;
    }
    sgc[tid] = g;
    sbeta[tid] = beta;
  }
  __syncthreads();
  {
    u16* gqk = (u16*)(p.ws + WS_G) + G_QK;
    const int ti = wid;
    for (int si = 0; si < 4; si++) {
      f32x4 a1 = (f32x4){0.f, 0.f, 0.f, 0.f}, a2 = (f32x4){0.f, 0.f, 0.f, 0.f};
      if (si <= ti) {
        a1 = mma_lds_<128>(lane, sk + ti * 16 * 136, 136, sk + si * 16 * 136, 136, a1);
        a2 = mma_lds_<128>(lane, sq + ti * 16 * 136, 136, sk + si * 16 * 136, 136, a2);
      }
#pragma unroll
      for (int e = 0; e < 4; e++) {
        const int t = ti * 16 + fq * 4 + e, s = si * 16 + fr;
        const float dec = (s <= t) ? __expf(sgc[t] - sgc[s]) : 0.f;
        sAm[s * 68 + t] = (s < t) ? sbeta[t] * a1[e] * dec : 0.f;
        gqk[(size_t)(tok0 + t) * 256 + hd * 64 + s] = f2bf((s <= t) ? a2[e] * dec : 0.f);
      }
    }
  }
  __syncthreads();
  {
    const int col = tid & 127, isw = tid >> 7;
    const u16* src = isw ? sk : sv;
    u16* dst = (u16*)(p.ws + WS_G) + (isw ? G_W : G_U) + (size_t)tok0 * 512 + hd * 128 + col;
    float r[64];
#pragma unroll
    for (int t = 0; t < 64; t++) {
      float a = bf2f(src[t * 136 + col]) * sbeta[t];
      if (isw) a *= __expf(sgc[t]);
      r[t] = a;
    }
#pragma unroll
    for (int j = 0; j < 64; j++) {
      const float xj = r[j];
      *dst = f2bf(xj);
      dst += 512;
#pragma unroll
      for (int g = (j + 1) / 4; g < 16; g++) {
        const float4 a4 = *(const float4*)(sAm + j * 68 + g * 4);
        if (g * 4 > j) r[g * 4] -= a4.x * xj;
        if (g * 4 + 1 > j) r[g * 4 + 1] -= a4.y * xj;
        if (g * 4 + 2 > j) r[g * 4 + 2] -= a4.z * xj;
        if (g * 4 + 3 > j) r[g * 4 + 3] -= a4.w * xj;
      }
    }
  }
  {
    u16* gqp = (u16*)(p.ws + WS_G) + G_QP;
    const float gl = sgc[63];
#pragma unroll 4
    for (int i = 0; i < 32; i++) {
      const int e = tid + i * 256, t = e >> 7, cc = e & 127;
      gqp[(size_t)(tok0 + t) * 512 + hd * 128 + cc] = f2bf(bf2f(sq[t * 136 + cc]) * __expf(sgc[t]));
    }
    u16* kpt = (u16*)(p.ws + WS_G) + G_KPT + (size_t)(c * 4 + hd) * 128 * 64;
#pragma unroll 4
    for (int i = 0; i < 32; i++) {
      const int e = tid + i * 256, dk = e >> 6, t = e & 63;
      kpt[dk * 64 + t] = f2bf(bf2f(sk[t * 136 + dk]) * __expf(gl - sgc[t]));
    }
    if (tid == 0) ((float*)(p.ws + WS_GGL))[c * 4 + hd] = __expf(gl);
  }
  __syncthreads();
}

__device__ __forceinline__ void rglru_prep(u16* smem, const Params& p, int l, int c, int n) {
  const u16* z = (const u16*)(p.ws + WS_Z);
  float* sx = (float*)smem;
  float* su = sx + 64 * 65;
  u16* sxb = (u16*)(su + 64 * 65);
  u16* swa = sxb + 64 * 72;
  u16* swx = swa + 64 * 72;
  OPAQUE_TID(tid);
  const int lane = tid & 63, wid = tid >> 6, fr = lane & 15, fq = lane >> 4;
  const int tok0 = c * 64;
  const bool first = (c == 0) || (c >= 256);
  const int sb = c - 256;
  {
    const int ch = tid & 63, tq = tid >> 6, col = n * 64 + ch;
    const float* cw = p.b_conv_w + (size_t)l * 4 * 512 + col;
    const float w0 = cw[0], w1 = cw[512], w2 = cw[1024], w3 = cw[1536], bias = p.b_conv_b[l * 512 + col];
    u16* sraw = swx + 64 * 72;
    {
      u32x4 rr4[3];
#pragma unroll
      for (int i = 0; i < 3; i++) {
        const int idx = tid + i * 256, row = idx >> 3, c8 = (idx & 7) * 8, rr = row - 3;
        u32x4 v = (u32x4){0u, 0u, 0u, 0u};
        if (idx < 67 * 8) {
          if (rr >= 0 || !first) {
            v = *(const u32x4*)(z + (size_t)(tok0 + rr) * ZS + ZB_X + n * 64 + c8);
          } else if (c >= 256) {
            const float* st = p.st_rglru_conv + ((size_t)(l * 32 + sb) * 3 + row) * 512 + n * 64 + c8;
            const float4 f0 = *(const float4*)st, f1 = *(const float4*)(st + 4);
            v = (u32x4){pack2(f0.x, f0.y), pack2(f0.z, f0.w), pack2(f1.x, f1.y), pack2(f1.z, f1.w)};
          }
        }
        rr4[i] = v;
      }
#pragma unroll
      for (int i = 0; i < 3; i++) {
        const int idx = tid + i * 256, row = idx >> 3, c8 = (idx & 7) * 8;
        if (idx < 67 * 8) *(u32x4*)(sraw + row * 72 + c8) = rr4[i];
      }
    }
    __syncthreads();
    {
      const u16* src = sraw + (tq * 16) * 72 + ch;
      float x0 = bf2f(src[0]), x1 = bf2f(src[72]), x2 = bf2f(src[2 * 72]);
#pragma unroll 8
      for (int i = 0; i < 16; i++) {
        const int t = tq * 16 + i;
        const float x3 = bf2f(src[(i + 3) * 72]);
        const float y = w0 * x0 + w1 * x1 + w2 * x2 + w3 * x3 + bias;
        sx[t * 65 + ch] = y;
        sxb[t * 72 + ch] = f2bf(y);
        x0 = x1; x1 = x2; x2 = x3;
      }
    }
    const float* wa = p.b_ga_w + ((size_t)l * 8 + n) * 4096;
    const float* wx = p.b_gx_w + ((size_t)l * 8 + n) * 4096;
#pragma unroll
    for (int i = 0; i < 16; i++) {
      const int e = tid + i * 256, cin = e >> 6, d = e & 63;
      swa[d * 72 + cin] = f2bf(wa[e]);
      swx[d * 72 + cin] = f2bf(wx[e]);
    }
    if (c == 255 || c >= 256) {
      float* dst = (c == 255) ? p.out + O_PRC + (size_t)l * 3 * 512 : p.out + O_SRC + (size_t)(l * 32 + sb) * 3 * 512;
      if (tid < 192) {
        const int j = tid >> 6;
        dst[j * 512 + col] = bf2f(sraw[(64 + j) * 72 + ch]);
      }
    }
  }
  __syncthreads();
  f32x4 ra[4], rx[4];
  {
    const int ti = wid;
#pragma unroll
    for (int si = 0; si < 4; si++) {
      ra[si] = mma_lds_<64>(lane, sxb + ti * 16 * 72, 72, swa + si * 16 * 72, 72, (f32x4){0.f, 0.f, 0.f, 0.f});
      rx[si] = mma_lds_<64>(lane, sxb + ti * 16 * 72, 72, swx + si * 16 * 72, 72, (f32x4){0.f, 0.f, 0.f, 0.f});
    }
  }
  float lav[4][4], uv[4][4];
  {
    const int ti = wid;
#pragma unroll
    for (int si = 0; si < 4; si++) {
      const int d = si * 16 + fr, col = n * 64 + d;
      const float ba = p.b_ga_b[l * 512 + col], bx = p.b_gx_b[l * 512 + col];
      const float sp = softplus(-p.b_lambda[l * 512 + col]);
#pragma unroll
      for (int e = 0; e < 4; e++) {
        const int t = ti * 16 + fq * 4 + e;
        const float r = sigm(ra[si][e] + ba), ig = sigm(rx[si][e] + bx);
        const float la = -8.f * r * sp;
        float mult = sqrtf(fmaxf(1.f - __expf(2.f * la), 0.f));
        if (c == 0 && t == 0) mult = 1.f;
        const float u = mult * ig * sx[t * 65 + d];
        lav[si][e] = bf2f(f2bf(la));
        uv[si][e] = bf2f(f2bf(u));
      }
    }
  }
  __syncthreads();
  {
    const int ti = wid;
    u16* rla = (u16*)(p.ws + WS_RLA);
    u16* ru = (u16*)(p.ws + WS_RU);
#pragma unroll
    for (int si = 0; si < 4; si++) {
      const int d = si * 16 + fr, col = n * 64 + d;
#pragma unroll
      for (int e = 0; e < 4; e++) {
        const int t = ti * 16 + fq * 4 + e;
        sx[t * 65 + d] = lav[si][e];
        su[t * 65 + d] = uv[si][e];
        rla[(size_t)(tok0 + t) * 512 + col] = f2bf(lav[si][e]);
        ru[(size_t)(tok0 + t) * 512 + col] = f2bf(uv[si][e]);
      }
    }
  }
  __syncthreads();
  if (tid < 64) {
    float h = 0.f, sl = 0.f;
    for (int t = 0; t < 64; t++) {
      const float la = sx[t * 65 + tid];
      h = __expf(la) * h + su[t * 65 + tid];
      sl += la;
    }
    float* agg = (float*)(p.ws + WS_RAGG) + ((size_t)c * 512 + n * 64 + tid) * 2;
    agg[0] = sl;
    agg[1] = h;
  }
  __syncthreads();
}

__device__ __forceinline__ void rglru_scan(const Params& p, int l, int c, int hf) {
  OPAQUE_TID(tid);
  const int col = hf * 256 + tid;
  const int tok0 = c * 64;
  float h = 0.f;
  if (c >= 256) {
    h = p.st_rglru[(size_t)(l * 32 + (c - 256)) * 512 + col];
  } else {
    const float* agg = (const float*)(p.ws + WS_RAGG) + (size_t)col * 2;
    for (int cc = 0; cc < c; cc += 16) {
      float2 ab[16];
#pragma unroll
      for (int i = 0; i < 16; i++) ab[i] = *(const float2*)(agg + (size_t)min(cc + i, c - 1) * 1024);
#pragma unroll
      for (int i = 0; i < 16; i++) if (cc + i < c) h = __expf(ab[i].x) * h + ab[i].y;
    }
  }
  const u16* rla = (const u16*)(p.ws + WS_RLA) + (size_t)tok0 * 512 + col;
  u16* ru = (u16*)(p.ws + WS_RU) + (size_t)tok0 * 512 + col;
  for (int t0 = 0; t0 < 64; t0 += 32) {
    float la[32], u[32];
#pragma unroll
    for (int i = 0; i < 32; i++) { la[i] = bf2f(rla[(size_t)(t0 + i) * 512]); u[i] = bf2f(ru[(size_t)(t0 + i) * 512]); }
#pragma unroll
    for (int i = 0; i < 32; i++) {
      h = __expf(la[i]) * h + u[i];
      ru[(size_t)(t0 + i) * 512] = f2bf(h);
    }
  }
  if (c == 255) p.out[O_PR + (size_t)l * 512 + col] = h;
  else if (c >= 256) p.out[O_SR + (size_t)(l * 32 + (c - 256)) * 512 + col] = h;
}

template <bool GDN>
__device__ __forceinline__ void mat_scan(u16* smem, const Params& p, int l, int kind, int seg, int seq, int hd, int sl) {
  u16* z = (u16*)(p.ws + WS_Z);
  u16* sW = smem;
  u16* sQP = smem + 64 * 136;
  u16* sKT = smem + 2 * 64 * 136;
  u16* sQK = sKT + 128 * 72;
  u16* sSt = sQK + 64 * 72;
  u16* sVt = sSt + 32 * 136;
  OPAQUE_TID(tid);
  const int lane = tid & 63, wid = tid >> 6, fr = lane & 15, fq = lane >> 4;
  const int nchunk = (kind == 0) ? 1 : 16;
  const int c0 = (kind == 0) ? 255 + seq : seg * 16;
  const int cg = sl & 3;
  const int dvc = cg * 32 + fr;
  const bool full = (kind != 1);
  const bool uzero = (kind == 1 && sl >= 4);
  const int r16 = tid >> 4, c16 = (tid & 15) * 8;
  const int r8 = tid >> 3, c8 = (tid & 7) * 8;
  f32x4 S[2][2];
  f32x4 Dacc[2];
  { float one_ = 1.f; asm volatile("" : "+v"(one_)); Dacc[0] = (f32x4){one_, one_, one_, one_}; Dacc[1] = Dacc[0]; }
  if (kind == 0) {
    const float* st = (GDN ? p.st_gdn : p.st_hgrn) + ((size_t)(l * 32 + (seq - 1)) * 4 + hd) * 16384;
#pragma unroll
    for (int i = 0; i < 2; i++)
#pragma unroll
      for (int n = 0; n < 2; n++)
#pragma unroll
        for (int e = 0; e < 4; e++) S[i][n][e] = st[((wid * 2 + i) * 16 + fq * 4 + e) * 128 + dvc + n * 16];
  } else if (kind == 1) {
#pragma unroll
    for (int i = 0; i < 2; i++)
#pragma unroll
      for (int n = 0; n < 2; n++)
#pragma unroll
        for (int e = 0; e < 4; e++)
          S[i][n][e] = (sl >= 4 && ((wid * 2 + i) * 16 + fq * 4 + e) == (sl - 4) * 32 + n * 16 + fr) ? 1.f : 0.f;
  } else {
#pragma unroll
    for (int i = 0; i < 2; i++)
#pragma unroll
      for (int n = 0; n < 2; n++) S[i][n] = (f32x4){0.f, 0.f, 0.f, 0.f};
    if (!GDN) {
      const float* hs = (const float*)(p.ws + WS_HS);
      const float* hdp = (const float*)(p.ws + WS_HD);
#pragma unroll 4
      for (int j = 0; j < seg; j++) {
        f32x4 dj[2], sj[2][2];
#pragma unroll
        for (int i = 0; i < 2; i++) {
          dj[i] = *(const f32x4*)(hdp + (size_t)(j * 4 + hd) * 128 + (wid * 2 + i) * 16 + fq * 4);
#pragma unroll
          for (int n = 0; n < 2; n++)
#pragma unroll
            for (int e = 0; e < 4; e++)
              sj[i][n][e] = hs[((size_t)(j * 4 + hd) * 128 + (wid * 2 + i) * 16 + fq * 4 + e) * 128 + dvc + n * 16];
        }
#pragma unroll
        for (int i = 0; i < 2; i++)
#pragma unroll
          for (int n = 0; n < 2; n++) S[i][n] = S[i][n] * dj[i] + sj[i][n];
      }
    } else {
      const float* gb = (const float*)(p.ws + WS_GB);
      const u16* gp = (const u16*)(p.ws + WS_GP);
      u16* sP = smem;
      u32x4 rP[8];
      if (seg > 1) {
#pragma unroll
        for (int i = 0; i < 8; i++) rP[i] = *(const u32x4*)(gp + ((size_t)(1 * 4 + hd) * 128 + r16 + i * 16) * 128 + c16);
      }
      f32x4 bn[2][2];
#pragma unroll
      for (int i = 0; i < 2; i++)
#pragma unroll
        for (int n = 0; n < 2; n++)
#pragma unroll
          for (int e = 0; e < 4; e++)
            bn[i][n][e] = gb[((size_t)(0 * 4 + hd) * 128 + (wid * 2 + i) * 16 + fq * 4 + e) * 128 + dvc + n * 16];
      for (int j = 0; j < seg; j++) {
        f32x4 bj[2][2];
#pragma unroll
        for (int i = 0; i < 2; i++)
#pragma unroll
          for (int n = 0; n < 2; n++) bj[i][n] = bn[i][n];
        if (j == 0) {
#pragma unroll
          for (int i = 0; i < 2; i++)
#pragma unroll
            for (int n = 0; n < 2; n++) S[i][n] = bj[i][n];
          if (seg > 1) {
#pragma unroll
            for (int i = 0; i < 2; i++)
#pragma unroll
              for (int n = 0; n < 2; n++)
#pragma unroll
                for (int e = 0; e < 4; e++)
                  bn[i][n][e] = gb[((size_t)(1 * 4 + hd) * 128 + (wid * 2 + i) * 16 + fq * 4 + e) * 128 + dvc + n * 16];
          }
        } else {
          __syncthreads();
#pragma unroll
          for (int i = 0; i < 8; i++) *(u32x4*)(sP + (r16 + i * 16) * 136 + c16) = rP[i];
#pragma unroll
          for (int i = 0; i < 2; i++)
#pragma unroll
            for (int n = 0; n < 2; n++) {
              uint2 o2;
              o2.x = pack2(S[i][n][0], S[i][n][1]);
              o2.y = pack2(S[i][n][2], S[i][n][3]);
              *(uint2*)(sSt + (n * 16 + fr) * 136 + (wid * 2 + i) * 16 + fq * 4) = o2;
            }
          __syncthreads();
          if (j + 1 < seg) {
#pragma unroll
            for (int i = 0; i < 8; i++) rP[i] = *(const u32x4*)(gp + ((size_t)((j + 1) * 4 + hd) * 128 + r16 + i * 16) * 128 + c16);
#pragma unroll
            for (int i = 0; i < 2; i++)
#pragma unroll
              for (int n = 0; n < 2; n++)
#pragma unroll
                for (int e = 0; e < 4; e++)
                  bn[i][n][e] = gb[((size_t)((j + 1) * 4 + hd) * 128 + (wid * 2 + i) * 16 + fq * 4 + e) * 128 + dvc + n * 16];
          }
#pragma unroll
          for (int i = 0; i < 2; i++)
#pragma unroll
            for (int n = 0; n < 2; n++)
              S[i][n] = mma_lds_<128>(lane, sP + (wid * 2 + i) * 16 * 136, 136, sSt + n * 16 * 136, 136, bj[i][n]);
        }
      }
    }
  }
  const u16* gQP = GDN ? (const u16*)(p.ws + WS_G) + G_QP + hd * 128 : z + ZA_Q + hd * 128;
  const int ldqp = GDN ? 512 : ZS;
  const u16* gKT = GDN ? (const u16*)(p.ws + WS_G) + G_KPT : (const u16*)(p.ws + WS_HKPT);
  const u16* gQK = (GDN ? (const u16*)(p.ws + WS_G) + G_QK : (const u16*)(p.ws + WS_HQK)) + hd * 64;
  const u16* gW = (const u16*)(p.ws + WS_G) + G_W + hd * 128;
  const u16* gU = (const u16*)(p.ws + WS_G) + G_U + hd * 128 + dvc;
  u16* gO = z + (GDN ? ZC_V : ZA_I) + hd * 128 + dvc;

  u32x4 rQP[2][4], rW[2][4], rKT[2][4], rQK[2][2];
  unsigned rV[2][8];
  f32x4 rDv[2][2];
  float rG[2];
#define LOAD_REGS(ST, cx) do { \
    const int c_ = (cx); \
    const size_t tk0_ = (size_t)c_ * 64; \
    _Pragma("unroll") \
    for (int i = 0; i < 4; i++) { \
      if (full) rQP[ST][i] = *(const u32x4*)(gQP + (tk0_ + r16 + i * 16) * ldqp + c16); \
      if (GDN) rW[ST][i] = *(const u32x4*)(gW + (tk0_ + r16 + i * 16) * 512 + c16); \
      rKT[ST][i] = *(const u32x4*)(gKT + ((size_t)(c_ * 4 + hd) * 128 + r8 + i * 32) * 64 + c8); \
    } \
    if (full) { \
    _Pragma("unroll") \
      for (int i = 0; i < 2; i++) rQK[ST][i] = *(const u32x4*)(gQK + (tk0_ + r8 + i * 32) * 256 + c8); \
    } \
    if (GDN) { \
    _Pragma("unroll") \
      for (int n = 0; n < 2; n++) \
    _Pragma("unroll") \
        for (int e = 0; e < 4; e++) rV[ST][n * 4 + e] = uzero ? 0u : (unsigned)gU[(tk0_ + wid * 16 + fq * 4 + e) * 512 + n * 16]; \
      rG[ST] = ((const float*)(p.ws + WS_GGL))[c_ * 4 + hd]; \
    } else { \
    _Pragma("unroll") \
      for (int i = 0; i < 8; i++) { \
        const int e = tid + i * 256; \
        rV[ST][i] = z[(tk0_ + (e >> 5)) * ZS + ZA_I + hd * 128 + cg * 32 + (e & 31)]; \
      } \
      const float* da = (const float*)(p.ws + WS_HDA) + (size_t)c_ * 512 + hd * 128; \
    _Pragma("unroll") \
      for (int i = 0; i < 2; i++) rDv[ST][i] = *(const f32x4*)(da + (wid * 2 + i) * 16 + fq * 4); \
    } \
  } while (0)
#define SCAN_STEP(ST, cix) do { \
    const int ci_ = (cix); \
    const int c = c0 + ci_; \
    const size_t tok0 = (size_t)c * 64; \
    __syncthreads(); \
    _Pragma("unroll") \
    for (int i = 0; i < 4; i++) { \
      if (full) *(u32x4*)(sQP + (r16 + i * 16) * 136 + c16) = rQP[ST][i]; \
      if (GDN) *(u32x4*)(sW + (r16 + i * 16) * 136 + c16) = rW[ST][i]; \
      *(u32x4*)(sKT + (r8 + i * 32) * 72 + c8) = rKT[ST][i]; \
    } \
    if (full) { \
    _Pragma("unroll") \
      for (int i = 0; i < 2; i++) *(u32x4*)(sQK + (r8 + i * 32) * 72 + c8) = rQK[ST][i]; \
    } \
    _Pragma("unroll") \
    for (int i = 0; i < 2; i++) \
    _Pragma("unroll") \
      for (int n = 0; n < 2; n++) { \
        uint2 o2; \
        o2.x = pack2(S[i][n][0], S[i][n][1]); \
        o2.y = pack2(S[i][n][2], S[i][n][3]); \
        *(uint2*)(sSt + (n * 16 + fr) * 136 + (wid * 2 + i) * 16 + fq * 4) = o2; \
      } \
    float uu[8]; \
    if (GDN) { \
    _Pragma("unroll") \
      for (int e = 0; e < 8; e++) uu[e] = bf2f((u16)rV[ST][e]); \
    } else { \
    _Pragma("unroll") \
      for (int i = 0; i < 8; i++) { \
        const int e = tid + i * 256; \
        sVt[(e & 31) * 72 + (e >> 5)] = (u16)rV[ST][i]; \
      } \
    } \
    __syncthreads(); \
    float g_ = 0.f; f32x4 dv0_, dv1_; \
    if (GDN) { g_ = rG[ST]; asm volatile("" : "+v"(g_), "+v"(uu[0]), "+v"(uu[1]), "+v"(uu[2]), "+v"(uu[3]), "+v"(uu[4]), "+v"(uu[5]), "+v"(uu[6]), "+v"(uu[7]) :: "memory"); } \
    else { dv0_ = rDv[ST][0]; dv1_ = rDv[ST][1]; asm volatile("" : "+v"(dv0_), "+v"(dv1_) :: "memory"); } \
    if (ci_ + 2 < nchunk) LOAD_REGS(ST, c + 2); \
    f32x4 o[2]; \
    o[0] = (f32x4){0.f, 0.f, 0.f, 0.f}; o[1] = o[0]; \
    if (full) { \
    _Pragma("unroll") \
      for (int n = 0; n < 2; n++) o[n] = mma_lds_<128>(lane, sQP + wid * 16 * 136, 136, sSt + n * 16 * 136, 136, o[n]); \
    } \
    if (GDN) { \
    _Pragma("unroll") \
      for (int n = 0; n < 2; n++) { \
        f32x4 a = mma_lds_<128>(lane, sW + wid * 16 * 136, 136, sSt + n * 16 * 136, 136, (f32x4){0.f, 0.f, 0.f, 0.f}); \
        uint2 ov; \
        ov.x = pack2(uu[n * 4 + 0] - a[0], uu[n * 4 + 1] - a[1]); \
        ov.y = pack2(uu[n * 4 + 2] - a[2], uu[n * 4 + 3] - a[3]); \
        *(uint2*)(sVt + (n * 16 + fr) * 72 + wid * 16 + fq * 4) = ov; \
      } \
      __syncthreads(); \
    } \
    if (full) { \
    _Pragma("unroll") \
      for (int n = 0; n < 2; n++) { \
        o[n] = mma_lds_<64>(lane, sQK + wid * 16 * 72, 72, sVt + n * 16 * 72, 72, o[n]); \
    _Pragma("unroll") \
        for (int e = 0; e < 4; e++) gO[(tok0 + wid * 16 + fq * 4 + e) * ZS + n * 16] = f2bf(o[n][e]); \
      } \
    } \
    if (GDN) { \
      const float gs_ = __int_as_float(__builtin_amdgcn_readfirstlane(__float_as_int(g_))); \
    _Pragma("unroll") \
      for (int i = 0; i < 2; i++) { S[i][0] *= gs_; S[i][1] *= gs_; } \
    } else { \
      S[0][0] *= dv0_; S[0][1] *= dv0_; S[1][0] *= dv1_; S[1][1] *= dv1_; \
      Dacc[0] *= dv0_; Dacc[1] *= dv1_; \
    } \
    _Pragma("unroll") \
    for (int i = 0; i < 2; i++) \
    _Pragma("unroll") \
      for (int n = 0; n < 2; n++) \
        S[i][n] = mma_lds_<64>(lane, sKT + (wid * 2 + i) * 16 * 72, 72, sVt + n * 16 * 72, 72, S[i][n]); \
  } while (0)
  __syncthreads();
  LOAD_REGS(0, c0);
  if (nchunk > 1) LOAD_REGS(1, c0 + 1);
  for (int ci = 0; ci < nchunk; ci += 2) {
    SCAN_STEP(0, ci);
    if (ci + 1 < nchunk) SCAN_STEP(1, ci + 1);
  }
  if (kind == 1) {
    if (GDN && sl >= 4) {
      u16* gp = (u16*)(p.ws + WS_GP) + (size_t)(seg * 4 + hd) * 16384;
#pragma unroll
      for (int i = 0; i < 2; i++)
#pragma unroll
        for (int n = 0; n < 2; n++)
#pragma unroll
          for (int e = 0; e < 4; e++) gp[((wid * 2 + i) * 16 + fq * 4 + e) * 128 + (sl - 4) * 32 + n * 16 + fr] = f2bf(S[i][n][e]);
    } else {
      float* dst = (float*)(p.ws + (GDN ? WS_GB : WS_HS)) + (size_t)(seg * 4 + hd) * 16384;
#pragma unroll
      for (int i = 0; i < 2; i++)
#pragma unroll
        for (int n = 0; n < 2; n++)
#pragma unroll
          for (int e = 0; e < 4; e++) dst[((wid * 2 + i) * 16 + fq * 4 + e) * 128 + dvc + n * 16] = S[i][n][e];
      if (!GDN && sl == 0 && fr == 0) {
        float* dd = (float*)(p.ws + WS_HD) + (size_t)(seg * 4 + hd) * 128;
#pragma unroll
        for (int i = 0; i < 2; i++) *(f32x4*)(dd + (wid * 2 + i) * 16 + fq * 4) = Dacc[i];
      }
    }
  } else if (kind == 0 || seg == 15) {
    float* dst;
    if (kind == 2) dst = p.out + (GDN ? O_PG : O_PH) + ((size_t)l * 4 + hd) * 16384;
    else dst = p.out + (GDN ? O_SG : O_SH) + ((size_t)(l * 32 + (seq - 1)) * 4 + hd) * 16384;
#pragma unroll
    for (int i = 0; i < 2; i++)
#pragma unroll
      for (int n = 0; n < 2; n++)
#pragma unroll
        for (int e = 0; e < 4; e++) dst[((wid * 2 + i) * 16 + fq * 4 + e) * 128 + dvc + n * 16] = S[i][n][e];
  }
  __syncthreads();
}

__device__ __forceinline__ void onorm_phase(const Params& p, int l) {
  u16* z = (u16*)(p.ws + WS_Z);
  u16* ru = (u16*)(p.ws + WS_RU);
  OPAQUE_TID(tid);
  const int lane = tid & 63, wid = tid >> 6;
  for (int row = blockIdx.x * 4 + wid; row < NTOK; row += gridDim.x * 4) {
    u16* zr = z + (size_t)row * ZS;
#pragma unroll
    for (int br = 0; br < 2; br++) {
      u16* po = zr + (br == 0 ? ZA_I : ZC_V) + lane * 8;
      const u16* pg = zr + (br == 0 ? ZA_G : ZC_G) + lane * 8;
      const float* nw = (br == 0 ? p.a_norm : p.c_norm) + l * 128 + (lane & 15) * 8;
      const uint4 vo = *(const uint4*)po, vg = *(const uint4*)pg;
      const unsigned uo[4] = {vo.x, vo.y, vo.z, vo.w}, ug[4] = {vg.x, vg.y, vg.z, vg.w};
      float o[8], g[8];
#pragma unroll
      for (int i = 0; i < 4; i++) {
        o[2 * i] = bf2f((u16)(uo[i] & 0xffff)); o[2 * i + 1] = bf2f((u16)(uo[i] >> 16));
        g[2 * i] = bf2f((u16)(ug[i] & 0xffff)); g[2 * i + 1] = bf2f((u16)(ug[i] >> 16));
      }
      float ss = 0.f;
#pragma unroll
      for (int i = 0; i < 8; i++) ss += o[i] * o[i];
      ss += __shfl_xor(ss, 1); ss += __shfl_xor(ss, 2); ss += __shfl_xor(ss, 4); ss += __shfl_xor(ss, 8);
      const float r = rsqrtf(ss * (1.f / 128.f) + EPS);
      unsigned res[4];
#pragma unroll
      for (int i = 0; i < 4; i++)
        res[i] = pack2(o[2 * i] * r * nw[2 * i] * silu(g[2 * i]), o[2 * i + 1] * r * nw[2 * i + 1] * silu(g[2 * i + 1]));
      *(uint4*)po = make_uint4(res[0], res[1], res[2], res[3]);
    }
    {
      u16* ph = ru + (size_t)row * 512 + lane * 8;
      const u16* pg = zr + ZB_G + lane * 8;
      const uint4 vo = *(const uint4*)ph, vg = *(const uint4*)pg;
      const unsigned uo[4] = {vo.x, vo.y, vo.z, vo.w}, ug[4] = {vg.x, vg.y, vg.z, vg.w};
      unsigned res[4];
#pragma unroll
      for (int i = 0; i < 4; i++) {
        const float h0 = bf2f((u16)(uo[i] & 0xffff)), h1 = bf2f((u16)(uo[i] >> 16));
        const float g0 = bf2f((u16)(ug[i] & 0xffff)), g1 = bf2f((u16)(ug[i] >> 16));
        res[i] = pack2(gelu_t(g0) * h0, gelu_t(g1) * h1);
      }
      *(uint4*)ph = make_uint4(res[0], res[1], res[2], res[3]);
    }
  }
}

__device__ __forceinline__ void prep_phase(u16* smem, const Params& p, int l, bool dup) {
  for (int t = blockIdx.x; t < 4608; t += gridDim.x) {
    if (t < 1152) gdn_prep(smem, p, l, t >> 2, t & 3);
    else if (t < 2304) { if (!dup) hgrn_prep(smem, p, l, (t - 1152) >> 2, (t - 1152) & 3); }
    else rglru_prep(smem, p, l, (t - 2304) >> 3, (t - 2304) & 7);
  }
}

__device__ __forceinline__ void scan_phase(u16* smem, const Params& p, int l, int pass) {
  const int ntask = pass ? 512 : (720 + 576 + 1024);
  for (int t = blockIdx.x; t < ntask; t += gridDim.x) {
    bool isg; int kind, seg = 0, seq = 0, hd, sl;
    if (pass) {
      kind = 2;
      if (t < 256) { isg = true; seg = 15 - (t >> 4); hd = (t >> 2) & 3; sl = t & 3; }
      else { const int u = t - 256; isg = false; seg = u >> 4; hd = (u >> 2) & 3; sl = u & 3; }
    } else {
      if (t >= 720 && t < 1296) { rglru_scan(p, l, (t - 720) >> 1, (t - 720) & 1); continue; }
      if (t < 480) { kind = 1; isg = true; seg = t >> 5; hd = (t >> 3) & 3; sl = t & 7; }
      else if (t < 720) { const int u = t - 480; kind = 1; isg = false; seg = u >> 4; hd = (u >> 2) & 3; sl = u & 3; }
      else if (t < 1296 + 512) { const int u = t - 1296; kind = 0; isg = true; seq = 1 + (u >> 4); hd = (u >> 2) & 3; sl = u & 3; }
      else { const int u = t - 1808; kind = 0; isg = false; seq = 1 + (u >> 4); hd = (u >> 2) & 3; sl = u & 3; }
    }
    if (isg) mat_scan<true>(smem, p, l, kind, seg, seq, hd, sl);
    else mat_scan<false>(smem, p, l, kind, seg, seq, hd, sl);
  }
}

__device__ __forceinline__ void run_phase(u16* smem, const Params& p, int l, int ph, bool dup = false) {
#ifdef ONLY_PH
  if (ph != ONLY_PH) return;
  ph = ONLY_PH;
#endif
  u16* Z = (u16*)(p.ws + WS_Z);
  u16* WB = (u16*)(p.ws + WS_WB);
  u16* H = (u16*)(p.ws + WS_H);
  u16* Y = (u16*)(p.ws + WS_Y);
  if (ph == 0 || ph == 7 || ph == 10) {
    const bool fi = (ph == 0);
    const u16* y = fi ? nullptr : Y;
    const float* postw = ((ph == 7) ? opq(p.n_post_mix) : opq(p.n_post_mlp)) + l * D;
    const float* npm = opq(p.n_pre_mix);
    const float* prew = (ph == 0) ? npm : (ph == 7) ? opq(p.n_pre_mlp) + l * D : ((l + 1 < DEPTH) ? npm + (l + 1) * D : nullptr);
    rowpass_phase(p, fi, y, postw, prew, H);
    const int wl = (ph == 0) ? 0 : l + 1;
    if (ph != 7 && wl < DEPTH) wconv_phase(smem, p, wl);
  } else if (ph == 1 || ph == 6 || ph == 8 || ph == 9) {
    const u16* A = (ph == 9) ? Z : H;
    const int lda = (ph == 9) ? 4096 : 1024;
    const u16* Bt = WB + ((ph == 1) ? WB_IN : (ph == 6) ? WB_OUT : (ph == 8) ? WB_UP : WB_DN);
    const int K = (ph == 9) ? 4096 : 1024;
    const int N = (ph == 1) ? ZS : (ph == 8) ? 4096 : 1024;
    u16* C = (ph == 1 || ph == 8) ? Z : Y;
    const int ldc = (ph == 1) ? ZS : (ph == 8) ? 4096 : 1024;
    gemm_big_phase(smem, A, lda, Bt, K, N, K, C, ldc, ph == 8 ? 1 : 0);
  } else if (ph == 2) prep_phase(smem, p, l, dup);
  else if (ph == 3 || ph == 11) scan_phase(smem, p, l, ph == 11 ? 1 : 0);
  else if (ph == 4) onorm_phase(p, l);
  else if (ph == 5) merge_big_phase(smem, p);
}

#if MULTI_LAUNCH
__global__ void __launch_bounds__(256, 2) phase_kernel(Params p, int l, int ph) {
  __shared__ __attribute__((aligned(16))) u16 smem[SMEM_BYTES / 2];
  run_phase(smem, p, l, ph);
}
#endif

#if !MULTI_LAUNCH
#define XB_TMO      128
#define XB_XCNT(j)  (256  + 64 * (j))
#define XB_XSUB(j)  (1280 + 64 * (j))
#define XB_XGEN(j)  (2304 + 64 * (j))
#define XB_TOP      3328
#define XB_TOPGEN   3392
#define XCD_BAR_WORDS 3456
#define XB_SPIN_CAP (1u << 18)
#define LAS __attribute__((address_space(3)))

__device__ __forceinline__ unsigned xb_ld(unsigned* p)              { return __hip_atomic_load(p, __ATOMIC_RELAXED, __HIP_MEMORY_SCOPE_AGENT); }
__device__ __forceinline__ unsigned xb_add(unsigned* p, unsigned v) { return __hip_atomic_fetch_add(p, v, __ATOMIC_RELAXED, __HIP_MEMORY_SCOPE_AGENT); }
__device__ __forceinline__ unsigned xb_xcc_id() { return (unsigned)__builtin_amdgcn_s_getreg((3 << 11) | 20) & 0xFu; }
#define XB_SPIN(cond, bar) do { unsigned _sp = 0; while (cond) { __builtin_amdgcn_s_sleep(1); \
    if ((++_sp & 255u) == 0u) { if (xb_ld(&(bar)[XB_TMO])) break; if (_sp > XB_SPIN_CAP) { atomicAdd(&(bar)[XB_TMO], 1u); break; } } } } while (0)

struct XcdBarrier {
    unsigned* bar; unsigned x;
    volatile LAS unsigned* st;
};

__device__ __forceinline__ XcdBarrier xcd_barrier_post(unsigned* bar, volatile LAS unsigned* st) {
    XcdBarrier b; b.bar = bar; b.x = xb_xcc_id(); b.st = st;
    if (threadIdx.x == 0) (void)xb_add(&bar[XB_XCNT(b.x)], 1u);
    return b;
}
__device__ __forceinline__ void xcd_barrier_complete(unsigned* bar, unsigned x, unsigned& nloc, unsigned& nx) {
    const unsigned G = gridDim.x * gridDim.y * gridDim.z;
    unsigned sum, cnt, mine, sp = 0u;
    for (;;) {
        sum = 0u; cnt = 0u; mine = 0u;
#pragma unroll
        for (unsigned j = 0; j < 16; ++j) { const unsigned c = xb_ld(&bar[XB_XCNT(j)]); sum += c; cnt += (c > 0u) ? 1u : 0u; mine = (j == x) ? c : mine; }
        if (sum == G) break;
        __builtin_amdgcn_s_sleep(1);
        if ((++sp & 255u) == 0u) { if (xb_ld(&bar[XB_TMO])) break; if (sp > XB_SPIN_CAP) { atomicAdd(&bar[XB_TMO], 1u); break; } }
    }
    nloc = mine > 0u ? mine : 1u; nx = cnt > 0u ? cnt : 1u;
}

__device__ __forceinline__ void xcd_barrier(const XcdBarrier& b) {
    asm volatile("s_waitcnt vmcnt(0)" ::: "memory");
    __syncthreads();
    if (threadIdx.x == 0) {
        unsigned* bar = b.bar;
        __builtin_amdgcn_s_waitcnt(0);
        unsigned nloc = b.st[0], nx = b.st[1];
        if (nloc == 0u) { xcd_barrier_complete(bar, b.x, nloc, nx); b.st[0] = nloc; b.st[1] = nx; }
        const unsigned old = xb_add(&bar[XB_XSUB(b.x)], 1u);
        const unsigned gen = old / nloc;
        if (old + 1u == (gen + 1u) * nloc) {
            __builtin_amdgcn_fence(__ATOMIC_RELEASE, "agent");
            asm volatile("s_waitcnt vmcnt(0)" ::: "memory");
            const unsigned og = xb_add(&bar[XB_TOP], 1u);
            const unsigned tg = og / nx;
            if (og + 1u == (tg + 1u) * nx) xb_add(&bar[XB_TOPGEN], 1u);
            else XB_SPIN(xb_ld(&bar[XB_TOPGEN]) == tg, bar);
            __builtin_amdgcn_fence(__ATOMIC_ACQUIRE, "agent");
            xb_add(&bar[XB_XGEN(b.x)], 1u);
            asm volatile("s_waitcnt vmcnt(0)" ::: "memory");
        } else {
            XB_SPIN(xb_ld(&bar[XB_XGEN(b.x)]) == gen, bar);
            __builtin_amdgcn_fence(__ATOMIC_ACQUIRE, "agent");
            asm volatile("s_waitcnt vmcnt(0)" ::: "memory");
        }
    }
    __syncthreads();
}


__global__ void __launch_bounds__(256, 2) mega_kernel(Params p) {
  __shared__ __attribute__((aligned(16))) u16 smem[SMEM_BYTES / 2 + 8];
  cg::grid_group grid = cg::this_grid();
  unsigned* xbw = (unsigned*)(smem + SMEM_BYTES / 2);
  if (threadIdx.x == 0) { xbw[0] = 0u; xbw[1] = 0u; xbw[2] = 0u; xbw[3] = 0u; }
  __syncthreads();
  XcdBarrier xb = xcd_barrier_post((unsigned*)(p.ws + WS_BAR), (volatile LAS unsigned*)xbw);
  if (p.ws == nullptr) grid.sync();
  for (int s = 0; s < 1 + DEPTH * 11; s++) {
    int l = 0, ph = 0;
    if (s > 0) {
      l = (s - 1) / 11;
      const int pi = (s - 1) % 11 + 1;
      ph = (pi <= 3) ? pi : (pi == 4) ? 11 : pi - 1;
    }
    run_phase(smem, p, l, ph);
    xcd_barrier(xb);
#ifdef DUP_MASK
    if (s > 0 && ((DUP_MASK >> ph) & 1)) { run_phase(smem, p, l, ph, true); xcd_barrier(xb); }
#endif
#ifdef EXTRA_SYNCS
    for (int i = 0; i < EXTRA_SYNCS; i++) xcd_barrier(xb);
#endif
  }
}
#endif

extern "C" void kernel_launch(void* const* d_in, const int* in_sizes, int n_in, void* d_out, int out_size, void* d_ws,
                              size_t ws_size, hipStream_t stream) {
  if (ws_size < WS_END) { fprintf(stderr, "workspace too small: %zu < %zu\n", ws_size, (size_t)WS_END); return; }
  Params p{};
  const float** pp = (const float**)&p;
  for (int i = 0; i < 31; i++) pp[i] = (const float*)d_in[i];
  p.out = (float*)d_out;
  p.ws = (char*)d_ws;
  static int grid_blocks = 0;
  if (!grid_blocks) {
    int dev = 0, cus = 0, per_cu = 0;
    hipGetDevice(&dev);
    hipDeviceGetAttribute(&cus, hipDeviceAttributeMultiprocessorCount, dev);
#if MULTI_LAUNCH
    hipOccupancyMaxActiveBlocksPerMultiprocessor(&per_cu, phase_kernel, 256, 0);
#else
    hipOccupancyMaxActiveBlocksPerMultiprocessor(&per_cu, mega_kernel, 256, 0);
#endif
    if (per_cu > 2) per_cu = 2;
    if (per_cu < 1) per_cu = 1;
    grid_blocks = cus * per_cu;
  }
#if MULTI_LAUNCH
  phase_kernel<<<grid_blocks, 256, 0, stream>>>(p, 0, 0);
  for (int l = 0; l < DEPTH; l++)
    for (int pi = 1; pi <= 11; pi++) phase_kernel<<<grid_blocks, 256, 0, stream>>>(p, l, (pi <= 3) ? pi : (pi == 4) ? 11 : pi - 1);
#else
  hipMemsetAsync((char*)d_ws + WS_BAR, 0, 16384, stream);
  void* args[] = {&p};
  hipError_t e = hipLaunchCooperativeKernel((void*)mega_kernel, dim3(grid_blocks), dim3(256), args, 0, stream);
  if (e != hipSuccess) fprintf(stderr, "cooperative launch failed: %s (grid %d)\n", hipGetErrorString(e), grid_blocks);
#endif
}
```

```cpp
#include <hip/hip_runtime.h>
#include <hip/hip_cooperative_groups.h>
#include <cstdio>
namespace cg = cooperative_groups;

#ifndef MULTI_LAUNCH
#define MULTI_LAUNCH 0
#endif

typedef unsigned short u16;
typedef __attribute__((ext_vector_type(8))) short bf16x8;
typedef __attribute__((ext_vector_type(4))) float f32x4;
typedef __attribute__((ext_vector_type(4))) unsigned int u32x4;

constexpr int D = 1024, NTOK = 18432, TP = 16384, NCHUNK = 288, DEPTH = 4, DFF = 4096;
constexpr int DIN = 8200, ZS = 8320;
constexpr int ZA_Q = 0, ZA_F = 512, ZA_I = 1024, ZA_G = 1536, ZB_X = 2048, ZB_G = 2560, ZC_Q = 3072, ZC_V = 4096,
              ZC_G = 4608, ZC_BETA = 5120, ZC_ALPHA = 5124, Z_MERGE = 5128;
constexpr float EPS = 1e-6f;

constexpr size_t O_YP = 0, O_YS = 16777216, O_PH = 18874368, O_PR = 19136512, O_PRC = 19138560, O_PG = 19144704,
                 O_PGC = 19406848, O_SH = 19425280, O_SR = 27813888, O_SRC = 27879424, O_SG = 28076032, O_SGC = 36464640;

constexpr size_t WS_Z = 0;
constexpr size_t WS_WB = WS_Z + (size_t)NTOK * ZS * 2;
constexpr size_t WB_IN = 0, WB_BR = (size_t)ZS * 1024, WB_OUT = WB_BR + 3 * 1024 * 512, WB_UP = WB_OUT + 1024 * 1024,
                 WB_DN = WB_UP + 4096 * 1024, WB_END = WB_DN + 4096 * 1024;
constexpr size_t WS_G = WS_WB + WB_END * 2;
constexpr size_t G_U = 0, G_W = (size_t)NTOK * 512, G_QP = 2 * G_W, G_KPT = 3 * G_W, G_QK = 4 * G_W, G_END = 4 * G_W + (size_t)NTOK * 256;
constexpr size_t WS_H = WS_G, WS_Y = WS_G + (size_t)NTOK * 1024 * 2;
constexpr size_t WS_HKPT = WS_G + G_END * 2;
constexpr size_t WS_HQK = WS_HKPT + (size_t)NTOK * 512 * 2;
constexpr size_t WS_HDA = WS_HQK + (size_t)NTOK * 256 * 2;
constexpr size_t WS_GGL = WS_HDA + (size_t)NCHUNK * 512 * 4;
constexpr size_t WS_RLA = WS_GGL + 8192;
constexpr size_t WS_RU = WS_RLA + (size_t)NTOK * 512 * 2;
constexpr size_t WS_RAGG = WS_RU + (size_t)NTOK * 512 * 2;
constexpr size_t WS_BAR = WS_RAGG + (size_t)NCHUNK * 512 * 8;
constexpr size_t WS_HS = WS_BAR + 16384;
constexpr size_t WS_HD = WS_HS + (size_t)15 * 4 * 16384 * 4;
constexpr size_t WS_GB = WS_HD + (size_t)15 * 4 * 128 * 4;
constexpr size_t WS_GP = WS_GB + (size_t)15 * 4 * 16384 * 4;
constexpr size_t WS_END = WS_GP + (size_t)15 * 4 * 16384 * 2;

struct Params {
  const float *x_prompt, *x_sample, *st_hgrn, *st_rglru, *st_rglru_conv, *st_gdn, *st_gdn_conv, *lb_raw, *n_pre_mix,
      *n_post_mix, *n_pre_mlp, *n_post_mlp, *w_in, *a_norm, *b_conv_w, *b_conv_b, *b_ga_w, *b_ga_b, *b_gx_w, *b_gx_b,
      *b_lambda, *c_conv_w, *c_a_log, *c_dt_bias, *c_norm, *w_br_a, *w_br_b, *w_br_c, *w_out, *w_up, *w_down;
  float* out;
  char* ws;
};

__device__ __forceinline__ u16 f2bf(float f) {
  unsigned u = __float_as_uint(f);
  u += 0x7fffu + ((u >> 16) & 1u);
  return (u16)(u >> 16);
}
__device__ __forceinline__ float bf2f(u16 h) { return __uint_as_float(((unsigned)h) << 16); }
__device__ __forceinline__ float sigm(float x) { return 1.f / (1.f + __expf(-x)); }
__device__ __forceinline__ float silu(float x) { return x * sigm(x); }
__device__ __forceinline__ float softplus(float x) { return fmaxf(x, 0.f) + __logf(1.f + __expf(-fabsf(x))); }
__device__ __forceinline__ float gelu_t(float x) {
  const float u = 1.5957691216f * (x + 0.044715f * x * x * x);
  return x * sigm(u);
}
__device__ __forceinline__ unsigned pack2(float a, float b) { return (unsigned)f2bf(a) | ((unsigned)f2bf(b) << 16); }

template <class T> __device__ __forceinline__ T* opq(T* x) { asm volatile("" : "+s"(x)); return x; }
#define OPAQUE_TID(t) int t = threadIdx.x; asm volatile("" : "+v"(t))

template <int K>
__device__ __forceinline__ f32x4 mma_lds_(int lane, const u16* a, int lda, const u16* b, int ldb, f32x4 acc) {
  const int r = lane & 15, q = lane >> 4;
  const u16* pa = a + r * lda + q * 8;
  const u16* pb = b + r * ldb + q * 8;
#pragma unroll
  for (int k = 0; k < K; k += 32) {
    bf16x8 af = *(const bf16x8*)(pa + k);
    bf16x8 bf = *(const bf16x8*)(pb + k);
    acc = __builtin_amdgcn_mfma_f32_16x16x32_bf16(af, bf, acc, 0, 0, 0);
  }
  return acc;
}

constexpr int BM = 128, BK = 64, LDT = 72;
constexpr int SMEM_BYTES = 75776;

template <int NJ>
__device__ __forceinline__ void gemm_tile(u16* smem, const u16* __restrict__ A, int lda, const u16* __restrict__ Bt,
                                          int ldb, int K, int m0, int n0, f32x4 (&acc)[4][NJ]) {
  OPAQUE_TID(tid);
  const int lane = tid & 63, wid = tid >> 6, wr = wid >> 1, wc = wid & 1, fr = lane & 15, fq = lane >> 4;
#pragma unroll
  for (int i = 0; i < 4; i++)
#pragma unroll
    for (int j = 0; j < NJ; j++) acc[i][j] = (f32x4){0.f, 0.f, 0.f, 0.f};
  const int lrow = tid >> 3, lc8 = (tid & 7) * 8;
  const u16* ga = A + (size_t)(m0 + lrow) * lda + lc8;
  const u16* gb = Bt + (size_t)(n0 + lrow) * ldb + lc8;
  u32x4 ra[4], rb[NJ];
#pragma unroll
  for (int i = 0; i < 4; i++) {
    ra[i] = *(const u32x4*)(ga + (size_t)i * 32 * lda);
    if (i < NJ) rb[i] = *(const u32x4*)(gb + (size_t)i * 32 * ldb);
  }
#pragma unroll
  for (int i = 0; i < 4; i++) {
    *(u32x4*)(smem + (lrow + i * 32) * LDT + lc8) = ra[i];
    if (i < NJ) *(u32x4*)(smem + BM * LDT + (lrow + i * 32) * LDT + lc8) = rb[i];
  }
  __syncthreads();
  const int nk = K / BK;
  for (int kt = 0; kt < nk; kt++) {
    const int cur = kt & 1;
    const bool more = (kt + 1 < nk);
    if (more) {
      ga += BK; gb += BK;
#pragma unroll
      for (int i = 0; i < 4; i++) {
        ra[i] = *(const u32x4*)(ga + (size_t)i * 32 * lda);
        if (i < NJ) rb[i] = *(const u32x4*)(gb + (size_t)i * 32 * ldb);
      }
    }
    const u16* a = smem + cur * 2 * BM * LDT + (wr * 64 + fr) * LDT + fq * 8;
    const u16* b = smem + cur * 2 * BM * LDT + BM * LDT + (wc * 16 * NJ + fr) * LDT + fq * 8;
#pragma unroll
    for (int ks = 0; ks < 2; ks++) {
      bf16x8 af[4], bf[NJ];
#pragma unroll
      for (int i = 0; i < 4; i++) {
        af[i] = *(const bf16x8*)(a + i * 16 * LDT + ks * 32);
        if (i < NJ) bf[i] = *(const bf16x8*)(b + i * 16 * LDT + ks * 32);
      }
#pragma unroll
      for (int i = 0; i < 4; i++)
#pragma unroll
        for (int j = 0; j < NJ; j++) acc[i][j] = __builtin_amdgcn_mfma_f32_16x16x32_bf16(af[i], bf[j], acc[i][j], 0, 0, 0);
    }
    if (more) {
      u16* sa = smem + (cur ^ 1) * 2 * BM * LDT;
#pragma unroll
      for (int i = 0; i < 4; i++) {
        *(u32x4*)(sa + (lrow + i * 32) * LDT + lc8) = ra[i];
        if (i < NJ) *(u32x4*)(sa + BM * LDT + (lrow + i * 32) * LDT + lc8) = rb[i];
      }
    }
    __syncthreads();
  }
}

__device__ __forceinline__ void tile_coords(int tile, int NT, int& mt, int& nt) {
  const int band = tile / (8 * NT), within = tile % (8 * NT);
  mt = band * 8 + (within & 7);
  nt = within >> 3;
}

__device__ __forceinline__ void gemm_phase(u16* smem, const u16* A, int lda, const u16* Bt, int ldb, int N, int K, u16* C, int ldc, int EPI) {
  const int NT = N / 128, MT = NTOK / 128;
  OPAQUE_TID(tid);
  const int lane = tid & 63, wid = tid >> 6, wr = wid >> 1, wc = wid & 1, fr = lane & 15, fq = lane >> 4;
  for (int tile = blockIdx.x; tile < MT * NT; tile += gridDim.x) {
    int mt, nt;
    tile_coords(tile, NT, mt, nt);
    f32x4 acc[4][4];
    gemm_tile<4>(smem, A, lda, Bt, ldb, K, mt * 128, nt * 128, acc);
#pragma unroll
    for (int i = 0; i < 4; i++)
#pragma unroll
      for (int j = 0; j < 4; j++)
#pragma unroll
        for (int e = 0; e < 4; e++) {
          const int row = mt * 128 + wr * 64 + i * 16 + fq * 4 + e, col = nt * 128 + wc * 64 + j * 16 + fr;
          float v = acc[i][j][e];
          if (EPI == 1) { v = fmaxf(v, 0.f); v = v * v; }
          C[(size_t)row * ldc + col] = f2bf(v);
        }
  }
}

__device__ __forceinline__ void glds16(const void* gsrc, unsigned lds_dst) {
  unsigned keep;
  asm volatile("s_mov_b32 %0, m0\n\ts_mov_b32 m0, %2\n\ts_nop 0\n\tglobal_load_lds_dwordx4 %1, off\n\ts_mov_b32 m0, %0"
               : "=&s"(keep) : "v"(gsrc), "s"(lds_dst) : "memory");
}

constexpr int BMB = 288, LDB_ = 40, STG = (BMB + 128) * LDB_;
constexpr int STGG = (BMB + 128) * 32;
__device__ __forceinline__ void gemm_big_phase(u16* smem, const u16* __restrict__ A, int lda, const u16* __restrict__ Bt, int ldb,
                                               int N, int K, u16* C, int ldc, int EPI) {
  const int NT = N / 128, MT = NTOK / BMB;
  OPAQUE_TID(tid);
  const int lane = tid & 63, wid = tid >> 6, wr = wid >> 1, wc = wid & 1, fr = lane & 15, fq = lane >> 4;
  const int nmc = (NT + 7) >> 3;
  const bool xcd_order = (gridDim.x == 512);
  const int nwork = xcd_order ? 8 * nmc * 64 : MT * NT;
  for (int w = blockIdx.x; w < nwork; w += gridDim.x) {
    int mt, nt;
    if (xcd_order) {
      const int q = (w >> 9) * 8 + (w & 7), slot = (w >> 3) & 63;
      mt = (q & 7) * 8 + (slot & 7); nt = (q >> 3) * 8 + (slot >> 3);
      if (nt >= NT) continue;
    } else {
      tile_coords(w, NT, mt, nt);
    }
    const int m0 = mt * BMB, n0 = nt * 128;
    f32x4 acc[9][4];
#pragma unroll
    for (int i = 0; i < 9; i++)
#pragma unroll
      for (int j = 0; j < 4; j++) acc[i][j] = (f32x4){0.f, 0.f, 0.f, 0.f};
    const int gl_row = lane >> 2, gl_c = (lane & 3) ^ ((lane >> 4) & 3);
    const unsigned oA = ((unsigned)(m0 + gl_row) * (unsigned)lda + gl_c * 8) * 2u;
    const unsigned oB = ((unsigned)(n0 + gl_row) * (unsigned)ldb + gl_c * 8) * 2u;
    const char* Ab = (const char*)A; const char* Bb = (const char*)Bt;
    const int pc = fq ^ (fr >> 2);
    const int nk = K / 32;
    const int uw = __builtin_amdgcn_readfirstlane(wid);
    const unsigned lds0 = (unsigned)__builtin_amdgcn_readfirstlane((int)(unsigned)(size_t)smem);
#define GG_STAGE(st_, kt_) do { \
      _Pragma("unroll") \
      for (int k_ = 0; k_ < 5; k_++) { \
        const int a_ = uw + 4 * k_; \
        if (a_ < 18) glds16(Ab + (oA + (unsigned)((16 * a_) * lda + (kt_) * 32) * 2u), lds0 + (unsigned)(((st_) * STGG + a_ * 512) * 2)); \
      } \
      _Pragma("unroll") \
      for (int k_ = 0; k_ < 2; k_++) { \
        const int b_ = uw + 4 * k_; \
        glds16(Bb + (oB + (unsigned)((16 * b_) * ldb + (kt_) * 32) * 2u), lds0 + (unsigned)(((st_) * STGG + 9216 + b_ * 512) * 2)); \
      } \
    } while (0)
    GG_STAGE(0, 0);
    asm volatile("s_waitcnt vmcnt(0)" ::: "memory");
    __syncthreads();
    for (int kt = 0; kt < nk; kt++) {
      const int cur = kt & 1;
      if (kt + 1 < nk) GG_STAGE(cur ^ 1, kt + 1);
      const u16* a = smem + cur * STGG + (wr * 144 + fr) * 32 + pc * 8;
      const u16* b = smem + cur * STGG + 9216 + (wc * 64 + fr) * 32 + pc * 8;
      bf16x8 bf[4], af[9];
#pragma unroll
      for (int j = 0; j < 4; j++) bf[j] = *(const bf16x8*)(b + j * 512);
#pragma unroll
      for (int i = 0; i < 9; i++) af[i] = *(const bf16x8*)(a + i * 512);
      __builtin_amdgcn_sched_barrier(0);
#pragma unroll
      for (int i = 0; i < 9; i++)
#pragma unroll
        for (int j = 0; j < 4; j++) acc[i][j] = __builtin_amdgcn_mfma_f32_16x16x32_bf16(af[i], bf[j], acc[i][j], 0, 0, 0);
      __builtin_amdgcn_sched_barrier(0);
      asm volatile("s_waitcnt vmcnt(0)" ::: "memory");
      __syncthreads();
    }
    {
      u16* scr = smem + STGG + wid * 16 * 72;
#pragma unroll
      for (int i = 0; i < 9; i++) {
#pragma unroll
        for (int j = 0; j < 4; j++)
#pragma unroll
          for (int e = 0; e < 4; e++) {
            float v = acc[i][j][e];
            if (EPI == 1) { v = fmaxf(v, 0.f); v = v * v; }
            scr[(fq * 4 + e) * 72 + j * 16 + fr] = f2bf(v);
          }
#pragma unroll
        for (int h = 0; h < 2; h++) {
          const int rr = h * 8 + (lane >> 3), cc = (lane & 7) * 8;
          const u32x4 v = *(const u32x4*)(scr + rr * 72 + cc);
          __builtin_nontemporal_store(v, (u32x4*)(C + (size_t)(m0 + wr * 144 + i * 16 + rr) * ldc + n0 + wc * 64 + cc));
        }
      }
    }
  }
}

__device__ __forceinline__ void merge_phase(u16* smem, const Params& p) {
  const u16* z = (const u16*)(p.ws + WS_Z);
  const u16* wb = (const u16*)(p.ws + WS_WB) + WB_BR;
  const u16* ru = (const u16*)(p.ws + WS_RU);
  u16* H = (u16*)(p.ws + WS_H);
  const int NT = 8, MT = NTOK / 128;
  OPAQUE_TID(tid);
  const int lane = tid & 63, wid = tid >> 6, wr = wid >> 1, wc = wid & 1, fr = lane & 15, fq = lane >> 4;
  const int lrow = tid >> 3, lc8 = (tid & 7) * 8;
  for (int tile = blockIdx.x; tile < MT * NT; tile += gridDim.x) {
    int mt, nt;
    tile_coords(tile, NT, mt, nt);
    const int m0 = mt * 128, n0 = nt * 128;
    f32x4 tot[4][4], acc[4][4];
#pragma unroll
    for (int i = 0; i < 4; i++)
#pragma unroll
      for (int j = 0; j < 4; j++) { tot[i][j] = (f32x4){0.f, 0.f, 0.f, 0.f}; acc[i][j] = tot[i][j]; }
    u32x4 ra[4], rb[4];
    unsigned gv[4][4][2];
#define MG_LOAD(it_) do { \
      const int sg_ = (it_) >> 3, kk_ = (it_) & 7; \
      const u16* A_ = (sg_ == 0) ? z + ZA_I : (sg_ == 1) ? ru : z + ZC_V; \
      const int lda_ = (sg_ == 1) ? 512 : ZS; \
      const u16* ga_ = A_ + (size_t)(m0 + lrow) * lda_ + kk_ * 64 + lc8; \
      const u16* gb_ = wb + (size_t)sg_ * 1024 * 512 + (size_t)(n0 + lrow) * 512 + kk_ * 64 + lc8; \
      _Pragma("unroll") \
      for (int i = 0; i < 4; i++) ra[i] = *(const u32x4*)(ga_ + (size_t)i * 32 * lda_); \
      _Pragma("unroll") \
      for (int i = 0; i < 4; i++) rb[i] = *(const u32x4*)(gb_ + (size_t)i * 32 * 512); \
    } while (0)
#define MG_STORE(st_) do { \
      u16* sa_ = smem + (st_) * 2 * BM * LDT; \
      _Pragma("unroll") \
      for (int i = 0; i < 4; i++) *(u32x4*)(sa_ + (lrow + i * 32) * LDT + lc8) = ra[i]; \
      _Pragma("unroll") \
      for (int i = 0; i < 4; i++) *(u32x4*)(sa_ + BM * LDT + (lrow + i * 32) * LDT + lc8) = rb[i]; \
    } while (0)
    MG_LOAD(0);
    MG_STORE(0);
    __syncthreads();
    for (int it = 0; it < 24; it++) {
      const int cur = it & 1, sg = it >> 3, kk = it & 7;
      if (kk == 0) {
#pragma unroll
        for (int i = 0; i < 4; i++)
#pragma unroll
          for (int j = 0; j < 4; j++) {
            const u16* gp = z + (size_t)(m0 + wr * 64 + i * 16 + fq * 4) * ZS + Z_MERGE + sg * 1024 + n0 + wc * 64 + j * 16 + fr;
            gv[i][j][0] = (unsigned)gp[0] | ((unsigned)gp[ZS] << 16);
            gv[i][j][1] = (unsigned)gp[2 * ZS] | ((unsigned)gp[3 * ZS] << 16);
          }
      }
      if (it + 1 < 24) MG_LOAD(it + 1);
      const u16* a = smem + cur * 2 * BM * LDT + (wr * 64 + fr) * LDT + fq * 8;
      const u16* b = smem + cur * 2 * BM * LDT + BM * LDT + (wc * 64 + fr) * LDT + fq * 8;
#pragma unroll
      for (int ks = 0; ks < 2; ks++) {
        bf16x8 af[4], bf[4];
#pragma unroll
        for (int i = 0; i < 4; i++) af[i] = *(const bf16x8*)(a + i * 16 * LDT + ks * 32);
#pragma unroll
        for (int j = 0; j < 4; j++) bf[j] = *(const bf16x8*)(b + j * 16 * LDT + ks * 32);
#pragma unroll
        for (int i = 0; i < 4; i++)
#pragma unroll
          for (int j = 0; j < 4; j++) acc[i][j] = __builtin_amdgcn_mfma_f32_16x16x32_bf16(af[i], bf[j], acc[i][j], 0, 0, 0);
      }
      if (it + 1 < 24) MG_STORE(cur ^ 1);
      if (kk == 7) {
#pragma unroll
        for (int i = 0; i < 4; i++)
#pragma unroll
          for (int j = 0; j < 4; j++) {
            tot[i][j][0] += sigm(bf2f((u16)(gv[i][j][0] & 0xffff))) * acc[i][j][0];
            tot[i][j][1] += sigm(bf2f((u16)(gv[i][j][0] >> 16))) * acc[i][j][1];
            tot[i][j][2] += sigm(bf2f((u16)(gv[i][j][1] & 0xffff))) * acc[i][j][2];
            tot[i][j][3] += sigm(bf2f((u16)(gv[i][j][1] >> 16))) * acc[i][j][3];
            acc[i][j] = (f32x4){0.f, 0.f, 0.f, 0.f};
          }
      }
      __syncthreads();
    }
#pragma unroll
    for (int i = 0; i < 4; i++)
#pragma unroll
      for (int j = 0; j < 4; j++)
#pragma unroll
        for (int e = 0; e < 4; e++) {
          const int row = m0 + wr * 64 + i * 16 + fq * 4 + e, col = n0 + wc * 64 + j * 16 + fr;
          H[(size_t)row * 1024 + col] = f2bf(tot[i][j][e]);
        }
  }
}

__device__ __forceinline__ void merge_big_phase(u16* smem, const Params& p) {
  const u16* z = (const u16*)(p.ws + WS_Z);
  const u16* wb = (const u16*)(p.ws + WS_WB) + WB_BR;
  const u16* ru = (const u16*)(p.ws + WS_RU);
  u16* H = (u16*)(p.ws + WS_H);
  const int NT = 8, MT = NTOK / BMB;
  OPAQUE_TID(tid);
  const int lane = tid & 63, wid = tid >> 6, wr = wid >> 1, wc = wid & 1, fr = lane & 15, fq = lane >> 4;
  for (int tile = blockIdx.x; tile < MT * NT; tile += gridDim.x) {
    int mt, nt;
    tile_coords(tile, NT, mt, nt);
    const int m0 = mt * BMB, n0 = nt * 128;
    f32x4 acc[9][4];
#pragma unroll
    for (int i = 0; i < 9; i++)
#pragma unroll
      for (int j = 0; j < 4; j++) acc[i][j] = (f32x4){0.f, 0.f, 0.f, 0.f};
    const int gl_row = lane >> 2, gl_c = (lane & 3) ^ ((lane >> 4) & 3);
    const int pc = fq ^ (fr >> 2);
    const int uw = __builtin_amdgcn_readfirstlane(wid);
    const unsigned lds0 = (unsigned)__builtin_amdgcn_readfirstlane((int)(unsigned)(size_t)smem);
#define MB_STAGE(st_, it_) do { \
      const int sg_ = (it_) >> 4, kk_ = (it_) & 15; \
      const char* A_ = (const char*)((sg_ == 0) ? z + ZA_I : (sg_ == 1) ? ru : z + ZC_V); \
      const int lda_ = (sg_ == 1) ? 512 : ZS; \
      const char* B_ = (const char*)(wb + (size_t)sg_ * 1024 * 512); \
      const unsigned oA_ = ((unsigned)(m0 + gl_row) * (unsigned)lda_ + gl_c * 8 + kk_ * 32) * 2u; \
      const unsigned oB_ = ((unsigned)(n0 + gl_row) * 512u + gl_c * 8 + kk_ * 32) * 2u; \
      _Pragma("unroll") \
      for (int k_ = 0; k_ < 5; k_++) { \
        const int a_ = uw + 4 * k_; \
        if (a_ < 18) glds16(A_ + (oA_ + (unsigned)(16 * a_ * lda_) * 2u), lds0 + (unsigned)(((st_) * STGG + a_ * 512) * 2)); \
      } \
      _Pragma("unroll") \
      for (int k_ = 0; k_ < 2; k_++) { \
        const int b_ = uw + 4 * k_; \
        glds16(B_ + (oB_ + (unsigned)(16 * b_ * 512) * 2u), lds0 + (unsigned)(((st_) * STGG + 9216 + b_ * 512) * 2)); \
      } \
    } while (0)
#define MB_GSTRIP_LOAD(G_, i_) do { \
        int t_ = tid; asm volatile("" : "+v"(t_)); \
        const int ln_ = t_ & 63, wd_ = t_ >> 6; \
        _Pragma("unroll") \
        for (int h = 0; h < 2; h++) { \
          const int rr = h * 8 + (ln_ >> 3), cc = (ln_ & 7) * 8; \
          nv[h] = *(const u32x4*)(z + (size_t)(m0 + (wd_ >> 1) * 144 + (i_) * 16 + rr) * ZS + Z_MERGE + (G_) * 1024 + n0 + (wd_ & 1) * 64 + cc); \
        } \
      } while (0)
#define MB_GATE(G_, INV) do { \
      u32x4 nv[2]; \
      MB_GSTRIP_LOAD(G_, 0); \
      _Pragma("unroll") \
      for (int i = 0; i < 9; i++) { \
        int t_ = tid; asm volatile("" : "+v"(t_));     \
        const int ln_ = t_ & 63, wd_ = t_ >> 6, fr_ = ln_ & 15, fq_ = ln_ >> 4; \
        u16* scr_ = smem + 2 * STGG + wd_ * 16 * 72; \
        _Pragma("unroll") \
        for (int h = 0; h < 2; h++) { \
          const int rr = h * 8 + (ln_ >> 3), cc = (ln_ & 7) * 8; \
          *(u32x4*)(scr_ + rr * 72 + cc) = nv[h]; \
        } \
        if (i + 1 < 9) MB_GSTRIP_LOAD(G_, i + 1);     \
        _Pragma("unroll") \
        for (int j = 0; j < 4; j++) \
        _Pragma("unroll") \
          for (int e = 0; e < 4; e++) { \
            const float x_ = 1.f + __expf(-bf2f(scr_[(fq_ * 4 + e) * 72 + j * 16 + fr_])); \
            acc[i][j][e] *= (INV) ? x_ : __frcp_rn(x_); \
          } \
      } \
    } while (0)
    MB_STAGE(0, 0);
    asm volatile("s_waitcnt vmcnt(0)" ::: "memory");
    __syncthreads();
#pragma unroll 1
    for (int it = 0; it < 48; it++) {
      const int cur = it & 1;
      if (it + 1 < 48) MB_STAGE(cur ^ 1, it + 1);
      const u16* a = smem + cur * STGG + (wr * 144 + fr) * 32 + pc * 8;
      const u16* b = smem + cur * STGG + 9216 + (wc * 64 + fr) * 32 + pc * 8;
      bf16x8 bf[4], af[9];
#pragma unroll
      for (int j = 0; j < 4; j++) bf[j] = *(const bf16x8*)(b + j * 512);
#pragma unroll
      for (int i = 0; i < 9; i++) af[i] = *(const bf16x8*)(a + i * 512);
      __builtin_amdgcn_sched_barrier(0);
#pragma unroll
      for (int i = 0; i < 9; i++)
#pragma unroll
        for (int j = 0; j < 4; j++) acc[i][j] = __builtin_amdgcn_mfma_f32_16x16x32_bf16(af[i], bf[j], acc[i][j], 0, 0, 0);
      __builtin_amdgcn_sched_barrier(0);
      if ((it & 15) == 15) {
        const int sg = it >> 4, napply = (sg < 2) ? 2 : 1;
#pragma unroll 1
        for (int q = 0; q < napply; q++) { MB_GATE(sg + q, q); }
      }
      asm volatile("s_waitcnt vmcnt(0)" ::: "memory");
      __syncthreads();
    }
    {
#pragma unroll
      for (int i = 0; i < 9; i++) {
        int t_ = tid; asm volatile("" : "+v"(t_));
        const int ln_ = t_ & 63, wd_ = t_ >> 6, fr_ = ln_ & 15, fq_ = ln_ >> 4;
        u16* scr_ = smem + 2 * STGG + wd_ * 16 * 72;
#pragma unroll
        for (int j = 0; j < 4; j++)
#pragma unroll
          for (int e = 0; e < 4; e++) scr_[(fq_ * 4 + e) * 72 + j * 16 + fr_] = f2bf(acc[i][j][e]);
#pragma unroll
        for (int h = 0; h < 2; h++) {
          const int rr = h * 8 + (ln_ >> 3), cc = (ln_ & 7) * 8;
          const u32x4 v = *(const u32x4*)(scr_ + rr * 72 + cc);
          *(u32x4*)(H + (size_t)(m0 + (wd_ >> 1) * 144 + i * 16 + rr) * 1024 + n0 + (wd_ & 1) * 64 + cc) = v;
        }
      }
    }
  }
}

__device__ __forceinline__ void conv_w_tile(float* sm, const float* __restrict__ W, int K, int N, u16* Wt, int kt, int nt) {
  OPAQUE_TID(tid);
  const int lane = tid & 63, wid = tid >> 6;
  const int n = nt * 64 + lane;
#pragma unroll
  for (int i = 0; i < 16; i++) {
    const int k = wid * 16 + i;
    sm[lane * 65 + k] = (n < N) ? W[(size_t)(kt * 64 + k) * N + n] : 0.f;
  }
  __syncthreads();
  const int nn = tid >> 2, ks = (tid & 3) * 16;
  const float* s = sm + nn * 65 + ks;
  uint4 o0, o1;
  o0.x = pack2(s[0], s[1]); o0.y = pack2(s[2], s[3]); o0.z = pack2(s[4], s[5]); o0.w = pack2(s[6], s[7]);
  o1.x = pack2(s[8], s[9]); o1.y = pack2(s[10], s[11]); o1.z = pack2(s[12], s[13]); o1.w = pack2(s[14], s[15]);
  u16* dst = Wt + (size_t)(nt * 64 + nn) * K + kt * 64 + ks;
  *(uint4*)dst = o0;
  *(uint4*)(dst + 8) = o1;
  __syncthreads();
}

__device__ __forceinline__ void wconv_phase(u16* smem, const Params& p, int l) {
  float* sm = (float*)smem;
  u16* wb = (u16*)(p.ws + WS_WB);
  const int total = 2080 + 384 + 256 + 1024 + 1024;
  for (int t = blockIdx.x; t < total; t += gridDim.x) {
    const float* src; u16* dst; int K, N, kt, nt;
    if (t < 2080) {
      src = opq(p.w_in) + (size_t)l * 1024 * DIN; K = 1024; N = DIN; dst = wb + WB_IN; kt = t / 130; nt = t % 130;
    } else if (t < 2080 + 384) {
      const int u = t - 2080, br = u / 128, v = u % 128;
      src = (br == 0 ? opq(p.w_br_a) : br == 1 ? opq(p.w_br_b) : opq(p.w_br_c)) + (size_t)l * 512 * 1024;
      K = 512; N = 1024; dst = wb + WB_BR + (size_t)br * 1024 * 512; kt = v / 16; nt = v % 16;
    } else if (t < 2080 + 384 + 256) {
      const int u = t - 2464;
      src = opq(p.w_out) + (size_t)l * 1024 * 1024; K = 1024; N = 1024; dst = wb + WB_OUT; kt = u / 16; nt = u % 16;
    } else if (t < 2080 + 384 + 256 + 1024) {
      const int u = t - 2720;
      src = opq(p.w_up) + (size_t)l * 1024 * 4096; K = 1024; N = 4096; dst = wb + WB_UP; kt = u / 64; nt = u % 64;
    } else {
      const int u = t - 3744;
      src = opq(p.w_down) + (size_t)l * 4096 * 1024; K = 4096; N = 1024; dst = wb + WB_DN; kt = u / 16; nt = u % 16;
    }
    conv_w_tile(sm, src, K, N, dst, kt, nt);
  }
}

__device__ __forceinline__ float wave_sum(float v) {
#pragma unroll
  for (int o = 32; o >= 1; o >>= 1) v += __shfl_xor(v, o);
  return v;
}

__device__ __forceinline__ void rowpass_phase(const Params& p, bool from_input, const u16* Y, const float* postw, const float* prew, u16* H) {
  OPAQUE_TID(tid);
  const int lane = tid & 63, wid = tid >> 6;
  const float* xpr = opq(p.x_prompt); const float* xsa = opq(p.x_sample); const float* xo = opq((const float*)p.out);
  const int stride = gridDim.x * 4;
  for (int row0 = blockIdx.x * 4 + wid; row0 < NTOK; row0 += 3 * stride) {
    float xv[3][16], yv[3][16];
#pragma unroll
    for (int k = 0; k < 3; k++) {
      const int row = min(row0 + k * stride, NTOK - 1);
      const float* xin = from_input ? (row < TP ? xpr + (size_t)row * D : xsa + (size_t)(row - TP) * D) : xo + (size_t)row * D;
#pragma unroll
      for (int i = 0; i < 4; i++) {
        const float4 v = *(const float4*)(xin + lane * 4 + i * 256);
        xv[k][i * 4] = v.x; xv[k][i * 4 + 1] = v.y; xv[k][i * 4 + 2] = v.z; xv[k][i * 4 + 3] = v.w;
      }
      if (Y) {
#pragma unroll
        for (int i = 0; i < 4; i++) {
          const uint2 v = *(const uint2*)(Y + (size_t)row * D + lane * 4 + i * 256);
          yv[k][i * 4] = bf2f((u16)(v.x & 0xffff)); yv[k][i * 4 + 1] = bf2f((u16)(v.x >> 16));
          yv[k][i * 4 + 2] = bf2f((u16)(v.y & 0xffff)); yv[k][i * 4 + 3] = bf2f((u16)(v.y >> 16));
        }
      }
    }
#pragma unroll
    for (int k = 0; k < 3; k++) {
      const int row = row0 + k * stride;
      if (row < NTOK) {
        if (Y) {
          float ss = 0.f;
#pragma unroll
          for (int i = 0; i < 16; i++) ss += yv[k][i] * yv[k][i];
          ss = wave_sum(ss);
          const float r = rsqrtf(ss * (1.f / D) + EPS);
#pragma unroll
          for (int i = 0; i < 4; i++) {
            const float4 w = *(const float4*)(postw + lane * 4 + i * 256);
            xv[k][i * 4] += yv[k][i * 4] * r * w.x; xv[k][i * 4 + 1] += yv[k][i * 4 + 1] * r * w.y;
            xv[k][i * 4 + 2] += yv[k][i * 4 + 2] * r * w.z; xv[k][i * 4 + 3] += yv[k][i * 4 + 3] * r * w.w;
          }
        }
        if (Y || from_input) {
#pragma unroll
          for (int i = 0; i < 4; i++)
            __builtin_nontemporal_store((f32x4){xv[k][i * 4], xv[k][i * 4 + 1], xv[k][i * 4 + 2], xv[k][i * 4 + 3]},
                                        (f32x4*)(p.out + (size_t)row * D + lane * 4 + i * 256));
        }
        if (prew) {
          float ss = 0.f;
#pragma unroll
          for (int i = 0; i < 16; i++) ss += xv[k][i] * xv[k][i];
          ss = wave_sum(ss);
          const float r = rsqrtf(ss * (1.f / D) + EPS);
#pragma unroll
          for (int i = 0; i < 4; i++) {
            const float4 w = *(const float4*)(prew + lane * 4 + i * 256);
            uint2 o;
            o.x = pack2(xv[k][i * 4] * r * w.x, xv[k][i * 4 + 1] * r * w.y);
            o.y = pack2(xv[k][i * 4 + 2] * r * w.z, xv[k][i * 4 + 3] * r * w.w);
            *(uint2*)(H + (size_t)row * D + lane * 4 + i * 256) = o;
          }
        }
      }
    }
  }
}

__device__ __forceinline__ void hgrn_prep(u16* smem, const Params& p, int l, int c, int hd) {
  u16* z = (u16*)(p.ws + WS_Z);
  u16* sq = smem;
  u16* skt = smem + 64 * 136;
  u16* skh = smem + 2 * 64 * 136;
  float* sd = (float*)(smem + 3 * 64 * 136);
  OPAQUE_TID(tid);
  const int lane = tid & 63, wid = tid >> 6, fr = lane & 15, fq = lane >> 4;
  const int tok0 = c * 64;
  {
    const int hb = tid >> 7, ch = tid & 127, col = hd * 128 + ch;
    float lbv = 0.f;
    if (l > 0) {
      const float r0 = p.lb_raw[col], r1 = p.lb_raw[512 + col], r2 = p.lb_raw[1024 + col], r3 = p.lb_raw[1536 + col];
      const float m = fmaxf(fmaxf(r0, r1), fmaxf(r2, r3));
      const float e0 = __expf(r0 - m), e1 = __expf(r1 - m), e2 = __expf(r2 - m), e3 = __expf(r3 - m);
      const float inv = 1.f / (e0 + e1 + e2 + e3);
      lbv = e1 * inv;
      if (l > 1) lbv += e2 * inv;
      if (l > 2) lbv += e3 * inv;
    }
    {
      u32x4 rq[4], rf[4];
#pragma unroll
      for (int i = 0; i < 4; i++) {
        const int idx = tid + i * 256, row = idx >> 4, c8 = (idx & 15) * 8;
        rq[i] = *(const u32x4*)(z + (size_t)(tok0 + row) * ZS + ZA_Q + hd * 128 + c8);
        rf[i] = *(const u32x4*)(z + (size_t)(tok0 + row) * ZS + ZA_F + hd * 128 + c8);
      }
#pragma unroll
      for (int i = 0; i < 4; i++) {
        const int idx = tid + i * 256, row = idx >> 4, c8 = (idx & 15) * 8;
        *(u32x4*)(sq + row * 136 + c8) = rq[i];
        *(u32x4*)(skt + row * 136 + c8) = rf[i];
      }
    }
    __syncthreads();
    float bb[32];
    float run = 0.f;
#pragma unroll
    for (int t = 0; t < 32; t++) {
      const float zf = bf2f(skt[(hb * 32 + t) * 136 + ch]);
      const float f = lbv + (1.f - lbv) * sigm(zf);
      const float logf = (lbv > 0.f) ? __logf(f) : (fminf(zf, 0.f) - __logf(1.f + __expf(-fabsf(zf))));
      run += logf;
      bb[t] = run;
    }
    const float blast = run;
#pragma unroll
    for (int t = 0; t < 32; t++) {
      const int o = (hb * 32 + t) * 136 + ch;
      const float zq = bf2f(sq[o]), zf = bf2f(skt[o]);
      const float qv = silu(zq), kv = (1.f - lbv) * sigm(-zf);
      sq[o] = f2bf(qv * __expf(bb[t]));
      skt[o] = f2bf(kv * __expf(fminf(-bb[t], 80.f)));
      skh[o] = f2bf(kv * __expf(blast - bb[t]));
    }
    sd[hb * 128 + ch] = __expf(blast);
  }
  __syncthreads();
  {
    u16* qk = (u16*)(p.ws + WS_HQK);
    const int ti = wid;
    for (int si = 0; si < 4; si++) {
      f32x4 acc = (f32x4){0.f, 0.f, 0.f, 0.f};
      const bool upper = (ti < 2 && si >= 2);
      const bool cross = (ti >= 2 && si < 2);
      if (!upper && !((ti >> 1) == (si >> 1) && si > ti))
        acc = mma_lds_<128>(lane, sq + ti * 16 * 136, 136, (cross ? skh : skt) + si * 16 * 136, 136, acc);
#pragma unroll
      for (int e = 0; e < 4; e++) {
        const int t = ti * 16 + fq * 4 + e, s = si * 16 + fr;
        float v = acc[e];
        if (!cross && s > t) v = 0.f;
        qk[(size_t)(tok0 + t) * 256 + hd * 64 + s] = f2bf(v);
      }
    }
  }
  {
#pragma unroll 4
    for (int i = 0; i < 32; i++) {
      const int e = tid + i * 256, t = e >> 7, ch = e & 127;
      float v = bf2f(sq[t * 136 + ch]);
      if (t >= 32) v *= sd[ch];
      z[(size_t)(tok0 + t) * ZS + ZA_Q + hd * 128 + ch] = f2bf(v);
    }
    u16* kpt = (u16*)(p.ws + WS_HKPT) + (size_t)(c * 4 + hd) * 128 * 64;
#pragma unroll 4
    for (int i = 0; i < 32; i++) {
      const int e = tid + i * 256, dk = e >> 6, t = e & 63;
      float v = bf2f(skh[t * 136 + dk]);
      if (t < 32) v *= sd[128 + dk];
      kpt[dk * 64 + t] = f2bf(v);
    }
    if (tid < 128) ((float*)(p.ws + WS_HDA))[c * 512 + hd * 128 + tid] = sd[tid] * sd[128 + tid];
  }
  __syncthreads();
}

__device__ __forceinline__ void gdn_prep(u16* smem, const Params& p, int l, int c, int hd) {
  const u16* z = (const u16*)(p.ws + WS_Z);
  u16* sq = smem;
  u16* sk = smem + 64 * 136;
  u16* sv = smem + 2 * 64 * 136;
  float* sAm = (float*)(smem + 3 * 64 * 136);
  float* sgc = sAm + 64 * 68;
  float* sbeta = sgc + 64;
  OPAQUE_TID(tid);
  const int lane = tid & 63, wid = tid >> 6, fr = lane & 15, fq = lane >> 4;
  const int tok0 = c * 64;
  const bool first = (c == 0) || (c >= 256);
  const int sb = c - 256;
  u16* sraw = (u16*)sAm;
  u32x4 rraw[3][5];
#pragma unroll
  for (int part = 0; part < 3; part++)
#pragma unroll
    for (int i = 0; i < 5; i++) {
      const int idx = tid + i * 256, row = idx >> 4, c8 = (idx & 15) * 8, rr = row - 3;
      const int colq = part * 512 + hd * 128 + c8;
      u32x4 v = (u32x4){0u, 0u, 0u, 0u};
      if (idx < 67 * 16) {
        if (rr >= 0 || !first) {
          v = *(const u32x4*)(z + (size_t)(tok0 + rr) * ZS + ZC_Q + colq);
        } else if (c >= 256) {
          const float* st = p.st_gdn_conv + ((size_t)(l * 32 + sb) * 3 + row) * 1536 + colq;
          const float4 f0 = *(const float4*)st, f1 = *(const float4*)(st + 4);
          v = (u32x4){pack2(f0.x, f0.y), pack2(f0.z, f0.w), pack2(f1.x, f1.y), pack2(f1.z, f1.w)};
        }
      }
      rraw[part][i] = v;
    }
#pragma unroll
  for (int part = 0; part < 3; part++) {
    if (part > 0) __syncthreads();
#pragma unroll
    for (int i = 0; i < 5; i++) {
      const int idx = tid + i * 256, row = idx >> 4, c8 = (idx & 15) * 8;
      if (idx < 67 * 16) *(u32x4*)(sraw + row * 136 + c8) = rraw[part][i];
    }
    __syncthreads();
    {
      const int cc = tid & 127, half = tid >> 7, colq = part * 512 + hd * 128 + cc;
      const float* cw = p.c_conv_w + (size_t)l * 4 * 1536 + colq;
      const float w0 = cw[0], w1 = cw[1536], w2 = cw[2 * 1536], w3 = cw[3 * 1536];
      const u16* src = sraw + (half * 32) * 136 + cc;
      u16* dst = smem + part * 64 * 136 + (half * 32) * 136 + cc;
      float x0 = bf2f(src[0]), x1 = bf2f(src[136]), x2 = bf2f(src[2 * 136]);
#pragma unroll 8
      for (int t = 0; t < 32; t++) {
        const float x3 = bf2f(src[(t + 3) * 136]);
        const float y = w0 * x0 + w1 * x1 + w2 * x2 + w3 * x3;
        dst[t * 136] = f2bf(silu(y));
        x0 = x1; x1 = x2; x2 = x3;
      }
      if ((c == 255 || c >= 256) && half == 0) {
        float* dsto = (c == 255) ? p.out + O_PGC + (size_t)l * 3 * 1536 : p.out + O_SGC + (size_t)(l * 32 + sb) * 3 * 1536;
#pragma unroll
        for (int j = 0; j < 3; j++) dsto[j * 1536 + colq] = bf2f(sraw[(64 + j) * 136 + cc]);
      }
    }
  }
  __syncthreads();
  {
    const int t = tid >> 2, qd = tid & 3;
#pragma unroll
    for (int part = 0; part < 2; part++) {
      u16* r = smem + part * 64 * 136 + t * 136 + qd * 32;
      float ss = 0.f;
#pragma unroll
      for (int i = 0; i < 32; i++) { const float v = bf2f(r[i]); ss += v * v; }
      ss += __shfl_xor(ss, 1);
      ss += __shfl_xor(ss, 2);
      const float sc = rsqrtf(ss + EPS) * (part == 0 ? 0.08838834764831845f : 1.f);
#pragma unroll
      for (int i = 0; i < 32; i++) r[i] = f2bf(bf2f(r[i]) * sc);
    }
  }
  if (tid < 64) {
    const float beta = sigm(bf2f(z[(size_t)(tok0 + tid) * ZS + ZC_BETA + hd]));
    const float al = bf2f(z[(size_t)(tok0 + tid) * ZS + ZC_ALPHA + hd]);
    float g = -__expf(p.c_a_log[l * 4 + hd]) * softplus(al + p.c_dt_bias[l * 4 + hd]);
#pragma unroll
    for (int o = 1; o < 64; o <<= 1) {
      const float v = __shfl_up(g, o);
      if (lane >= o) g += v;
    }
    sgc[tid] = g;
    sbeta[tid] = beta;
  }
  __syncthreads();
  {
    u16* gqk = (u16*)(p.ws + WS_G) + G_QK;
    const int ti = wid;
    for (int si = 0; si < 4; si++) {
      f32x4 a1 = (f32x4){0.f, 0.f, 0.f, 0.f}, a2 = (f32x4){0.f, 0.f, 0.f, 0.f};
      if (si <= ti) {
        a1 = mma_lds_<128>(lane, sk + ti * 16 * 136, 136, sk + si * 16 * 136, 136, a1);
        a2 = mma_lds_<128>(lane, sq + ti * 16 * 136, 136, sk + si * 16 * 136, 136, a2);
      }
#pragma unroll
      for (int e = 0; e < 4; e++) {
        const int t = ti * 16 + fq * 4 + e, s = si * 16 + fr;
        const float dec = (s <= t) ? __expf(sgc[t] - sgc[s]) : 0.f;
        sAm[s * 68 + t] = (s < t) ? sbeta[t] * a1[e] * dec : 0.f;
        gqk[(size_t)(tok0 + t) * 256 + hd * 64 + s] = f2bf((s <= t) ? a2[e] * dec : 0.f);
      }
    }
  }
  __syncthreads();
  {
    const int col = tid & 127, isw = tid >> 7;
    const u16* src = isw ? sk : sv;
    u16* dst = (u16*)(p.ws + WS_G) + (isw ? G_W : G_U) + (size_t)tok0 * 512 + hd * 128 + col;
    float r[64];
#pragma unroll
    for (int t = 0; t < 64; t++) {
      float a = bf2f(src[t * 136 + col]) * sbeta[t];
      if (isw) a *= __expf(sgc[t]);
      r[t] = a;
    }
#pragma unroll
    for (int j = 0; j < 64; j++) {
      const float xj = r[j];
      *dst = f2bf(xj);
      dst += 512;
#pragma unroll
      for (int g = (j + 1) / 4; g < 16; g++) {
        const float4 a4 = *(const float4*)(sAm + j * 68 + g * 4);
        if (g * 4 > j) r[g * 4] -= a4.x * xj;
        if (g * 4 + 1 > j) r[g * 4 + 1] -= a4.y * xj;
        if (g * 4 + 2 > j) r[g * 4 + 2] -= a4.z * xj;
        if (g * 4 + 3 > j) r[g * 4 + 3] -= a4.w * xj;
      }
    }
  }
  {
    u16* gqp = (u16*)(p.ws + WS_G) + G_QP;
    const float gl = sgc[63];
#pragma unroll 4
    for (int i = 0; i < 32; i++) {
      const int e = tid + i * 256, t = e >> 7, cc = e & 127;
      gqp[(size_t)(tok0 + t) * 512 + hd * 128 + cc] = f2bf(bf2f(sq[t * 136 + cc]) * __expf(sgc[t]));
    }
    u16* kpt = (u16*)(p.ws + WS_G) + G_KPT + (size_t)(c * 4 + hd) * 128 * 64;
#pragma unroll 4
    for (int i = 0; i < 32; i++) {
      const int e = tid + i * 256, dk = e >> 6, t = e & 63;
      kpt[dk * 64 + t] = f2bf(bf2f(sk[t * 136 + dk]) * __expf(gl - sgc[t]));
    }
    if (tid == 0) ((float*)(p.ws + WS_GGL))[c * 4 + hd] = __expf(gl);
  }
  __syncthreads();
}

__device__ __forceinline__ void rglru_prep(u16* smem, const Params& p, int l, int c, int n) {
  const u16* z = (const u16*)(p.ws + WS_Z);
  float* sx = (float*)smem;
  float* su = sx + 64 * 65;
  u16* sxb = (u16*)(su + 64 * 65);
  u16* swa = sxb + 64 * 72;
  u16* swx = swa + 64 * 72;
  OPAQUE_TID(tid);
  const int lane = tid & 63, wid = tid >> 6, fr = lane & 15, fq = lane >> 4;
  const int tok0 = c * 64;
  const bool first = (c == 0) || (c >= 256);
  const int sb = c - 256;
  {
    const int ch = tid & 63, tq = tid >> 6, col = n * 64 + ch;
    const float* cw = p.b_conv_w + (size_t)l * 4 * 512 + col;
    const float w0 = cw[0], w1 = cw[512], w2 = cw[1024], w3 = cw[1536], bias = p.b_conv_b[l * 512 + col];
    u16* sraw = swx + 64 * 72;
    {
      u32x4 rr4[3];
#pragma unroll
      for (int i = 0; i < 3; i++) {
        const int idx = tid + i * 256, row = idx >> 3, c8 = (idx & 7) * 8, rr = row - 3;
        u32x4 v = (u32x4){0u, 0u, 0u, 0u};
        if (idx < 67 * 8) {
          if (rr >= 0 || !first) {
            v = *(const u32x4*)(z + (size_t)(tok0 + rr) * ZS + ZB_X + n * 64 + c8);
          } else if (c >= 256) {
            const float* st = p.st_rglru_conv + ((size_t)(l * 32 + sb) * 3 + row) * 512 + n * 64 + c8;
            const float4 f0 = *(const float4*)st, f1 = *(const float4*)(st + 4);
            v = (u32x4){pack2(f0.x, f0.y), pack2(f0.z, f0.w), pack2(f1.x, f1.y), pack2(f1.z, f1.w)};
          }
        }
        rr4[i] = v;
      }
#pragma unroll
      for (int i = 0; i < 3; i++) {
        const int idx = tid + i * 256, row = idx >> 3, c8 = (idx & 7) * 8;
        if (idx < 67 * 8) *(u32x4*)(sraw + row * 72 + c8) = rr4[i];
      }
    }
    __syncthreads();
    {
      const u16* src = sraw + (tq * 16) * 72 + ch;
      float x0 = bf2f(src[0]), x1 = bf2f(src[72]), x2 = bf2f(src[2 * 72]);
#pragma unroll 8
      for (int i = 0; i < 16; i++) {
        const int t = tq * 16 + i;
        const float x3 = bf2f(src[(i + 3) * 72]);
        const float y = w0 * x0 + w1 * x1 + w2 * x2 + w3 * x3 + bias;
        sx[t * 65 + ch] = y;
        sxb[t * 72 + ch] = f2bf(y);
        x0 = x1; x1 = x2; x2 = x3;
      }
    }
    const float* wa = p.b_ga_w + ((size_t)l * 8 + n) * 4096;
    const float* wx = p.b_gx_w + ((size_t)l * 8 + n) * 4096;
#pragma unroll
    for (int i = 0; i < 16; i++) {
      const int e = tid + i * 256, cin = e >> 6, d = e & 63;
      swa[d * 72 + cin] = f2bf(wa[e]);
      swx[d * 72 + cin] = f2bf(wx[e]);
    }
    if (c == 255 || c >= 256) {
      float* dst = (c == 255) ? p.out + O_PRC + (size_t)l * 3 * 512 : p.out + O_SRC + (size_t)(l * 32 + sb) * 3 * 512;
      if (tid < 192) {
        const int j = tid >> 6;
        dst[j * 512 + col] = bf2f(sraw[(64 + j) * 72 + ch]);
      }
    }
  }
  __syncthreads();
  f32x4 ra[4], rx[4];
  {
    const int ti = wid;
#pragma unroll
    for (int si = 0; si < 4; si++) {
      ra[si] = mma_lds_<64>(lane, sxb + ti * 16 * 72, 72, swa + si * 16 * 72, 72, (f32x4){0.f, 0.f, 0.f, 0.f});
      rx[si] = mma_lds_<64>(lane, sxb + ti * 16 * 72, 72, swx + si * 16 * 72, 72, (f32x4){0.f, 0.f, 0.f, 0.f});
    }
  }
  float lav[4][4], uv[4][4];
  {
    const int ti = wid;
#pragma unroll
    for (int si = 0; si < 4; si++) {
      const int d = si * 16 + fr, col = n * 64 + d;
      const float ba = p.b_ga_b[l * 512 + col], bx = p.b_gx_b[l * 512 + col];
      const float sp = softplus(-p.b_lambda[l * 512 + col]);
#pragma unroll
      for (int e = 0; e < 4; e++) {
        const int t = ti * 16 + fq * 4 + e;
        const float r = sigm(ra[si][e] + ba), ig = sigm(rx[si][e] + bx);
        const float la = -8.f * r * sp;
        float mult = sqrtf(fmaxf(1.f - __expf(2.f * la), 0.f));
        if (c == 0 && t == 0) mult = 1.f;
        const float u = mult * ig * sx[t * 65 + d];
        lav[si][e] = bf2f(f2bf(la));
        uv[si][e] = bf2f(f2bf(u));
      }
    }
  }
  __syncthreads();
  {
    const int ti = wid;
    u16* rla = (u16*)(p.ws + WS_RLA);
    u16* ru = (u16*)(p.ws + WS_RU);
#pragma unroll
    for (int si = 0; si < 4; si++) {
      const int d = si * 16 + fr, col = n * 64 + d;
#pragma unroll
      for (int e = 0; e < 4; e++) {
        const int t = ti * 16 + fq * 4 + e;
        sx[t * 65 + d] = lav[si][e];
        su[t * 65 + d] = uv[si][e];
        rla[(size_t)(tok0 + t) * 512 + col] = f2bf(lav[si][e]);
        ru[(size_t)(tok0 + t) * 512 + col] = f2bf(uv[si][e]);
      }
    }
  }
  __syncthreads();
  if (tid < 64) {
    float h = 0.f, sl = 0.f;
    for (int t = 0; t < 64; t++) {
      const float la = sx[t * 65 + tid];
      h = __expf(la) * h + su[t * 65 + tid];
      sl += la;
    }
    float* agg = (float*)(p.ws + WS_RAGG) + ((size_t)c * 512 + n * 64 + tid) * 2;
    agg[0] = sl;
    agg[1] = h;
  }
  __syncthreads();
}

__device__ __forceinline__ void rglru_scan(const Params& p, int l, int c, int hf) {
  OPAQUE_TID(tid);
  const int col = hf * 256 + tid;
  const int tok0 = c * 64;
  float h = 0.f;
  if (c >= 256) {
    h = p.st_rglru[(size_t)(l * 32 + (c - 256)) * 512 + col];
  } else {
    const float* agg = (const float*)(p.ws + WS_RAGG) + (size_t)col * 2;
    for (int cc = 0; cc < c; cc += 16) {
      float2 ab[16];
#pragma unroll
      for (int i = 0; i < 16; i++) ab[i] = *(const float2*)(agg + (size_t)min(cc + i, c - 1) * 1024);
#pragma unroll
      for (int i = 0; i < 16; i++) if (cc + i < c) h = __expf(ab[i].x) * h + ab[i].y;
    }
  }
  const u16* rla = (const u16*)(p.ws + WS_RLA) + (size_t)tok0 * 512 + col;
  u16* ru = (u16*)(p.ws + WS_RU) + (size_t)tok0 * 512 + col;
  for (int t0 = 0; t0 < 64; t0 += 32) {
    float la[32], u[32];
#pragma unroll
    for (int i = 0; i < 32; i++) { la[i] = bf2f(rla[(size_t)(t0 + i) * 512]); u[i] = bf2f(ru[(size_t)(t0 + i) * 512]); }
#pragma unroll
    for (int i = 0; i < 32; i++) {
      h = __expf(la[i]) * h + u[i];
      ru[(size_t)(t0 + i) * 512] = f2bf(h);
    }
  }
  if (c == 255) p.out[O_PR + (size_t)l * 512 + col] = h;
  else if (c >= 256) p.out[O_SR + (size_t)(l * 32 + (c - 256)) * 512 + col] = h;
}

template <bool GDN>
__device__ __forceinline__ void mat_scan(u16* smem, const Params& p, int l, int kind, int seg, int seq, int hd, int sl) {
  u16* z = (u16*)(p.ws + WS_Z);
  u16* sW = smem;
  u16* sQP = smem + 64 * 136;
  u16* sKT = smem + 2 * 64 * 136;
  u16* sQK = sKT + 128 * 72;
  u16* sSt = sQK + 64 * 72;
  u16* sVt = sSt + 32 * 136;
  OPAQUE_TID(tid);
  const int lane = tid & 63, wid = tid >> 6, fr = lane & 15, fq = lane >> 4;
  const int nchunk = (kind == 0) ? 1 : 16;
  const int c0 = (kind == 0) ? 255 + seq : seg * 16;
  const int cg = sl & 3;
  const int dvc = cg * 32 + fr;
  const bool full = (kind != 1);
  const bool uzero = (kind == 1 && sl >= 4);
  const int r16 = tid >> 4, c16 = (tid & 15) * 8;
  const int r8 = tid >> 3, c8 = (tid & 7) * 8;
  f32x4 S[2][2];
  f32x4 Dacc[2];
  { float one_ = 1.f; asm volatile("" : "+v"(one_)); Dacc[0] = (f32x4){one_, one_, one_, one_}; Dacc[1] = Dacc[0]; }
  if (kind == 0) {
    const float* st = (GDN ? p.st_gdn : p.st_hgrn) + ((size_t)(l * 32 + (seq - 1)) * 4 + hd) * 16384;
#pragma unroll
    for (int i = 0; i < 2; i++)
#pragma unroll
      for (int n = 0; n < 2; n++)
#pragma unroll
        for (int e = 0; e < 4; e++) S[i][n][e] = st[((wid * 2 + i) * 16 + fq * 4 + e) * 128 + dvc + n * 16];
  } else if (kind == 1) {
#pragma unroll
    for (int i = 0; i < 2; i++)
#pragma unroll
      for (int n = 0; n < 2; n++)
#pragma unroll
        for (int e = 0; e < 4; e++)
          S[i][n][e] = (sl >= 4 && ((wid * 2 + i) * 16 + fq * 4 + e) == (sl - 4) * 32 + n * 16 + fr) ? 1.f : 0.f;
  } else {
#pragma unroll
    for (int i = 0; i < 2; i++)
#pragma unroll
      for (int n = 0; n < 2; n++) S[i][n] = (f32x4){0.f, 0.f, 0.f, 0.f};
    if (!GDN) {
      const float* hs = (const float*)(p.ws + WS_HS);
      const float* hdp = (const float*)(p.ws + WS_HD);
#pragma unroll 4
      for (int j = 0; j < seg; j++) {
        f32x4 dj[2], sj[2][2];
#pragma unroll
        for (int i = 0; i < 2; i++) {
          dj[i] = *(const f32x4*)(hdp + (size_t)(j * 4 + hd) * 128 + (wid * 2 + i) * 16 + fq * 4);
#pragma unroll
          for (int n = 0; n < 2; n++)
#pragma unroll
            for (int e = 0; e < 4; e++)
              sj[i][n][e] = hs[((size_t)(j * 4 + hd) * 128 + (wid * 2 + i) * 16 + fq * 4 + e) * 128 + dvc + n * 16];
        }
#pragma unroll
        for (int i = 0; i < 2; i++)
#pragma unroll
          for (int n = 0; n < 2; n++) S[i][n] = S[i][n] * dj[i] + sj[i][n];
      }
    } else {
      const float* gb = (const float*)(p.ws + WS_GB);
      const u16* gp = (const u16*)(p.ws + WS_GP);
      u16* sP = smem;
      u32x4 rP[8];
      if (seg > 1) {
#pragma unroll
        for (int i = 0; i < 8; i++) rP[i] = *(const u32x4*)(gp + ((size_t)(1 * 4 + hd) * 128 + r16 + i * 16) * 128 + c16);
      }
      f32x4 bn[2][2];
#pragma unroll
      for (int i = 0; i < 2; i++)
#pragma unroll
        for (int n = 0; n < 2; n++)
#pragma unroll
          for (int e = 0; e < 4; e++)
            bn[i][n][e] = gb[((size_t)(0 * 4 + hd) * 128 + (wid * 2 + i) * 16 + fq * 4 + e) * 128 + dvc + n * 16];
      for (int j = 0; j < seg; j++) {
        f32x4 bj[2][2];
#pragma unroll
        for (int i = 0; i < 2; i++)
#pragma unroll
          for (int n = 0; n < 2; n++) bj[i][n] = bn[i][n];
        if (j == 0) {
#pragma unroll
          for (int i = 0; i < 2; i++)
#pragma unroll
            for (int n = 0; n < 2; n++) S[i][n] = bj[i][n];
          if (seg > 1) {
#pragma unroll
            for (int i = 0; i < 2; i++)
#pragma unroll
              for (int n = 0; n < 2; n++)
#pragma unroll
                for (int e = 0; e < 4; e++)
                  bn[i][n][e] = gb[((size_t)(1 * 4 + hd) * 128 + (wid * 2 + i) * 16 + fq * 4 + e) * 128 + dvc + n * 16];
          }
        } else {
          __syncthreads();
#pragma unroll
          for (int i = 0; i < 8; i++) *(u32x4*)(sP + (r16 + i * 16) * 136 + c16) = rP[i];
#pragma unroll
          for (int i = 0; i < 2; i++)
#pragma unroll
            for (int n = 0; n < 2; n++) {
              uint2 o2;
              o2.x = pack2(S[i][n][0], S[i][n][1]);
              o2.y = pack2(S[i][n][2], S[i][n][3]);
              *(uint2*)(sSt + (n * 16 + fr) * 136 + (wid * 2 + i) * 16 + fq * 4) = o2;
            }
          __syncthreads();
          if (j + 1 < seg) {
#pragma unroll
            for (int i = 0; i < 8; i++) rP[i] = *(const u32x4*)(gp + ((size_t)((j + 1) * 4 + hd) * 128 + r16 + i * 16) * 128 + c16);
#pragma unroll
            for (int i = 0; i < 2; i++)
#pragma unroll
              for (int n = 0; n < 2; n++)
#pragma unroll
                for (int e = 0; e < 4; e++)
                  bn[i][n][e] = gb[((size_t)((j + 1) * 4 + hd) * 128 + (wid * 2 + i) * 16 + fq * 4 + e) * 128 + dvc + n * 16];
          }
#pragma unroll
          for (int i = 0; i < 2; i++)
#pragma unroll
            for (int n = 0; n < 2; n++)
              S[i][n] = mma_lds_<128>(lane, sP + (wid * 2 + i) * 16 * 136, 136, sSt + n * 16 * 136, 136, bj[i][n]);
        }
      }
    }
  }
  const u16* gQP = GDN ? (const u16*)(p.ws + WS_G) + G_QP + hd * 128 : z + ZA_Q + hd * 128;
  const int ldqp = GDN ? 512 : ZS;
  const u16* gKT = GDN ? (const u16*)(p.ws + WS_G) + G_KPT : (const u16*)(p.ws + WS_HKPT);
  const u16* gQK = (GDN ? (const u16*)(p.ws + WS_G) + G_QK : (const u16*)(p.ws + WS_HQK)) + hd * 64;
  const u16* gW = (const u16*)(p.ws + WS_G) + G_W + hd * 128;
  const u16* gU = (const u16*)(p.ws + WS_G) + G_U + hd * 128 + dvc;
  u16* gO = z + (GDN ? ZC_V : ZA_I) + hd * 128 + dvc;

  u32x4 rQP[2][4], rW[2][4], rKT[2][4], rQK[2][2];
  unsigned rV[2][8];
  f32x4 rDv[2][2];
  float rG[2];
#define LOAD_REGS(ST, cx) do { \
    const int c_ = (cx); \
    const size_t tk0_ = (size_t)c_ * 64; \
    _Pragma("unroll") \
    for (int i = 0; i < 4; i++) { \
      if (full) rQP[ST][i] = *(const u32x4*)(gQP + (tk0_ + r16 + i * 16) * ldqp + c16); \
      if (GDN) rW[ST][i] = *(const u32x4*)(gW + (tk0_ + r16 + i * 16) * 512 + c16); \
      rKT[ST][i] = *(const u32x4*)(gKT + ((size_t)(c_ * 4 + hd) * 128 + r8 + i * 32) * 64 + c8); \
    } \
    if (full) { \
    _Pragma("unroll") \
      for (int i = 0; i < 2; i++) rQK[ST][i] = *(const u32x4*)(gQK + (tk0_ + r8 + i * 32) * 256 + c8); \
    } \
    if (GDN) { \
    _Pragma("unroll") \
      for (int n = 0; n < 2; n++) \
    _Pragma("unroll") \
        for (int e = 0; e < 4; e++) rV[ST][n * 4 + e] = uzero ? 0u : (unsigned)gU[(tk0_ + wid * 16 + fq * 4 + e) * 512 + n * 16]; \
      rG[ST] = ((const float*)(p.ws + WS_GGL))[c_ * 4 + hd]; \
    } else { \
    _Pragma("unroll") \
      for (int i = 0; i < 8; i++) { \
        const int e = tid + i * 256; \
        rV[ST][i] = z[(tk0_ + (e >> 5)) * ZS + ZA_I + hd * 128 + cg * 32 + (e & 31)]; \
      } \
      const float* da = (const float*)(p.ws + WS_HDA) + (size_t)c_ * 512 + hd * 128; \
    _Pragma("unroll") \
      for (int i = 0; i < 2; i++) rDv[ST][i] = *(const f32x4*)(da + (wid * 2 + i) * 16 + fq * 4); \
    } \
  } while (0)
#define SCAN_STEP(ST, cix) do { \
    const int ci_ = (cix); \
    const int c = c0 + ci_; \
    const size_t tok0 = (size_t)c * 64; \
    __syncthreads(); \
    _Pragma("unroll") \
    for (int i = 0; i < 4; i++) { \
      if (full) *(u32x4*)(sQP + (r16 + i * 16) * 136 + c16) = rQP[ST][i]; \
      if (GDN) *(u32x4*)(sW + (r16 + i * 16) * 136 + c16) = rW[ST][i]; \
      *(u32x4*)(sKT + (r8 + i * 32) * 72 + c8) = rKT[ST][i]; \
    } \
    if (full) { \
    _Pragma("unroll") \
      for (int i = 0; i < 2; i++) *(u32x4*)(sQK + (r8 + i * 32) * 72 + c8) = rQK[ST][i]; \
    } \
    _Pragma("unroll") \
    for (int i = 0; i < 2; i++) \
    _Pragma("unroll") \
      for (int n = 0; n < 2; n++) { \
        uint2 o2; \
        o2.x = pack2(S[i][n][0], S[i][n][1]); \
        o2.y = pack2(S[i][n][2], S[i][n][3]); \
        *(uint2*)(sSt + (n * 16 + fr) * 136 + (wid * 2 + i) * 16 + fq * 4) = o2; \
      } \
    float uu[8]; \
    if (GDN) { \
    _Pragma("unroll") \
      for (int e = 0; e < 8; e++) uu[e] = bf2f((u16)rV[ST][e]); \
    } else { \
    _Pragma("unroll") \
      for (int i = 0; i < 8; i++) { \
        const int e = tid + i * 256; \
        sVt[(e & 31) * 72 + (e >> 5)] = (u16)rV[ST][i]; \
      } \
    } \
    __syncthreads(); \
    float g_ = 0.f; f32x4 dv0_, dv1_; \
    if (GDN) { g_ = rG[ST]; asm volatile("" : "+v"(g_), "+v"(uu[0]), "+v"(uu[1]), "+v"(uu[2]), "+v"(uu[3]), "+v"(uu[4]), "+v"(uu[5]), "+v"(uu[6]), "+v"(uu[7]) :: "memory"); } \
    else { dv0_ = rDv[ST][0]; dv1_ = rDv[ST][1]; asm volatile("" : "+v"(dv0_), "+v"(dv1_) :: "memory"); } \
    if (ci_ + 2 < nchunk) LOAD_REGS(ST, c + 2); \
    f32x4 o[2]; \
    o[0] = (f32x4){0.f, 0.f, 0.f, 0.f}; o[1] = o[0]; \
    if (full) { \
    _Pragma("unroll") \
      for (int n = 0; n < 2; n++) o[n] = mma_lds_<128>(lane, sQP + wid * 16 * 136, 136, sSt + n * 16 * 136, 136, o[n]); \
    } \
    if (GDN) { \
    _Pragma("unroll") \
      for (int n = 0; n < 2; n++) { \
        f32x4 a = mma_lds_<128>(lane, sW + wid * 16 * 136, 136, sSt + n * 16 * 136, 136, (f32x4){0.f, 0.f, 0.f, 0.f}); \
        uint2 ov; \
        ov.x = pack2(uu[n * 4 + 0] - a[0], uu[n * 4 + 1] - a[1]); \
        ov.y = pack2(uu[n * 4 + 2] - a[2], uu[n * 4 + 3] - a[3]); \
        *(uint2*)(sVt + (n * 16 + fr) * 72 + wid * 16 + fq * 4) = ov; \
      } \
      __syncthreads(); \
    } \
    if (full) { \
    _Pragma("unroll") \
      for (int n = 0; n < 2; n++) { \
        o[n] = mma_lds_<64>(lane, sQK + wid * 16 * 72, 72, sVt + n * 16 * 72, 72, o[n]); \
    _Pragma("unroll") \
        for (int e = 0; e < 4; e++) gO[(tok0 + wid * 16 + fq * 4 + e) * ZS + n * 16] = f2bf(o[n][e]); \
      } \
    } \
    if (GDN) { \
      const float gs_ = __int_as_float(__builtin_amdgcn_readfirstlane(__float_as_int(g_))); \
    _Pragma("unroll") \
      for (int i = 0; i < 2; i++) { S[i][0] *= gs_; S[i][1] *= gs_; } \
    } else { \
      S[0][0] *= dv0_; S[0][1] *= dv0_; S[1][0] *= dv1_; S[1][1] *= dv1_; \
      Dacc[0] *= dv0_; Dacc[1] *= dv1_; \
    } \
    _Pragma("unroll") \
    for (int i = 0; i < 2; i++) \
    _Pragma("unroll") \
      for (int n = 0; n < 2; n++) \
        S[i][n] = mma_lds_<64>(lane, sKT + (wid * 2 + i) * 16 * 72, 72, sVt + n * 16 * 72, 72, S[i][n]); \
  } while (0)
  __syncthreads();
  LOAD_REGS(0, c0);
  if (nchunk > 1) LOAD_REGS(1, c0 + 1);
  for (int ci = 0; ci < nchunk; ci += 2) {
    SCAN_STEP(0, ci);
    if (ci + 1 < nchunk) SCAN_STEP(1, ci + 1);
  }
  if (kind == 1) {
    if (GDN && sl >= 4) {
      u16* gp = (u16*)(p.ws + WS_GP) + (size_t)(seg * 4 + hd) * 16384;
#pragma unroll
      for (int i = 0; i < 2; i++)
#pragma unroll
        for (int n = 0; n < 2; n++)
#pragma unroll
          for (int e = 0; e < 4; e++) gp[((wid * 2 + i) * 16 + fq * 4 + e) * 128 + (sl - 4) * 32 + n * 16 + fr] = f2bf(S[i][n][e]);
    } else {
      float* dst = (float*)(p.ws + (GDN ? WS_GB : WS_HS)) + (size_t)(seg * 4 + hd) * 16384;
#pragma unroll
      for (int i = 0; i < 2; i++)
#pragma unroll
        for (int n = 0; n < 2; n++)
#pragma unroll
          for (int e = 0; e < 4; e++) dst[((wid * 2 + i) * 16 + fq * 4 + e) * 128 + dvc + n * 16] = S[i][n][e];
      if (!GDN && sl == 0 && fr == 0) {
        float* dd = (float*)(p.ws + WS_HD) + (size_t)(seg * 4 + hd) * 128;
#pragma unroll
        for (int i = 0; i < 2; i++) *(f32x4*)(dd + (wid * 2 + i) * 16 + fq * 4) = Dacc[i];
      }
    }
  } else if (kind == 0 || seg == 15) {
    float* dst;
    if (kind == 2) dst = p.out + (GDN ? O_PG : O_PH) + ((size_t)l * 4 + hd) * 16384;
    else dst = p.out + (GDN ? O_SG : O_SH) + ((size_t)(l * 32 + (seq - 1)) * 4 + hd) * 16384;
#pragma unroll
    for (int i = 0; i < 2; i++)
#pragma unroll
      for (int n = 0; n < 2; n++)
#pragma unroll
        for (int e = 0; e < 4; e++) dst[((wid * 2 + i) * 16 + fq * 4 + e) * 128 + dvc + n * 16] = S[i][n][e];
  }
  __syncthreads();
}

__device__ __forceinline__ void onorm_phase(const Params& p, int l) {
  u16* z = (u16*)(p.ws + WS_Z);
  u16* ru = (u16*)(p.ws + WS_RU);
  OPAQUE_TID(tid);
  const int lane = tid & 63, wid = tid >> 6;
  for (int row = blockIdx.x * 4 + wid; row < NTOK; row += gridDim.x * 4) {
    u16* zr = z + (size_t)row * ZS;
#pragma unroll
    for (int br = 0; br < 2; br++) {
      u16* po = zr + (br == 0 ? ZA_I : ZC_V) + lane * 8;
      const u16* pg = zr + (br == 0 ? ZA_G : ZC_G) + lane * 8;
      const float* nw = (br == 0 ? p.a_norm : p.c_norm) + l * 128 + (lane & 15) * 8;
      const uint4 vo = *(const uint4*)po, vg = *(const uint4*)pg;
      const unsigned uo[4] = {vo.x, vo.y, vo.z, vo.w}, ug[4] = {vg.x, vg.y, vg.z, vg.w};
      float o[8], g[8];
#pragma unroll
      for (int i = 0; i < 4; i++) {
        o[2 * i] = bf2f((u16)(uo[i] & 0xffff)); o[2 * i + 1] = bf2f((u16)(uo[i] >> 16));
        g[2 * i] = bf2f((u16)(ug[i] & 0xffff)); g[2 * i + 1] = bf2f((u16)(ug[i] >> 16));
      }
      float ss = 0.f;
#pragma unroll
      for (int i = 0; i < 8; i++) ss += o[i] * o[i];
      ss += __shfl_xor(ss, 1); ss += __shfl_xor(ss, 2); ss += __shfl_xor(ss, 4); ss += __shfl_xor(ss, 8);
      const float r = rsqrtf(ss * (1.f / 128.f) + EPS);
      unsigned res[4];
#pragma unroll
      for (int i = 0; i < 4; i++)
        res[i] = pack2(o[2 * i] * r * nw[2 * i] * silu(g[2 * i]), o[2 * i + 1] * r * nw[2 * i + 1] * silu(g[2 * i + 1]));
      *(uint4*)po = make_uint4(res[0], res[1], res[2], res[3]);
    }
    {
      u16* ph = ru + (size_t)row * 512 + lane * 8;
      const u16* pg = zr + ZB_G + lane * 8;
      const uint4 vo = *(const uint4*)ph, vg = *(const uint4*)pg;
      const unsigned uo[4] = {vo.x, vo.y, vo.z, vo.w}, ug[4] = {vg.x, vg.y, vg.z, vg.w};
      unsigned res[4];
#pragma unroll
      for (int i = 0; i < 4; i++) {
        const float h0 = bf2f((u16)(uo[i] & 0xffff)), h1 = bf2f((u16)(uo[i] >> 16));
        const float g0 = bf2f((u16)(ug[i] & 0xffff)), g1 = bf2f((u16)(ug[i] >> 16));
        res[i] = pack2(gelu_t(g0) * h0, gelu_t(g1) * h1);
      }
      *(uint4*)ph = make_uint4(res[0], res[1], res[2], res[3]);
    }
  }
}

__device__ __forceinline__ void prep_phase(u16* smem, const Params& p, int l, bool dup) {
  for (int t = blockIdx.x; t < 4608; t += gridDim.x) {
    if (t < 1152) gdn_prep(smem, p, l, t >> 2, t & 3);
    else if (t < 2304) { if (!dup) hgrn_prep(smem, p, l, (t - 1152) >> 2, (t - 1152) & 3); }
    else rglru_prep(smem, p, l, (t - 2304) >> 3, (t - 2304) & 7);
  }
}

__device__ __forceinline__ void scan_phase(u16* smem, const Params& p, int l, int pass) {
  const int ntask = pass ? 512 : (720 + 576 + 1024);
  for (int t = blockIdx.x; t < ntask; t += gridDim.x) {
    bool isg; int kind, seg = 0, seq = 0, hd, sl;
    if (pass) {
      kind = 2;
      if (t < 256) { isg = true; seg = 15 - (t >> 4); hd = (t >> 2) & 3; sl = t & 3; }
      else { const int u = t - 256; isg = false; seg = u >> 4; hd = (u >> 2) & 3; sl = u & 3; }
    } else {
      if (t >= 720 && t < 1296) { rglru_scan(p, l, (t - 720) >> 1, (t - 720) & 1); continue; }
      if (t < 480) { kind = 1; isg = true; seg = t >> 5; hd = (t >> 3) & 3; sl = t & 7; }
      else if (t < 720) { const int u = t - 480; kind = 1; isg = false; seg = u >> 4; hd = (u >> 2) & 3; sl = u & 3; }
      else if (t < 1296 + 512) { const int u = t - 1296; kind = 0; isg = true; seq = 1 + (u >> 4); hd = (u >> 2) & 3; sl = u & 3; }
      else { const int u = t - 1808; kind = 0; isg = false; seq = 1 + (u >> 4); hd = (u >> 2) & 3; sl = u & 3; }
    }
    if (isg) mat_scan<true>(smem, p, l, kind, seg, seq, hd, sl);
    else mat_scan<false>(smem, p, l, kind, seg, seq, hd, sl);
  }
}

__device__ __forceinline__ void run_phase(u16* smem, const Params& p, int l, int ph, bool dup = false) {
#ifdef ONLY_PH
  if (ph != ONLY_PH) return;
  ph = ONLY_PH;
#endif
  u16* Z = (u16*)(p.ws + WS_Z);
  u16* WB = (u16*)(p.ws + WS_WB);
  u16* H = (u16*)(p.ws + WS_H);
  u16* Y = (u16*)(p.ws + WS_Y);
  if (ph == 0 || ph == 7 || ph == 10) {
    const bool fi = (ph == 0);
    const u16* y = fi ? nullptr : Y;
    const float* postw = ((ph == 7) ? opq(p.n_post_mix) : opq(p.n_post_mlp)) + l * D;
    const float* npm = opq(p.n_pre_mix);
    const float* prew = (ph == 0) ? npm : (ph == 7) ? opq(p.n_pre_mlp) + l * D : ((l + 1 < DEPTH) ? npm + (l + 1) * D : nullptr);
    rowpass_phase(p, fi, y, postw, prew, H);
    const int wl = (ph == 0) ? 0 : l + 1;
    if (ph != 7 && wl < DEPTH) wconv_phase(smem, p, wl);
  } else if (ph == 1 || ph == 6 || ph == 8 || ph == 9) {
    const u16* A = (ph == 9) ? Z : H;
    const int lda = (ph == 9) ? 4096 : 1024;
    const u16* Bt = WB + ((ph == 1) ? WB_IN : (ph == 6) ? WB_OUT : (ph == 8) ? WB_UP : WB_DN);
    const int K = (ph == 9) ? 4096 : 1024;
    const int N = (ph == 1) ? ZS : (ph == 8) ? 4096 : 1024;
    u16* C = (ph == 1 || ph == 8) ? Z : Y;
    const int ldc = (ph == 1) ? ZS : (ph == 8) ? 4096 : 1024;
    gemm_big_phase(smem, A, lda, Bt, K, N, K, C, ldc, ph == 8 ? 1 : 0);
  } else if (ph == 2) prep_phase(smem, p, l, dup);
  else if (ph == 3 || ph == 11) scan_phase(smem, p, l, ph == 11 ? 1 : 0);
  else if (ph == 4) onorm_phase(p, l);
  else if (ph == 5) merge_big_phase(smem, p);
}

#if MULTI_LAUNCH
__global__ void __launch_bounds__(256, 2) phase_kernel(Params p, int l, int ph) {
  __shared__ __attribute__((aligned(16))) u16 smem[SMEM_BYTES / 2];
  run_phase(smem, p, l, ph);
}
#endif

#if !MULTI_LAUNCH
#define XB_TMO      128
#define XB_XCNT(j)  (256  + 64 * (j))
#define XB_XSUB(j)  (1280 + 64 * (j))
#define XB_XGEN(j)  (2304 + 64 * (j))
#define XB_TOP      3328
#define XB_TOPGEN   3392
#define XCD_BAR_WORDS 3456
#define XB_SPIN_CAP (1u << 18)
#define LAS __attribute__((address_space(3)))

__device__ __forceinline__ unsigned xb_ld(unsigned* p)              { return __hip_atomic_load(p, __ATOMIC_RELAXED, __HIP_MEMORY_SCOPE_AGENT); }
__device__ __forceinline__ unsigned xb_add(unsigned* p, unsigned v) { return __hip_atomic_fetch_add(p, v, __ATOMIC_RELAXED, __HIP_MEMORY_SCOPE_AGENT); }
__device__ __forceinline__ unsigned xb_xcc_id() { return (unsigned)__builtin_amdgcn_s_getreg((3 << 11) | 20) & 0xFu; }
#define XB_SPIN(cond, bar) do { unsigned _sp = 0; while (cond) { __builtin_amdgcn_s_sleep(1); \
    if ((++_sp & 255u) == 0u) { if (xb_ld(&(bar)[XB_TMO])) break; if (_sp > XB_SPIN_CAP) { atomicAdd(&(bar)[XB_TMO], 1u); break; } } } } while (0)

struct XcdBarrier {
    unsigned* bar; unsigned x;
    volatile LAS unsigned* st;
};

__device__ __forceinline__ XcdBarrier xcd_barrier_post(unsigned* bar, volatile LAS unsigned* st) {
    XcdBarrier b; b.bar = bar; b.x = xb_xcc_id(); b.st = st;
    if (threadIdx.x == 0) (void)xb_add(&bar[XB_XCNT(b.x)], 1u);
    return b;
}
__device__ __forceinline__ void xcd_barrier_complete(unsigned* bar, unsigned x, unsigned& nloc, unsigned& nx) {
    const unsigned G = gridDim.x * gridDim.y * gridDim.z;
    unsigned sum, cnt, mine, sp = 0u;
    for (;;) {
        sum = 0u; cnt = 0u; mine = 0u;
#pragma unroll
        for (unsigned j = 0; j < 16; ++j) { const unsigned c = xb_ld(&bar[XB_XCNT(j)]); sum += c; cnt += (c > 0u) ? 1u : 0u; mine = (j == x) ? c : mine; }
        if (sum == G) break;
        __builtin_amdgcn_s_sleep(1);
        if ((++sp & 255u) == 0u) { if (xb_ld(&bar[XB_TMO])) break; if (sp > XB_SPIN_CAP) { atomicAdd(&bar[XB_TMO], 1u); break; } }
    }
    nloc = mine > 0u ? mine : 1u; nx = cnt > 0u ? cnt : 1u;
}

__device__ __forceinline__ void xcd_barrier(const XcdBarrier& b) {
    asm volatile("s_waitcnt vmcnt(0)" ::: "memory");
    __syncthreads();
    if (threadIdx.x == 0) {
        unsigned* bar = b.bar;
        __builtin_amdgcn_s_waitcnt(0);
        unsigned nloc = b.st[0], nx = b.st[1];
        if (nloc == 0u) { xcd_barrier_complete(bar, b.x, nloc, nx); b.st[0] = nloc; b.st[1] = nx; }
        const unsigned old = xb_add(&bar[XB_XSUB(b.x)], 1u);
        const unsigned gen = old / nloc;
        if (old + 1u == (gen + 1u) * nloc) {
            __builtin_amdgcn_fence(__ATOMIC_RELEASE, "agent");
            asm volatile("s_waitcnt vmcnt(0)" ::: "memory");
            const unsigned og = xb_add(&bar[XB_TOP], 1u);
            const unsigned tg = og / nx;
            if (og + 1u == (tg + 1u) * nx) xb_add(&bar[XB_TOPGEN], 1u);
            else XB_SPIN(xb_ld(&bar[XB_TOPGEN]) == tg, bar);
            __builtin_amdgcn_fence(__ATOMIC_ACQUIRE, "agent");
            xb_add(&bar[XB_XGEN(b.x)], 1u);
            asm volatile("s_waitcnt vmcnt(0)" ::: "memory");
        } else {
            XB_SPIN(xb_ld(&bar[XB_XGEN(b.x)]) == gen, bar);
            __builtin_amdgcn_fence(__ATOMIC_ACQUIRE, "agent");
            asm volatile("s_waitcnt vmcnt(0)" ::: "memory");
        }
    }
    __syncthreads();
}


__global__ void __launch_bounds__(256, 2) mega_kernel(Params p) {
  __shared__ __attribute__((aligned(16))) u16 smem[SMEM_BYTES / 2 + 8];
  cg::grid_group grid = cg::this_grid();
  unsigned* xbw = (unsigned*)(smem + SMEM_BYTES / 2);
  if (threadIdx.x == 0) { xbw[0] = 0u; xbw[1] = 0u; xbw[2] = 0u; xbw[3] = 0u; }
  __syncthreads();
  XcdBarrier xb = xcd_barrier_post((unsigned*)(p.ws + WS_BAR), (volatile LAS unsigned*)xbw);
  if (p.ws == nullptr) grid.sync();
  for (int s = 0; s < 1 + DEPTH * 11; s++) {
    int l = 0, ph = 0;
    if (s > 0) {
      l = (s - 1) / 11;
      const int pi = (s - 1) % 11 + 1;
      ph = (pi <= 3) ? pi : (pi == 4) ? 11 : pi - 1;
    }
    run_phase(smem, p, l, ph);
    xcd_barrier(xb);
#ifdef DUP_MASK
    if (s > 0 && ((DUP_MASK >> ph) & 1)) { run_phase(smem, p, l, ph, true); xcd_barrier(xb); }
#endif
#ifdef EXTRA_SYNCS
    for (int i = 0; i < EXTRA_SYNCS; i++) xcd_barrier(xb);
#endif
  }
}
#endif

extern "C" void kernel_launch(void* const* d_in, const int* in_sizes, int n_in, void* d_out, int out_size, void* d_ws,
                              size_t ws_size, hipStream_t stream) {
  if (ws_size < WS_END) { fprintf(stderr, "workspace too small: %zu < %zu\n", ws_size, (size_t)WS_END); return; }
  Params p{};
  const float** pp = (const float**)&p;
  for (int i = 0; i < 31; i++) pp[i] = (const float*)d_in[i];
  p.out = (float*)d_out;
  p.ws = (char*)d_ws;
  static int grid_blocks = 0;
  if (!grid_blocks) {
    int dev = 0, cus = 0, per_cu = 0;
    hipGetDevice(&dev);
    hipDeviceGetAttribute(&cus, hipDeviceAttributeMultiprocessorCount, dev);
#if MULTI_LAUNCH
    hipOccupancyMaxActiveBlocksPerMultiprocessor(&per_cu, phase_kernel, 256, 0);
#else
    hipOccupancyMaxActiveBlocksPerMultiprocessor(&per_cu, mega_kernel, 256, 0);
#endif
    if (per_cu > 2) per_cu = 2;
    if (per_cu < 1) per_cu = 1;
    grid_blocks = cus * per_cu;
  }
#if MULTI_LAUNCH
  phase_kernel<<<grid_blocks, 256, 0, stream>>>(p, 0, 0);
  for (int l = 0; l < DEPTH; l++)
    for (int pi = 1; pi <= 11; pi++) phase_kernel<<<grid_blocks, 256, 0, stream>>>(p, l, (pi <= 3) ? pi : (pi == 4) ? 11 : pi - 1);
#else
  hipMemsetAsync((char*)d_ws + WS_BAR, 0, 16384, stream);
  void* args[] = {&p};
  hipError_t e = hipLaunchCooperativeKernel((void*)mega_kernel, dim3(grid_blocks), dim3(256), args, 0, stream);
  if (e != hipSuccess) fprintf(stderr, "cooperative launch failed: %s (grid %d)\n", hipGetErrorString(e), grid_blocks);
#endif
}
```
